# Optimizing an MI355X kernel written in HIP

```python
import jax, jax.numpy as jnp
from jax import lax
import numpy as np

D_MODEL = 2048
BATCH = 4
SEQ = 2048
DEPTH = 4

RET_HEADS = 8
RET_DK = D_MODEL // RET_HEADS
RET_DV = 2 * D_MODEL // RET_HEADS
RET_QK = RET_HEADS * RET_DK
RET_V = RET_HEADS * RET_DV
RET_CHUNK = 128
ROPE_BASE = 10000.0
POOL_WINDOWS = (2, 4, 8, 16)
POOL_GROUPS = len(POOL_WINDOWS)
POOL_G = D_MODEL // POOL_GROUPS
D_FF = 5632
N_EXPERTS = 8
TOP_K = 2
D_FF_EXPERT = 1408
NORM_EPS = 1e-6
N_RET = (DEPTH + 1) // 2
N_POOL = DEPTH // 2

kernel_name = "hybrid_retention_pool_moe_trunk"


def rms_norm(x, g):
    xf = x.astype(jnp.float32)
    y = xf * lax.rsqrt(jnp.mean(xf * xf, axis=-1, keepdims=True) + NORM_EPS)
    return (y * g.astype(jnp.float32)).astype(x.dtype)


def rotary_interleaved(x, pos):
    b, s, h, dk = x.shape
    freq = 1.0 / (ROPE_BASE ** jnp.linspace(0.0, 1.0, dk // 2, dtype=jnp.float32))
    ang = pos.astype(jnp.float32)[:, None] * freq[None, :]
    cos = jnp.cos(ang)[None, :, None, :]
    sin = jnp.sin(ang)[None, :, None, :]
    xr = x.astype(jnp.float32).reshape(b, s, h, dk // 2, 2)
    x1, x2 = xr[..., 0], xr[..., 1]
    out = jnp.stack([x1 * cos - x2 * sin, x2 * cos + x1 * sin], axis=-1)
    return out.reshape(b, s, h, dk)


def chunkwise_retention(q, k, v):
    b, s, h, dk = q.shape
    dv = v.shape[-1]
    c = RET_CHUNK
    nc = s // c

    def to_chunks(t):
        return t.reshape(b, nc, c, h, t.shape[-1]).transpose(1, 0, 3, 2, 4)

    log_g = jnp.log1p(-jnp.exp2(-5.0 - jnp.arange(h, dtype=jnp.float32)))
    idx = jnp.arange(c, dtype=jnp.float32)
    rel = idx[:, None] - idx[None, :]
    decay_mask = jnp.where(rel[None] >= 0,
                           jnp.exp(jnp.maximum(rel, 0.0)[None] * log_g[:, None, None]),
                           0.0)
    q_decay = jnp.exp((idx + 1.0)[None, :] * log_g[:, None])[:, :, None]
    k_decay = jnp.exp((c - 1.0 - idx)[None, :] * log_g[:, None])[:, :, None]
    chunk_decay = jnp.exp(c * log_g)[:, None, None]

    def step(state, qkv):
        qc, kc, vc = qkv
        scores = jnp.einsum('bhid,bhjd->bhij', qc, kc) * decay_mask
        inner = jnp.einsum('bhij,bhjv->bhiv', scores, vc)
        cross = jnp.einsum('bhid,bhdv->bhiv', qc, state) * q_decay
        new_state = state * chunk_decay + jnp.einsum('bhjd,bhjv->bhdv', kc * k_decay, vc)
        return new_state, inner + cross

    state0 = jnp.zeros((b, h, dk, dv), jnp.float32)
    _, out = lax.scan(step, state0, (to_chunks(q), to_chunks(k), to_chunks(v)))
    return out.transpose(1, 0, 3, 2, 4).reshape(b, s, h, dv)


def retention_mixer(hn, w_in, norm_g, w_out):
    b, s, _ = hn.shape
    proj = hn @ w_in
    q, k, v, g = jnp.split(proj, [RET_QK, 2 * RET_QK, 2 * RET_QK + RET_V], axis=-1)
    pos = jnp.arange(s)
    q = rotary_interleaved(q.reshape(b, s, RET_HEADS, RET_DK), pos)
    k = rotary_interleaved(k.reshape(b, s, RET_HEADS, RET_DK), pos) * (RET_DK ** -0.5)
    v = v.reshape(b, s, RET_HEADS, RET_DV).astype(jnp.float32)
    o = chunkwise_retention(q, k, v)
    o = o * lax.rsqrt(jnp.mean(o * o, axis=-1, keepdims=True) + NORM_EPS)
    o = o * norm_g.astype(jnp.float32).reshape(RET_HEADS, RET_DV)
    o = o.reshape(b, s, RET_V).astype(hn.dtype) * jax.nn.silu(g)
    return o @ w_out


def pool_mixer(hn, w_groups, scale):
    b, s, _ = hn.shape
    hf = hn.astype(jnp.float32)
    cs = jnp.pad(jnp.cumsum(hf, axis=1), ((0, 0), (1, 0), (0, 0)))
    t = jnp.arange(s)
    outs = []
    for gi, w in enumerate(POOL_WINDOWS):
        lo, hi = gi * POOL_G, (gi + 1) * POOL_G
        c = cs[:, :, lo:hi]
        lag = jnp.pad(c[:, :s - w + 1], ((0, 0), (w - 1, 0), (0, 0)))
        count = jnp.minimum(t + 1, w).astype(jnp.float32)[None, :, None]
        mix = ((c[:, 1:] - lag) / count - hf[:, :, lo:hi]).astype(hn.dtype)
        outs.append(mix @ w_groups[gi])
    return jnp.concatenate(outs, axis=-1) * scale


def swiglu(h, w_gu, w_down):
    a, u = jnp.split(h @ w_gu, 2, axis=-1)
    return (jax.nn.silu(a) * u) @ w_down


def moe_swiglu(hn, router, w_gu, w_down):
    b, s, d = hn.shape
    tok = hn.reshape(b * s, d)
    logits = (tok @ router).astype(jnp.float32)
    top_v, top_i = lax.top_k(logits, TOP_K)
    gates = jax.nn.softmax(top_v, axis=-1)
    combine = jnp.sum(jax.nn.one_hot(top_i, N_EXPERTS, dtype=jnp.float32) * gates[..., None], axis=1)
    combine = combine.astype(tok.dtype)
    out = jnp.zeros_like(tok)
    for e in range(N_EXPERTS):
        out = out + combine[:, e:e + 1] * swiglu(tok, w_gu[e], w_down[e])
    return out.reshape(b, s, d)


def setup_inputs(seed: int = 0) -> dict:
    key = jax.random.key(seed)
    ks = jax.random.split(key, 16)
    f32 = jnp.float32
    D = D_MODEL

    def nrm(k, shape, fan_in):
        return jax.random.normal(k, shape, f32) * (fan_in ** -0.5)

    def gain(k, shape):
        return 1.0 + 0.02 * jax.random.normal(k, shape, f32)

    return {
        "x": jax.random.normal(ks[0], (BATCH, SEQ, D), f32),
        "ret_w_in": nrm(ks[1], (N_RET, D, 2 * RET_QK + 2 * RET_V), D),
        "ret_norm_g": gain(ks[2], (N_RET, RET_V)),
        "ret_w_out": nrm(ks[3], (N_RET, RET_V, D), RET_V),
        "pool_w": nrm(ks[4], (N_POOL, POOL_GROUPS, POOL_G, POOL_G), POOL_G),
        "pool_scale": gain(ks[5], (N_POOL, D)),
        "ffn_w_gu": nrm(ks[6], (N_RET, D, 2 * D_FF), D),
        "ffn_w_down": nrm(ks[7], (N_RET, D_FF, D), D_FF),
        "moe_router": nrm(ks[8], (N_POOL, D, N_EXPERTS), D),
        "moe_w_gu": nrm(ks[9], (N_POOL, N_EXPERTS, D, 2 * D_FF_EXPERT), D),
        "moe_w_down": nrm(ks[10], (N_POOL, N_EXPERTS, D_FF_EXPERT, D), D_FF_EXPERT),
        "norm_mix_g": gain(ks[11], (DEPTH, D)),
        "norm_ffn_g": gain(ks[12], (DEPTH, D)),
        "norm_final_g": gain(ks[13], (D,)),
    }


def reference(x, ret_w_in, ret_norm_g, ret_w_out, pool_w, pool_scale, ffn_w_gu, ffn_w_down,
              moe_router, moe_w_gu, moe_w_down, norm_mix_g, norm_ffn_g, norm_final_g):
    for i in range(DEPTH):
        j = i // 2
        hn = rms_norm(x, norm_mix_g[i])
        if i % 2 == 0:
            x = x + retention_mixer(hn, ret_w_in[j], ret_norm_g[j], ret_w_out[j])
        else:
            x = x + pool_mixer(hn, pool_w[j], pool_scale[j])
        hn = rms_norm(x, norm_ffn_g[i])
        if i % 2 == 0:
            x = x + swiglu(hn, ffn_w_gu[j], ffn_w_down[j])
        else:
            x = x + moe_swiglu(hn, moe_router[j], moe_w_gu[j], moe_w_down[j])
    return rms_norm(x, norm_final_g)
```

```cpp
#include <hip/hip_runtime.h>
#include <cstdio>

#define LAS __attribute__((address_space(3)))
#define GAS __attribute__((address_space(1)))
typedef unsigned short bf16_t;
typedef short bf16x8 __attribute__((ext_vector_type(8)));
typedef float f32x4 __attribute__((ext_vector_type(4)));
typedef float f32x2 __attribute__((ext_vector_type(2)));
typedef unsigned u32x4 __attribute__((ext_vector_type(4)));
typedef unsigned u32x2 __attribute__((ext_vector_type(2)));
typedef int i32x4 __attribute__((ext_vector_type(4)));
typedef int i32x8 __attribute__((ext_vector_type(8)));

#ifndef MK_N_LAUNCHES
#define MK_N_LAUNCHES 1
#endif

constexpr int NT = 8192, SEQ = 2048, D = 2048, NH = 8, DK = 256, DV = 512, QKW = 2048, VW = 4096, FF = 5632, NE = 8, FE = 1408;
constexpr float EPS = 1e-6f;
constexpr int NPHASE = 23;
#ifndef DENSE8
#define DENSE8 3
#endif
#ifndef PROJ8
#define PROJ8 2
#endif
#ifndef I8A1
#define I8A1 3
#endif
#ifndef I8A4
#define I8A4 1
#endif
#ifndef I8B4
#define I8B4 0
#endif
#ifndef RET8
#define RET8 2
#endif
#ifndef F8MASK
#define F8MASK 3
#endif
constexpr int FE8 = 1536;

constexpr size_t MiB = 1u << 20;
constexpr size_t WS_CTL = 0, CTL_BYTES = 1 * MiB;
constexpr size_t WS_COS = 1 * MiB, WS_SIN = 2 * MiB, WS_DQ = 3 * MiB, WS_DKS = 3 * MiB + 4096, WS_LG2 = 3 * MiB + 8192, WS_DQ8 = 3 * MiB + 12288, WS_DKS8 = 3 * MiB + 16384;
constexpr size_t WS_ROWSS = 4 * MiB, WS_TOK = 5 * MiB, WS_GATE = 5 * MiB + 512 * 1024;
constexpr size_t WS_SA = 6 * MiB, WS_SWGU = 6 * MiB + 64 * 1024;
constexpr size_t WS_SWQ = WS_SA + 128 * 1024, WS_SWV = WS_SA + 160 * 1024, SZ_SWL = 256 * 1024;
constexpr size_t WS_SAM = WS_SA + 1024 * 1024, WS_SWM = WS_SA + 1536 * 1024;
constexpr size_t WS_WQKG = 8 * MiB, SZ_WQKG = 32 * MiB;
constexpr size_t WS_WVT = 72 * MiB, SZ_WVT = 16 * MiB;
constexpr size_t WS_WOUT = 104 * MiB, SZ_WOUT = 16 * MiB;
constexpr size_t WS_WGU = 136 * MiB, SZ_WGU = 44 * MiB;
constexpr size_t WS_WDN = 224 * MiB, SZ_WDN = 22 * MiB;
constexpr size_t WS_WPOOL = 268 * MiB, SZ_WPOOL = 2 * MiB;
constexpr size_t WS_WMGU = 272 * MiB, SZ_WMGU = 88 * MiB;
constexpr size_t WS_WMDN = 448 * MiB, SZ_WMDN = 44 * MiB;
constexpr size_t WS_X = 536 * MiB, WS_XB = 600 * MiB, WS_S = 632 * MiB;
constexpr size_t WS_QB = WS_S, WS_KB = WS_S + 32 * MiB, WS_VT = WS_S + 64 * MiB, WS_GB = WS_S + 128 * MiB, WS_OG = WS_S + 192 * MiB, WS_ACT = WS_S;
constexpr size_t WS_MIX = WS_S, WS_XG = WS_S + 32 * MiB, WS_ACTM = WS_S + 288 * MiB, WS_Y = WS_S + 464 * MiB;
constexpr size_t WS_END = WS_S + 592 * MiB;
constexpr unsigned WS_END_32 = (unsigned)WS_END;
constexpr int CW_BAR = 4096;
constexpr int CW_Q = 8192;
constexpr int CW_CNT = 1024;

constexpr int RING_BYTES = 131072, MISC_OFF = 139264, LDS_BYTES = 143360;

__device__ __forceinline__ unsigned cvt_pk_bf16(float lo, float hi) { unsigned r; asm volatile("v_cvt_pk_bf16_f32 %0, %1, %2" : "=v"(r) : "v"(lo), "v"(hi)); return r; }
__device__ __forceinline__ float bf_lo(unsigned w) { return __uint_as_float(w << 16); }
__device__ __forceinline__ float bf_hi(unsigned w) { return __uint_as_float(w & 0xffff0000u); }
__device__ __forceinline__ f32x4 bf4(u32x2 w) { return (f32x4){bf_lo(w.x), bf_hi(w.x), bf_lo(w.y), bf_hi(w.y)}; }
__device__ __forceinline__ float fast_sigmoid(float a) { return __builtin_amdgcn_rcpf(1.0f + __builtin_amdgcn_exp2f(-1.4426950408889634f * a)); }
__device__ __forceinline__ float wave_sum(float v) {
#pragma unroll
    for (int o = 1; o < 64; o <<= 1) v += __shfl_xor(v, o);
    return v;
}
#define LDS_WAIT() asm volatile("s_waitcnt lgkmcnt(0)" ::: "memory")
__device__ __forceinline__ int mk_tid(int wv) { unsigned z = 0u; asm volatile("" : "+s"(z)); return wv * 64 + (int)__builtin_amdgcn_mbcnt_hi(~0u, __builtin_amdgcn_mbcnt_lo(~0u, z)); }
#define VM_WAIT() asm volatile("s_waitcnt vmcnt(0)" ::: "memory")

namespace pg8 {
constexpr int BM = 256, BK = 64, HALF = 128, HTB = HALF * BK * 2, STAGE_BYTES = 8 * HTB;
__host__ __device__ __forceinline__ int lds_byte(int r, int c) { const int st = (r >> 4) * 2 + (c >> 5), rr = r & 15, cc = c & 31, ob = rr * 64 + cc * 2; return st * 1024 + (ob ^ (((ob >> 9) & 1) << 5)); }
__host__ __device__ __forceinline__ void stage_rc(int b, int& R, int& C) { const int st = b / 1024, sb = b % 1024, swz = sb ^ (((sb >> 9) & 1) << 5); R = (st >> 1) * 16 + swz / 64; C = (st & 1) * 32 + (swz % 64) / 2; }
__host__ __device__ __forceinline__ int perm32(int rho) { const int n = rho >> 4, i = rho & 15; return 8 * (i >> 2) + 4 * n + (i & 3); }

struct Unit { unsigned a, b; int pm, pn, grp, rows; };

__device__ __forceinline__ int xcd_remap(int L, int nwg) { const int q = nwg / 8, r = nwg % 8, xcd = L % 8, off = L / 8; return (xcd < r ? xcd * (q + 1) : r * (q + 1) + (xcd - r) * q) + off; }
__device__ __forceinline__ void walk2d(int w, int nM, int nN, int& pm, int& pn) { const int nig = 8 * nN, gid = w / nig, fm = gid * 8, gsz = (nM - fm) < 8 ? (nM - fm) : 8; pm = fm + ((w % nig) % gsz); pn = (w % nig) / gsz; }

template <class Epi, class Sched, int FP8 = 0>
__device__ __forceinline__ void gemm_phase(LAS unsigned char* lds, const unsigned char* wsbase, const int K, const int lda, const int ldb, const Sched& S, const Epi& E, const int wv) {
    int tid = mk_tid(wv); asm volatile("" : "+v"(tid));
    const int wid = __builtin_amdgcn_readfirstlane(tid >> 6), lane = tid & 63, wr = wid >> 2, wc = wid & 3, fr = lane & 15, fq = lane >> 4;
    constexpr int ES = FP8 ? 1 : 2;
    const int nt = K * ES / 128;
    unsigned voffA[2], voffB[2];
#pragma unroll
    for (int i = 0; i < 2; ++i) { int R, C; stage_rc(tid * 16 + i * 8192, R, C); const int Rb = (R & ~31) + perm32(R & 31);
        voffA[i] = (unsigned)(R * lda * ES + C * 2); voffB[i] = (unsigned)(Rb * ldb * ES + C * 2); }
    const unsigned kstep = (unsigned)(BK * 2);
    const unsigned hstepA = (unsigned)HALF * lda * ES, hstepB = (unsigned)HALF * ldb * ES;
    const unsigned ldsw = (unsigned)wid * 1024u;
    const __amdgpu_buffer_rsrc_t rsrc = __builtin_amdgcn_make_buffer_rsrc((void*)wsbase, 0, (int)WS_END_32, 0x00020000);
    const int aoff = lds_byte(wr * 64 + fr, fq * 8); int boff = lds_byte(wc * 32 + fr, fq * 8) + 4 * HTB;
    asm volatile("" : "+v"(boff));
#define PG8_SBR(b, h) (((b) * 2 + (h)) * HTB)
#define PG8_SA(b, h) (((b) * 2 + (h)) * HTB)
#define PG8_SB(b, h) ((4 + (b) * 2 + (h)) * HTB)
#define PG8_STAGE(bufoff, soff, voff) do { _Pragma("unroll") for (int _i = 0; _i < 2; ++_i) \
        __builtin_amdgcn_raw_ptr_buffer_load_lds(rsrc, (LAS unsigned*)(lds + (bufoff) + ldsw + _i * 8192), 16, (voff)[_i], (int)(soff), 0, 0); } while (0)
#define PG8_LD16(off) (*(const LAS i32x4*)(lds + (off)))
#define PG8_LDA(dst, b, h) do { _Pragma("unroll") for (int m = 0; m < 4; ++m) { \
        if constexpr (FP8 == 1) { dst##8[m].lo = PG8_LD16(PG8_SA(b, h) + aoff + m * 2048); dst##8[m].hi = PG8_LD16(PG8_SA(b, h) + aoff + m * 2048 + 1024); } \
        else { _Pragma("unroll") for (int k = 0; k < 2; ++k) dst[m][k] = *(const LAS bf16x8*)(lds + PG8_SA(b, h) + aoff + m * 2048 + k * 1024); } } } while (0)
#define PG8_LDB(dst, b, h) do { _Pragma("unroll") for (int n = 0; n < 2; ++n) { \
        if constexpr (FP8 == 1) { dst##8[n].lo = PG8_LD16(PG8_SBR(b, h) + boff + n * 2048); dst##8[n].hi = PG8_LD16(PG8_SBR(b, h) + boff + n * 2048 + 1024); } \
        else { _Pragma("unroll") for (int k = 0; k < 2; ++k) dst[n][k] = *(const LAS bf16x8*)(lds + PG8_SBR(b, h) + boff + n * 2048 + k * 1024); } } } while (0)
#define PG8_MMA(ai, bj, At, Bt) do { __builtin_amdgcn_s_setprio(1); _Pragma("unroll") for (int m = 0; m < 4; ++m) _Pragma("unroll") for (int n = 0; n < 2; ++n) { \
        if constexpr (FP8 == 1) asm volatile("v_mfma_scale_f32_16x16x128_f8f6f4 %0, %1, %2, %0, %3, %3 op_sel_hi:[0,0,0]" : "+v"(acc[ai][bj][m][n]) : "v"(Bt##8[n]), "v"(At##8[m]), "v"(f8scale)); \
        else if constexpr (FP8 == 2) { _Pragma("unroll") for (int k = 0; k < 2; ++k) acc[ai][bj][m][n] = __builtin_bit_cast(f32x4, __builtin_amdgcn_mfma_i32_16x16x64_i8(__builtin_bit_cast(i32x4, Bt[n][k]), __builtin_bit_cast(i32x4, At[m][k]), __builtin_bit_cast(i32x4, acc[ai][bj][m][n]), 0, 0, 0)); } \
        else { _Pragma("unroll") for (int k = 0; k < 2; ++k) acc[ai][bj][m][n] = __builtin_amdgcn_mfma_f32_16x16x32_bf16(Bt[n][k], At[m][k], acc[ai][bj][m][n], 0, 0, 0); } } \
        __builtin_amdgcn_s_setprio(0); } while (0)
#define PG8_WAIT_V(n) asm volatile("s_waitcnt vmcnt(" #n ")" ::: "memory")
#define PG8_WAIT_L(n) asm volatile("s_waitcnt lgkmcnt(" #n ")" ::: "memory")
#define PG8_BAR __builtin_amdgcn_s_barrier()
#define PG8_SCHED __builtin_amdgcn_sched_barrier(0)
    Unit cur, nxt; int ui = 0;
    if (!S.next(0, cur)) return;
    f32x4 acc[2][2][4][2];
#pragma unroll
    for (int a = 0; a < 2; ++a)
#pragma unroll
        for (int b = 0; b < 2; ++b)
#pragma unroll
            for (int m = 0; m < 4; ++m)
#pragma unroll
                for (int n = 0; n < 2; ++n) acc[a][b][m][n] = (f32x4){0.f, 0.f, 0.f, 0.f};
    bf16x8 At[4][2], B0[2][2], B1[2][2]; i32x8 At8[4], B08[2], B18[2];
    int f8scale = 0x7f7f7f7f; asm volatile("" : "+v"(f8scale));
    unsigned cA = cur.a, cB = cur.b;
    PG8_STAGE(PG8_SB(0, 0), cB, voffB); PG8_STAGE(PG8_SB(0, 1), cB + hstepB, voffB); PG8_STAGE(PG8_SA(0, 0), cA, voffA); PG8_STAGE(PG8_SA(0, 1), cA + hstepA, voffA);
    if (wr == 1) PG8_BAR;
    PG8_WAIT_V(2); PG8_BAR;
    PG8_STAGE(PG8_SB(1, 0), cB + kstep, voffB); PG8_STAGE(PG8_SA(1, 0), cA + kstep, voffA); PG8_STAGE(PG8_SB(1, 1), cB + hstepB + kstep, voffB);
    PG8_WAIT_V(6); PG8_BAR;
    for (;;) {
        const bool has_next = S.next(ui + 1, nxt);
        const unsigned nA = has_next ? nxt.a : cA, nB = has_next ? nxt.b : cB;
        const bool full = cur.rows > 128;
        for (int t = 0; t < nt; t += 2) {
            const bool last = (t == nt - 2);
            const unsigned a1 = cA + (unsigned)(t + 1) * kstep;
            const unsigned a2 = last ? nA : cA + (unsigned)(t + 2) * kstep, b2 = last ? nB : cB + (unsigned)(t + 2) * kstep;
            const unsigned a3 = a2 + kstep, b3 = b2 + kstep;
            PG8_LDB(B0, 0, 0); PG8_LDB(B1, 0, 1); PG8_SCHED; PG8_LDA(At, 0, 0); PG8_STAGE(PG8_SA(1, 1), a1 + hstepA, voffA);
            PG8_WAIT_V(8); PG8_WAIT_L(0); PG8_BAR; PG8_MMA(0, 0, At, B0); PG8_MMA(0, 1, At, B1); PG8_BAR; PG8_SCHED;
            if (full) PG8_LDA(At, 0, 1); PG8_STAGE(PG8_SB(0, 0), b2, voffB); PG8_STAGE(PG8_SB(0, 1), b2 + hstepB, voffB); PG8_STAGE(PG8_SA(0, 0), a2, voffA);
            PG8_WAIT_V(8); PG8_WAIT_L(0); PG8_BAR; if (full) { PG8_MMA(1, 0, At, B0); PG8_MMA(1, 1, At, B1); } PG8_BAR; PG8_SCHED;
            PG8_LDB(B0, 1, 0); PG8_LDB(B1, 1, 1); PG8_SCHED; PG8_LDA(At, 1, 0); PG8_STAGE(PG8_SA(0, 1), a2 + hstepA, voffA);
            PG8_WAIT_V(8); PG8_WAIT_L(0); PG8_BAR; PG8_MMA(0, 0, At, B0); PG8_MMA(0, 1, At, B1); PG8_BAR; PG8_SCHED;
            if (full) PG8_LDA(At, 1, 1); PG8_STAGE(PG8_SB(1, 0), b3, voffB); PG8_STAGE(PG8_SB(1, 1), b3 + hstepB, voffB); PG8_STAGE(PG8_SA(1, 0), a3, voffA);
            PG8_WAIT_V(8); PG8_WAIT_L(0); PG8_BAR; if (full) { PG8_MMA(1, 0, At, B0); PG8_MMA(1, 1, At, B1); } PG8_BAR; PG8_SCHED;
        }
        if (wr == 0) PG8_BAR;
        if constexpr (FP8 == 1) { asm volatile("s_nop 15\n\ts_nop 7" ::: "memory"); PG8_SCHED; }
        if constexpr (FP8 == 2) {
            _Pragma("unroll") for (int a = 0; a < 2; ++a) _Pragma("unroll") for (int b = 0; b < 2; ++b) _Pragma("unroll") for (int m = 0; m < 4; ++m) _Pragma("unroll") for (int n = 0; n < 2; ++n)
                acc[a][b][m][n] = __builtin_convertvector(__builtin_bit_cast(i32x4, acc[a][b][m][n]), f32x4); }
        E(acc, cur, wr, wc, fr, fq);
        if (!has_next) break;
#pragma unroll
        for (int a = 0; a < 2; ++a)
#pragma unroll
            for (int b = 0; b < 2; ++b)
#pragma unroll
                for (int m = 0; m < 4; ++m)
#pragma unroll
                    for (int n = 0; n < 2; ++n) acc[a][b][m][n] = (f32x4){0.f, 0.f, 0.f, 0.f};
        cur = nxt; cA = nA; cB = nB; ++ui;
        if (wr == 1) PG8_BAR;
    }
    PG8_WAIT_V(0);
    PG8_BAR;
#undef PG8_SA
#undef PG8_SB
#undef PG8_SBR
#undef PG8_STAGE
#undef PG8_LDA
#undef PG8_LD16
#undef PG8_LDB
#undef PG8_MMA
#undef PG8_WAIT_V
#undef PG8_WAIT_L
#undef PG8_BAR
#undef PG8_SCHED
}
}

#define XB_TMO      128
#define XB_XCNT(j)  (256  + 64 * (j))
#define XB_XSUB(j)  (1280 + 64 * (j))
#define XB_XGEN(j)  (2304 + 64 * (j))
#define XB_TOP      3328
#define XB_TOPGEN   3392
#define XCD_BAR_WORDS 3456
#define XB_SPIN_CAP (1u << 18)

__device__ __forceinline__ unsigned xb_ld(unsigned* p)              { return __hip_atomic_load(p, __ATOMIC_RELAXED, __HIP_MEMORY_SCOPE_AGENT); }
__device__ __forceinline__ unsigned xb_add(unsigned* p, unsigned v) { return __hip_atomic_fetch_add(p, v, __ATOMIC_RELAXED, __HIP_MEMORY_SCOPE_AGENT); }
__device__ __forceinline__ unsigned xb_xcc_id() { return (unsigned)__builtin_amdgcn_s_getreg((3 << 11) | 20) & 0xFu; }
#define XB_SPIN(cond, bar) do { unsigned _sp = 0; while (cond) { __builtin_amdgcn_s_sleep(1); \
    if ((++_sp & 255u) == 0u) { if (xb_ld(&(bar)[XB_TMO])) break; if (_sp > XB_SPIN_CAP) { atomicAdd(&(bar)[XB_TMO], 1u); break; } } } } while (0)

struct XcdBarrier { unsigned* bar; unsigned x; volatile LAS unsigned* st; int wv; };

__device__ __forceinline__ XcdBarrier xcd_barrier_post(unsigned* bar, volatile LAS unsigned* st) {
    XcdBarrier b; b.bar = bar; b.x = xb_xcc_id(); b.st = st;
    if (threadIdx.x == 0) (void)xb_add(&bar[XB_XCNT(b.x)], 1u);
    return b;
}
__device__ __forceinline__ void xcd_barrier_complete(unsigned* bar, unsigned x, unsigned& nloc, unsigned& nx) {
    const unsigned G = gridDim.x * gridDim.y * gridDim.z;
    unsigned sum, cnt, mine, sp = 0u;
    for (;;) {
        sum = 0u; cnt = 0u; mine = 0u;
#pragma unroll
        for (unsigned j = 0; j < 16; ++j) { const unsigned c = xb_ld(&bar[XB_XCNT(j)]); sum += c; cnt += (c > 0u) ? 1u : 0u; mine = (j == x) ? c : mine; }
        if (sum == G) break;
        __builtin_amdgcn_s_sleep(1);
        if ((++sp & 255u) == 0u) { if (xb_ld(&bar[XB_TMO])) break; if (sp > XB_SPIN_CAP) { atomicAdd(&bar[XB_TMO], 1u); break; } }
    }
    nloc = mine > 0u ? mine : 1u; nx = cnt > 0u ? cnt : 1u;
}
__device__ __forceinline__ void xcd_barrier(const XcdBarrier& b) {
    asm volatile("s_waitcnt vmcnt(0)" ::: "memory");
    __syncthreads();
    if (mk_tid(b.wv) == 0) {
        unsigned* bar = b.bar;
        __builtin_amdgcn_s_waitcnt(0);
        unsigned nloc = b.st[0], nx = b.st[1];
        if (nloc == 0u) { xcd_barrier_complete(bar, b.x, nloc, nx); b.st[0] = nloc; b.st[1] = nx; }
        const unsigned old = xb_add(&bar[XB_XSUB(b.x)], 1u);
        const unsigned gen = old / nloc;
        if (old + 1u == (gen + 1u) * nloc) {
            __builtin_amdgcn_fence(__ATOMIC_RELEASE, "agent");
            asm volatile("s_waitcnt vmcnt(0)" ::: "memory");
            const unsigned og = xb_add(&bar[XB_TOP], 1u);
            const unsigned tg = og / nx;
            if (og + 1u == (tg + 1u) * nx) xb_add(&bar[XB_TOPGEN], 1u);
            else XB_SPIN(xb_ld(&bar[XB_TOPGEN]) == tg, bar);
            __builtin_amdgcn_fence(__ATOMIC_ACQUIRE, "agent");
            xb_add(&bar[XB_XGEN(b.x)], 1u);
            asm volatile("s_waitcnt vmcnt(0)" ::: "memory");
        } else {
            XB_SPIN(xb_ld(&bar[XB_XGEN(b.x)]) == gen, bar);
            __builtin_amdgcn_fence(__ATOMIC_ACQUIRE, "agent");
            asm volatile("s_waitcnt vmcnt(0)" ::: "memory");
        }
    }
    __syncthreads();
}

using pg8::Unit;
struct DenseOrder {
    unsigned A, B; int nM, nN, nwg, G, c; unsigned tA, tB;
    __device__ __forceinline__ void init(size_t A_, int lda, size_t B_, int ldb, int M, int N, int G_, int c_) { A = (unsigned)A_; B = (unsigned)B_; nM = M / 256; nN = N / 256; nwg = nM * nN; G = G_; c = c_; tA = 256u * lda * 2; tB = 256u * ldb * 2; }
    __device__ __forceinline__ bool next(int i, Unit& u) const {
        const long L = (long)i * G + c; if (L >= nwg) return false;
        const int w = pg8::xcd_remap((int)L, nwg); pg8::walk2d(w, nM, nN, u.pm, u.pn);
        u.a = A + (unsigned)u.pm * tA; u.b = B + (unsigned)u.pn * tB; u.grp = 0; u.rows = 256; return true;
    }
};
struct A1Order {
    unsigned XB, WQKG, WVT, t; int G, c;
    __device__ __forceinline__ bool next(int i, Unit& u) const {
        const long L = (long)i * G + c; if (L >= 32 * 48) return false;
        const int w = pg8::xcd_remap((int)L, 32 * 48); pg8::walk2d(w, 32, 48, u.pm, u.pn);
        if (u.pn < 32) { u.a = XB + (unsigned)u.pm * t; u.b = WQKG + (unsigned)u.pn * t; } else { u.a = WVT + (unsigned)(u.pn - 32) * t; u.b = XB + (unsigned)u.pm * t; }
        u.grp = 0; u.rows = 256; return true;
    }
};
struct PoolOrder {
    unsigned MIX, W; int G, c;
    __device__ __forceinline__ bool next(int i, Unit& u) const {
        const long L = (long)i * G + c; if (L >= 256) return false;
        const int rem = (int)L & 7; u.pm = (int)L >> 3; u.grp = rem >> 1; u.pn = rem & 1;
        u.a = MIX + ((unsigned)u.pm * 256 * D + (unsigned)u.grp * 512) * 2; u.b = W + ((unsigned)u.grp * 512 * 512 + (unsigned)u.pn * 256 * 512) * 2; u.rows = 256; return true;
    }
};
struct MoeOrder {
    unsigned A, B; int G, c, nN, total, Fu, nF; unsigned pfl, pfh, ptw, rml, rmh; unsigned eA, eB, tA, tB;
    __device__ __forceinline__ void init(size_t A_, size_t eA_, int lda, size_t B_, size_t eB_, int ldb, int nN_, const unsigned* counts, int G_, int c_, int es = 2) {
        A = (unsigned)A_; B = (unsigned)B_; eA = (unsigned)eA_; eB = (unsigned)eB_; tA = 256u * lda * es; tB = 256u * ldb * es; nN = nN_; G = G_; c = c_;
        unsigned pf = 0, pt = 0; pfl = 0; pfh = 0; ptw = 0; rml = 0; rmh = 0;
#pragma unroll
        for (int e = 0; e < 8; ++e) { int n = (int)__builtin_amdgcn_readfirstlane(__hip_atomic_load(counts + 64 * e, __ATOMIC_RELAXED, __HIP_MEMORY_SCOPE_AGENT)); n = n > NT ? NT : n;
            const unsigned f = (unsigned)n >> 8, r = (unsigned)n & 255u;
            if (e >= 1) { if (e <= 4) pfl |= pf << (8 * (e - 1)); else pfh |= pf << (8 * (e - 5)); ptw |= pt << (4 * (e - 1)); }
            if (e < 4) rml |= r << (8 * e); else rmh |= r << (8 * (e - 4));
            pf += f; pt += r ? 1u : 0u; }
        nF = (int)pf; Fu = (int)pf * nN; total = (int)(pf + pt) * nN;
    }
    __device__ __forceinline__ int pfj(int j) const { return j == 0 ? 0 : (j == 8 ? nF : (int)(((j <= 4 ? pfl : pfh) >> (8 * ((j - 1) & 3))) & 255u)); }
    __device__ __forceinline__ bool next(int i, Unit& u) const {
        const long L = (long)i * G + c; if (L >= total) return false;
        int e = 0;
        if (L < Fu) {
            const int w = pg8::xcd_remap((int)L, Fu);
#pragma unroll
            for (int j = 1; j < 8; ++j) e += (w >= pfj(j) * nN) ? 1 : 0;
            int pe = 0, te = 0;
#pragma unroll
            for (int j = 0; j < 8; ++j) { if (j == e) { pe = pfj(j); te = pfj(j + 1) - pe; } }
            pg8::walk2d(w - pe * nN, te, nN, u.pm, u.pn); u.rows = 256;
        } else {
            const int t = (int)L - Fu, tq = t / nN; u.pn = t - tq * nN;
#pragma unroll
            for (int j = 1; j < 8; ++j) e += (tq >= (int)((ptw >> (4 * (j - 1))) & 15u)) ? 1 : 0;
            int pm = 0, rw = 0;
#pragma unroll
            for (int j = 0; j < 8; ++j) { if (j == e) { pm = pfj(j + 1) - pfj(j); rw = (int)(((j < 4 ? rml : rmh) >> (8 * (j & 3))) & 255u); } }
            u.pm = pm; u.rows = rw;
        }
        u.grp = e;
        u.a = A + (unsigned)e * eA + (unsigned)u.pm * tA; u.b = B + (unsigned)e * eB + (unsigned)u.pn * tB; return true;
    }
};

struct EpiA1 {
    bf16_t* QB; bf16_t* KB; bf16_t* GB; bf16_t* VT; const float* COS; const float* SIN; const float* DQ; const float* DKS; float ascale; int r8; const float* SA; const float* SWQ; const float* SWV;
    __device__ __forceinline__ void operator()(const f32x4 (&acc)[2][2][4][2], const Unit& u, int wr, int wc, int fr, int fq) const {
        if (u.pn < 32) {
            const int kind = u.pn < 8 ? 0 : (u.pn < 16 ? 1 : 2), h = u.pn & 7;
#pragma unroll
            for (int ai = 0; ai < 2; ++ai)
#pragma unroll
                for (int m = 0; m < 4; ++m) {
                    const int row = u.pm * 256 + ai * 128 + wr * 64 + m * 16 + fr, pos = row & (SEQ - 1);
                    float rf = ascale; if (kind < 2) rf = ascale * (kind == 0 ? DQ : DKS)[h * 128 + (pos & 127)];
                    if (SA) rf *= SA[row];
#pragma unroll
                    for (int bj = 0; bj < 2; ++bj) {
                        const int cc = bj * 128 + wc * 32 + fq * 8;
                        f32x4 v0 = acc[ai][bj][m][0], v1 = acc[ai][bj][m][1];
                        if (SA) { v0 = v0 * *(const f32x4*)(SWQ + u.pn * 256 + cc); v1 = v1 * *(const f32x4*)(SWQ + u.pn * 256 + cc + 4); }
                        bf16_t* dst;
                        if (kind < 2) {
                            const f32x4 cs = *(const f32x4*)(COS + pos * 128 + (cc >> 1)), sn = *(const f32x4*)(SIN + pos * 128 + (cc >> 1));
                            f32x4 o0, o1;
                            o0[0] = v0[0] * cs[0] - v0[1] * sn[0]; o0[1] = v0[1] * cs[0] + v0[0] * sn[0];
                            o0[2] = v0[2] * cs[1] - v0[3] * sn[1]; o0[3] = v0[3] * cs[1] + v0[2] * sn[1];
                            o1[0] = v1[0] * cs[2] - v1[1] * sn[2]; o1[1] = v1[1] * cs[2] + v1[0] * sn[2];
                            o1[2] = v1[2] * cs[3] - v1[3] * sn[3]; o1[3] = v1[3] * cs[3] + v1[2] * sn[3];
                            v0 = o0 * rf; v1 = o1 * rf;
                            dst = (kind == 0 ? QB : KB) + (size_t)row * QKW + h * 256 + cc;
                        } else { v0 = v0 * rf; v1 = v1 * rf; dst = GB + (size_t)row * VW + (u.pn - 16) * 256 + cc; }
                        if (r8 && kind < 2) { int w0 = 0, w1 = 0; w0 = __builtin_amdgcn_cvt_pk_fp8_f32(v0[0], v0[1], w0, false); w0 = __builtin_amdgcn_cvt_pk_fp8_f32(v0[2], v0[3], w0, true);
                            w1 = __builtin_amdgcn_cvt_pk_fp8_f32(v1[0], v1[1], w1, false); w1 = __builtin_amdgcn_cvt_pk_fp8_f32(v1[2], v1[3], w1, true); u32x2 w; w.x = (unsigned)w0; w.y = (unsigned)w1;
                            *(u32x2*)((unsigned char*)(kind == 0 ? QB : KB) + (size_t)row * QKW + h * 256 + cc) = w; }
                        else { u32x4 w; w.x = cvt_pk_bf16(v0[0], v0[1]); w.y = cvt_pk_bf16(v0[2], v0[3]); w.z = cvt_pk_bf16(v1[0], v1[1]); w.w = cvt_pk_bf16(v1[2], v1[3]);
                            *(u32x4*)dst = w; }
                    }
                }
        } else {
#pragma unroll
            for (int ai = 0; ai < 2; ++ai)
#pragma unroll
                for (int m = 0; m < 4; ++m) {
                    const int vrow = (u.pn - 32) * 256 + ai * 128 + wr * 64 + m * 16 + fr; const float rsv = SA ? ascale * SWV[vrow] : ascale;
#pragma unroll
                    for (int bj = 0; bj < 2; ++bj) {
                        const int tok = u.pm * 256 + bj * 128 + wc * 32 + fq * 8;
                        f32x4 v0 = acc[ai][bj][m][0] * rsv, v1 = acc[ai][bj][m][1] * rsv;
                        if (SA) { v0 = v0 * *(const f32x4*)(SA + tok); v1 = v1 * *(const f32x4*)(SA + tok + 4); }
                        if (r8) { int w0 = 0, w1 = 0; w0 = __builtin_amdgcn_cvt_pk_fp8_f32(v0[0], v0[1], w0, false); w0 = __builtin_amdgcn_cvt_pk_fp8_f32(v0[2], v0[3], w0, true);
                            w1 = __builtin_amdgcn_cvt_pk_fp8_f32(v1[0], v1[1], w1, false); w1 = __builtin_amdgcn_cvt_pk_fp8_f32(v1[2], v1[3], w1, true); u32x2 w; w.x = (unsigned)w0; w.y = (unsigned)w1;
                            *(u32x2*)((unsigned char*)VT + (size_t)vrow * NT + tok) = w; }
                        else { u32x4 w; w.x = cvt_pk_bf16(v0[0], v0[1]); w.y = cvt_pk_bf16(v0[2], v0[3]); w.z = cvt_pk_bf16(v1[0], v1[1]); w.w = cvt_pk_bf16(v1[2], v1[3]);
                            *(u32x4*)(VT + (size_t)vrow * NT + tok) = w; }
                    }
                }
        }
    }
};
struct EpiRes {
    bf16_t* X; bf16_t* XB; float* ROWSS; const float* colscale; int pool; float ascale; unsigned char* XB8;
    __device__ __forceinline__ void operator()(const f32x4 (&acc)[2][2][4][2], const Unit& u, int wr, int wc, int fr, int fq) const {
        const int colbase = pool ? (u.grp * 512 + u.pn * 256) : u.pn * 256;
        f32x4 cs[2][2];
#pragma unroll
        for (int bj = 0; bj < 2; ++bj)
#pragma unroll
            for (int n = 0; n < 2; ++n) cs[bj][n] = (colscale ? *(const f32x4*)(colscale + colbase + bj * 128 + wc * 32 + fq * 8 + n * 4) : (f32x4){1.f, 1.f, 1.f, 1.f}) * ascale;
#pragma unroll
        for (int ai = 0; ai < 2; ++ai)
#pragma unroll
            for (int m = 0; m < 4; ++m) {
                const int row = u.pm * 256 + ai * 128 + wr * 64 + m * 16 + fr;
                float ss = 0.f;
#pragma unroll
                for (int bj = 0; bj < 2; ++bj) {
                    const size_t off = (size_t)row * D + colbase + bj * 128 + wc * 32 + fq * 8;
                    const u32x4 xw = *(const u32x4*)(X + off); const f32x4 x0 = bf4((u32x2){xw.x, xw.y}), x1 = bf4((u32x2){xw.z, xw.w});
                    const f32x4 v0 = x0 + acc[ai][bj][m][0] * cs[bj][0], v1 = x1 + acc[ai][bj][m][1] * cs[bj][1];
                    { u32x4 w; w.x = cvt_pk_bf16(v0[0], v0[1]); w.y = cvt_pk_bf16(v0[2], v0[3]); w.z = cvt_pk_bf16(v1[0], v1[1]); w.w = cvt_pk_bf16(v1[2], v1[3]); *(u32x4*)(X + off) = w; }
                    if (XB) { u32x4 w; w.x = cvt_pk_bf16(v0[0], v0[1]); w.y = cvt_pk_bf16(v0[2], v0[3]); w.z = cvt_pk_bf16(v1[0], v1[1]); w.w = cvt_pk_bf16(v1[2], v1[3]); *(u32x4*)(XB + off) = w; }
                    if (XB8) { int w0 = 0, w1 = 0; w0 = __builtin_amdgcn_cvt_pk_fp8_f32(v0[0], v0[1], w0, false); w0 = __builtin_amdgcn_cvt_pk_fp8_f32(v0[2], v0[3], w0, true);
                        w1 = __builtin_amdgcn_cvt_pk_fp8_f32(v1[0], v1[1], w1, false); w1 = __builtin_amdgcn_cvt_pk_fp8_f32(v1[2], v1[3], w1, true); u32x2 w; w.x = (unsigned)w0; w.y = (unsigned)w1; *(u32x2*)(XB8 + off) = w; }
                    ss += (v0[0] * v0[0] + v0[1] * v0[1]) + (v0[2] * v0[2] + v0[3] * v0[3]) + (v1[0] * v1[0] + v1[1] * v1[1]) + (v1[2] * v1[2] + v1[3] * v1[3]);
                }
                ss += __shfl_xor(ss, 16); ss += __shfl_xor(ss, 32);
                if (fq == 0) ROWSS[(size_t)row * 32 + (colbase >> 8) * 4 + wc] = ss;
                if (m & 1) asm volatile("" ::: "memory");
            }
    }
};
struct EpiZ {
    bf16_t* Z;
    __device__ __forceinline__ void operator()(const f32x4 (&acc)[2][2][4][2], const Unit& u, int wr, int wc, int fr, int fq) const {
#pragma unroll
        for (int ai = 0; ai < 2; ++ai)
#pragma unroll
            for (int m = 0; m < 4; ++m) { const int row = u.pm * 256 + ai * 128 + wr * 64 + m * 16 + fr;
#pragma unroll
                for (int bj = 0; bj < 2; ++bj) { const f32x4 v0 = acc[ai][bj][m][0], v1 = acc[ai][bj][m][1];
                    u32x4 w; w.x = cvt_pk_bf16(v0[0], v0[1]); w.y = cvt_pk_bf16(v0[2], v0[3]); w.z = cvt_pk_bf16(v1[0], v1[1]); w.w = cvt_pk_bf16(v1[2], v1[3]);
                    *(u32x4*)(Z + (size_t)row * D + u.grp * 512 + u.pn * 256 + bj * 128 + wc * 32 + fq * 8) = w; } }
    }
};
struct EpiGU {
    bf16_t* ACT; int ldact; const float* ROWSS; size_t estride;
    __device__ __forceinline__ void operator()(const f32x4 (&acc)[2][2][4][2], const Unit& u, int wr, int wc, int fr, int fq) const {
        bf16_t* base = ACT + (size_t)u.grp * estride;
#pragma unroll
        for (int ai = 0; ai < 2; ++ai)
#pragma unroll
            for (int m = 0; m < 4; ++m) {
                const int row = u.pm * 256 + ai * 128 + wr * 64 + m * 16 + fr;
                float rs = 1.f;
                if (ROWSS) { const f32x4 p0 = *(const f32x4*)(ROWSS + (size_t)row * 32 + fq * 8), p1 = *(const f32x4*)(ROWSS + (size_t)row * 32 + fq * 8 + 4);
                    float s = (p0[0] + p0[1]) + (p0[2] + p0[3]) + (p1[0] + p1[1]) + (p1[2] + p1[3]); s += __shfl_xor(s, 16); s += __shfl_xor(s, 32); rs = __builtin_amdgcn_rsqf(s * (1.0f / D) + EPS); }
                float o[8];
#pragma unroll
                for (int n = 0; n < 2; ++n)
#pragma unroll
                    for (int j = 0; j < 4; ++j) { const float a = acc[ai][0][m][n][j] * rs, g = acc[ai][1][m][n][j] * rs; o[n * 4 + j] = a * fast_sigmoid(a) * g; }
                u32x4 w; w.x = cvt_pk_bf16(o[0], o[1]); w.y = cvt_pk_bf16(o[2], o[3]); w.z = cvt_pk_bf16(o[4], o[5]); w.w = cvt_pk_bf16(o[6], o[7]);
                *(u32x4*)(base + (size_t)row * ldact + u.pn * 128 + wc * 32 + fq * 8) = w;
            }
    }
};
struct EpiGUi8 {
    bf16_t* ACT; int ldact; const float* SA; const float* SW; int out8; size_t estride; int sastride, swstride;
    __device__ __forceinline__ void operator()(const f32x4 (&acc)[2][2][4][2], const Unit& u, int wr, int wc, int fr, int fq) const {
        f32x4 wa[2], wu[2];
#pragma unroll
        for (int n = 0; n < 2; ++n) { wa[n] = *(const f32x4*)(SW + u.grp * swstride + u.pn * 256 + wc * 32 + fq * 8 + n * 4); wu[n] = *(const f32x4*)(SW + u.grp * swstride + u.pn * 256 + 128 + wc * 32 + fq * 8 + n * 4); }
#pragma unroll
        for (int ai = 0; ai < 2; ++ai)
#pragma unroll
            for (int m = 0; m < 4; ++m) {
                const int row = u.pm * 256 + ai * 128 + wr * 64 + m * 16 + fr; const float sa = SA[u.grp * sastride + row];
                float o[8];
#pragma unroll
                for (int n = 0; n < 2; ++n)
#pragma unroll
                    for (int j = 0; j < 4; ++j) { const float a = acc[ai][0][m][n][j] * sa * wa[n][j], g = acc[ai][1][m][n][j] * sa * wu[n][j]; o[n * 4 + j] = a * fast_sigmoid(a) * g; }
                if (out8) { u32x2 w; w.x = 0u; w.y = 0u;
                    w.x = (unsigned)__builtin_amdgcn_cvt_pk_fp8_f32(o[0], o[1], (int)w.x, false); w.x = (unsigned)__builtin_amdgcn_cvt_pk_fp8_f32(o[2], o[3], (int)w.x, true);
                    w.y = (unsigned)__builtin_amdgcn_cvt_pk_fp8_f32(o[4], o[5], (int)w.y, false); w.y = (unsigned)__builtin_amdgcn_cvt_pk_fp8_f32(o[6], o[7], (int)w.y, true);
                    *(u32x2*)((unsigned char*)ACT + (size_t)u.grp * estride + (size_t)row * ldact + u.pn * 128 + wc * 32 + fq * 8) = w; }
                else { u32x4 w; w.x = cvt_pk_bf16(o[0], o[1]); w.y = cvt_pk_bf16(o[2], o[3]); w.z = cvt_pk_bf16(o[4], o[5]); w.w = cvt_pk_bf16(o[6], o[7]);
                    *(u32x4*)(ACT + (size_t)row * ldact + u.pn * 128 + wc * 32 + fq * 8) = w; }
            }
    }
};
struct EpiGU8 {
    unsigned char* ACT; int ldact; size_t estride; float s; const float* ROWSS;
    __device__ __forceinline__ void operator()(const f32x4 (&acc)[2][2][4][2], const Unit& u, int wr, int wc, int fr, int fq) const {
        unsigned char* base = ACT + (size_t)u.grp * estride;
#pragma unroll
        for (int ai = 0; ai < 2; ++ai)
#pragma unroll
            for (int m = 0; m < 4; ++m) {
                const int row = u.pm * 256 + ai * 128 + wr * 64 + m * 16 + fr;
                float rs = s;
                if (ROWSS) { const f32x4 p0 = *(const f32x4*)(ROWSS + (size_t)row * 32 + fq * 8), p1 = *(const f32x4*)(ROWSS + (size_t)row * 32 + fq * 8 + 4);
                    float q = (p0[0] + p0[1]) + (p0[2] + p0[3]) + (p1[0] + p1[1]) + (p1[2] + p1[3]); q += __shfl_xor(q, 16); q += __shfl_xor(q, 32); rs = s * __builtin_amdgcn_rsqf(q * (1.0f / D) + EPS); }
                float o[8];
#pragma unroll
                for (int n = 0; n < 2; ++n)
#pragma unroll
                    for (int j = 0; j < 4; ++j) { const float a = acc[ai][0][m][n][j] * rs, g = acc[ai][1][m][n][j] * rs; o[n * 4 + j] = a * fast_sigmoid(a) * g; }
                u32x2 w; w.x = 0u; w.y = 0u;
                w.x = (unsigned)__builtin_amdgcn_cvt_pk_fp8_f32(o[0], o[1], (int)w.x, false); w.x = (unsigned)__builtin_amdgcn_cvt_pk_fp8_f32(o[2], o[3], (int)w.x, true);
                w.y = (unsigned)__builtin_amdgcn_cvt_pk_fp8_f32(o[4], o[5], (int)w.y, false); w.y = (unsigned)__builtin_amdgcn_cvt_pk_fp8_f32(o[6], o[7], (int)w.y, true);
                *(u32x2*)(base + (size_t)row * ldact + u.pn * 128 + wc * 32 + fq * 8) = w;
            }
    }
};
struct EpiMoeDown {
    bf16_t* Y; const int* TOK; const float* GATE; float wscale;
    __device__ __forceinline__ void operator()(const f32x4 (&acc)[2][2][4][2], const Unit& u, int wr, int wc, int fr, int fq) const {
#pragma unroll
        for (int ai = 0; ai < 2; ++ai)
#pragma unroll
            for (int m = 0; m < 4; ++m) {
                const int rloc = ai * 128 + wr * 64 + m * 16 + fr;
                if (rloc < u.rows) {
                    const int gi = u.grp * NT + u.pm * 256 + rloc; const int t2 = TOK[gi]; const float gt = GATE[gi] * wscale;
                    bf16_t* dst = Y + ((size_t)(t2 & 1) * NT + (size_t)(t2 >> 1)) * D + u.pn * 256 + wc * 32 + fq * 8;
#pragma unroll
                    for (int bj = 0; bj < 2; ++bj) { const f32x4 v0 = acc[ai][bj][m][0] * gt, v1 = acc[ai][bj][m][1] * gt;
                        u32x4 w; w.x = cvt_pk_bf16(v0[0], v0[1]); w.y = cvt_pk_bf16(v0[2], v0[3]); w.z = cvt_pk_bf16(v1[0], v1[1]); w.w = cvt_pk_bf16(v1[2], v1[3]);
                        *(u32x4*)(dst + bj * 128) = w; }
                }
            }
    }
};

struct Frame {
    LAS unsigned char* lds; int tid, lane, wave, G, bid, wv;
    float* out; unsigned char* ws;
};
struct Params { const float* in[14]; float* out; unsigned char* ws; int ph_lo, ph_hi; };

struct TrItem { const float* src; unsigned char* dst; const float* ks; int srcld, dstpitch, f8; };
__device__ __forceinline__ TrItem tr_make(int r, const float* src, int srcld, int K, int col_begin, int ncols, void* dst, int row_begin, int mode, const float* kscale, int f8 = 0, int pitch8 = 0) {
    const int nb = ncols / 64, g = r >> 2, tq = r & 3, kb = 2 * (g / (nb >> 1)) + (tq >> 1), jb = 2 * (g % (nb >> 1)) + (tq & 1), j0 = jb * 64, k0 = kb * 64;
    const int drow = mode ? (256 * (j0 >> 7) + (j0 & 127) + row_begin) : (row_begin + j0);
    TrItem t; t.src = src + (size_t)k0 * srcld + col_begin + j0; t.ks = kscale ? kscale + k0 : nullptr; t.srcld = srcld;
    if (f8) { t.dst = (unsigned char*)dst + (size_t)drow * pitch8 + k0; t.dstpitch = pitch8; t.f8 = (f8 == 2 && kb == K / 64 - 1) ? 2 : 1; }
    else { t.dst = (unsigned char*)dst + ((size_t)drow * K + k0) * 2; t.dstpitch = K * 2; t.f8 = 0; }
    return t;
}
constexpr int IT_A = 2048 * 4 + 2816 * 3, IT_B = 256 + 5632 * 3;
__device__ __forceinline__ TrItem conv_item_A(const Params& PA, unsigned char* ws, int l, int r) {
    const float* w_in = PA.in[1] + (size_t)l * D * 12288; const float* gm = PA.in[11] + (size_t)(2 * l) * D; const float* gf = PA.in[12] + (size_t)(2 * l) * D;
    bf16_t* WQKG = (bf16_t*)(ws + WS_WQKG + l * SZ_WQKG); bf16_t* WVT = (bf16_t*)(ws + WS_WVT + l * SZ_WVT);
    const int p8 = (PROJ8 >> l) & 1;
    if (r < 2048) return tr_make(r, w_in, 12288, D, 0, 4096, WQKG, 0, 0, gm, p8, D); r -= 2048;
    if (r < 2048) return tr_make(r, w_in, 12288, D, 8192, 4096, WQKG, 4096, 0, gm, p8, D); r -= 2048;
    if (r < 2048) return tr_make(r, w_in, 12288, D, 4096, 4096, WVT, 0, 0, gm, p8, D); r -= 2048;
    if (r < 2048) return tr_make(r, PA.in[3] + (size_t)l * VW * D, D, VW, 0, D, (bf16_t*)(ws + WS_WOUT + l * SZ_WOUT), 0, 0, nullptr, p8, VW); r -= 2048;
    const float* gu = PA.in[6] + (size_t)l * D * 2 * FF; bf16_t* WGU = (bf16_t*)(ws + WS_WGU + l * SZ_WGU); const int d8 = (DENSE8 >> l) & 1;
    if (r < 2816) return tr_make(r, gu, 2 * FF, D, 0, FF, WGU, 0, 1, gf, d8, D); r -= 2816;
    if (r < 2816) return tr_make(r, gu, 2 * FF, D, FF, FF, WGU, 128, 1, gf, d8, D); r -= 2816;
    return tr_make(r, PA.in[7] + (size_t)l * FF * D, D, FF, 0, D, (bf16_t*)(ws + WS_WDN + l * SZ_WDN), 0, 0, nullptr, d8, FF);
}
__device__ __forceinline__ TrItem conv_item_B(const Params& PA, unsigned char* ws, int l, int r) {
    if (r < 256) { const int g = r >> 6; return tr_make(r & 63, PA.in[4] + ((size_t)l * 4 + g) * 512 * 512, 512, 512, 0, 512, (bf16_t*)(ws + WS_WPOOL + l * SZ_WPOOL) + (size_t)g * 512 * 512, 0, 0, PA.in[11] + (size_t)(2 * l + 1) * D + g * 512); } r -= 256;
    const int f8 = (F8MASK >> l) & 1;
    if (r < 5632) { const int e = r / 704; unsigned char* d = ws + WS_WMGU + l * SZ_WMGU + (size_t)e * 2 * FE * D * (f8 ? 1 : 2); return tr_make(r % 704, PA.in[9] + ((size_t)l * NE + e) * D * 2 * FE, 2 * FE, D, 0, FE, d, 0, 1, nullptr, f8, D); } r -= 5632;
    if (r < 5632) { const int e = r / 704; unsigned char* d = ws + WS_WMGU + l * SZ_WMGU + (size_t)e * 2 * FE * D * (f8 ? 1 : 2); return tr_make(r % 704, PA.in[9] + ((size_t)l * NE + e) * D * 2 * FE, 2 * FE, D, FE, FE, d, 128, 1, nullptr, f8, D); } r -= 5632;
    { const int e = r / 704; unsigned char* d = ws + WS_WMDN + l * SZ_WMDN + (size_t)e * D * (f8 ? FE8 : FE * 2); return tr_make(r % 704, PA.in[10] + ((size_t)l * NE + e) * FE * D, D, FE, 0, D, d, 0, 0, nullptr, f8 ? 2 : 0, FE8); }
}
__device__ __forceinline__ int conv_batch_size(int b) { return b == 0 ? (IT_A - ((I8A1 & 1) ? 6144 : 0) - ((I8A4 & 1) ? 5632 : 0)) : b == 1 ? ((I8B4 & 1) ? 256 : 11520) : b == 2 ? (5632 + 8192 - ((I8A1 & 2) ? 6144 : 0)) : b == 3 ? (8448 + 256 + 5632) : ((I8B4 & 2) ? 0 : 11264); }
__device__ __forceinline__ TrItem conv_batch_item(const Params& PA, unsigned char* ws, int b, int r) {
    if (b == 0) { if (I8A1 & 1) r += 6144; if ((I8A4 & 1) && r >= 8192) r += 5632; return conv_item_A(PA, ws, 0, r); }
    if (b == 1) return conv_item_B(PA, ws, 0, r);
    if (b == 2) { if (r < 5632) return conv_item_B(PA, ws, 0, 11520 + r); return conv_item_A(PA, ws, 1, r - 5632 + ((I8A1 & 2) ? 6144 : 0)); }
    if (b == 3) { if (r < 8448) return conv_item_A(PA, ws, 1, 8192 + r); if (r < 8448 + 256) return conv_item_B(PA, ws, 1, r - 8448); return conv_item_B(PA, ws, 1, 11520 + (r - 8448 - 256)); }
    return conv_item_B(PA, ws, 1, 256 + r);
}
__device__ __forceinline__ void tr_load(const TrItem& t, f32x4 (&v)[16], int lane) {
#pragma unroll
    for (int it = 0; it < 16; ++it) { const int kk = it * 4 + (lane >> 4), cc = (lane & 15) * 4; v[it] = *(const f32x4*)(t.src + (size_t)kk * t.srcld + cc); }
}
__device__ __forceinline__ void tr_process(const TrItem& t, const f32x4 (&v)[16], LAS float* scr, int lane) {
    const int c = lane & 7;
    f32x4 k0 = (f32x4){1.f, 1.f, 1.f, 1.f}, k1 = k0; if (t.ks) { k0 = *(const f32x4*)(t.ks + 8 * c); k1 = *(const f32x4*)(t.ks + 8 * c + 4); }
    if (t.f8) { k0 = k0 * 32.0f; k1 = k1 * 32.0f; }
#pragma unroll
    for (int it = 0; it < 16; ++it) { const int kk = it * 4 + (lane >> 4), cc = (lane & 15) * 4;
        LAS float* p = scr + kk * 65 + cc; p[0] = v[it][0]; p[1] = v[it][1]; p[2] = v[it][2]; p[3] = v[it][3]; }
    LDS_WAIT(); asm volatile("" ::: "memory");
    if (t.f8 == 0) {
#pragma unroll
        for (int it = 0; it < 8; ++it) { const int n = it * 8 + (lane >> 3); const LAS float* s = scr + (8 * c) * 65 + n;
            u32x4 o; o.x = cvt_pk_bf16(s[0] * k0[0], s[65] * k0[1]); o.y = cvt_pk_bf16(s[2 * 65] * k0[2], s[3 * 65] * k0[3]); o.z = cvt_pk_bf16(s[4 * 65] * k1[0], s[5 * 65] * k1[1]); o.w = cvt_pk_bf16(s[6 * 65] * k1[2], s[7 * 65] * k1[3]);
            *(u32x4*)(t.dst + (size_t)n * t.dstpitch + 16 * c) = o; }
    } else {
#pragma unroll
        for (int it = 0; it < 8; ++it) { const int n = it * 8 + (lane >> 3); const LAS float* s = scr + (8 * c) * 65 + n;
            int w0 = 0, w1 = 0;
            w0 = __builtin_amdgcn_cvt_pk_fp8_f32(s[0] * k0[0], s[65] * k0[1], w0, false); w0 = __builtin_amdgcn_cvt_pk_fp8_f32(s[2 * 65] * k0[2], s[3 * 65] * k0[3], w0, true);
            w1 = __builtin_amdgcn_cvt_pk_fp8_f32(s[4 * 65] * k1[0], s[5 * 65] * k1[1], w1, false); w1 = __builtin_amdgcn_cvt_pk_fp8_f32(s[6 * 65] * k1[2], s[7 * 65] * k1[3], w1, true);
            u32x2 o; o.x = (unsigned)w0; o.y = (unsigned)w1;
            *(u32x2*)(t.dst + (size_t)n * t.dstpitch + 8 * c) = o;
            if (t.f8 == 2) *(u32x4*)(t.dst + (size_t)n * t.dstpitch + 64 + 16 * c) = (u32x4){0u, 0u, 0u, 0u}; }
    }
    LDS_WAIT(); asm volatile("" ::: "memory");
}
__device__ __forceinline__ void conv_queue(Frame& F_, const Params& PA, int b) {
    Frame F = F_; { int t_ = mk_tid(F_.wv); asm volatile("" : "+v"(t_)); F.tid = t_; F.lane = t_ & 63; F.wave = __builtin_amdgcn_readfirstlane(t_ >> 6); }
    LAS float* scr = (LAS float*)(F.lds + F.wave * 16640);
    unsigned* qb = (unsigned*)(F.ws + WS_CTL) + CW_Q + 512 * b; const int n = conv_batch_size(b), per = n / 8;
    for (int k = 0; k < 8; ++k) {
        const int sq = (F.bid + k) & 7; unsigned* q = qb + 64 * sq;
        for (;;) {
            unsigned r = 0; if (F.lane == 0) r = __hip_atomic_fetch_add(q, 4u, __ATOMIC_RELAXED, __HIP_MEMORY_SCOPE_AGENT);
            r = (unsigned)__builtin_amdgcn_readfirstlane((int)r);
            if (r >= (unsigned)per) break;
            const int base = sq * per + (int)r;
            f32x4 va[16], vb[16];
            TrItem ta = conv_batch_item(PA, F.ws, b, base), tb = conv_batch_item(PA, F.ws, b, base + 1);
            tr_load(ta, va, F.lane); tr_load(tb, vb, F.lane);
            tr_process(ta, va, scr, F.lane); ta = conv_batch_item(PA, F.ws, b, base + 2); tr_load(ta, va, F.lane);
            tr_process(tb, vb, scr, F.lane); tb = conv_batch_item(PA, F.ws, b, base + 3); tr_load(tb, vb, F.lane);
            tr_process(ta, va, scr, F.lane);
            tr_process(tb, vb, scr, F.lane);
        }
    }
}
__device__ __forceinline__ int pack_i8x4(f32x4 v) {
    const int a = (int)rintf(v[0]), b = (int)rintf(v[1]), c = (int)rintf(v[2]), d = (int)rintf(v[3]);
    return (a & 0xff) | ((b & 0xff) << 8) | ((c & 0xff) << 16) | (d << 24);
}
__device__ __forceinline__ float wave_max(float v) {
#pragma unroll
    for (int o = 1; o < 64; o <<= 1) v = fmaxf(v, __shfl_xor(v, o));
    return v;
}
struct StripJob { const float* src; const float* ks; unsigned char* dst; float* sw; int srcld; };
__device__ __forceinline__ StripJob strip_make(const Params& PA, unsigned char* ws, int l, int st) {
    StripJob J;
    if (st < 384) { const int c0 = st * 32; J.srcld = 12288; J.src = PA.in[1] + (size_t)l * D * 12288 + c0; J.ks = PA.in[11] + (size_t)(2 * l) * D;
        J.dst = c0 < 4096 ? ws + WS_WQKG + l * SZ_WQKG + (size_t)c0 * D : (c0 < 8192 ? ws + WS_WVT + l * SZ_WVT + (size_t)(c0 - 4096) * D : ws + WS_WQKG + l * SZ_WQKG + (size_t)(c0 - 4096) * D);
        J.sw = c0 < 4096 ? (float*)(ws + WS_SWQ + l * SZ_SWL) + c0 : (c0 < 8192 ? (float*)(ws + WS_SWV + l * SZ_SWL) + (c0 - 4096) : (float*)(ws + WS_SWQ + l * SZ_SWL) + (c0 - 4096));
    } else if (st < 736) { const int s4 = st - 384, part = s4 / 176, j0 = (s4 % 176) * 32, drow = 256 * (j0 >> 7) + (j0 & 127) + 128 * part; J.srcld = 2 * FF;
        J.src = PA.in[6] + (size_t)l * D * 2 * FF + part * FF + j0; J.ks = PA.in[12] + (size_t)(2 * l) * D; J.dst = ws + WS_WGU + l * SZ_WGU + (size_t)drow * D; J.sw = (float*)(ws + WS_SWGU + l * SZ_SWL) + drow;
    } else { const int sm = st - 736, e = sm / 88, s4 = sm % 88, part = s4 / 44, j0 = (s4 % 44) * 32, drow = 256 * (j0 >> 7) + (j0 & 127) + 128 * part; J.srcld = 2 * FE;
        J.src = PA.in[9] + ((size_t)l * NE + e) * D * 2 * FE + part * FE + j0; J.ks = nullptr; J.dst = ws + WS_WMGU + l * SZ_WMGU + (size_t)e * 2 * FE * D + (size_t)drow * D; J.sw = (float*)(ws + WS_SWM) + (l * NE + e) * 2 * FE + drow; }
    return J;
}
template <bool DYN>
__device__ __forceinline__ void strip_loop(Frame& F_, const Params& PA, int l, int first, int end, int step, int base, int qi) {
    Frame F = F_; { int t_ = mk_tid(F_.wv); asm volatile("" : "+v"(t_)); F.tid = t_; F.lane = t_ & 63; F.wave = __builtin_amdgcn_readfirstlane(t_ >> 6); }
    constexpr int PITCH = 4104;
    LAS unsigned char* T = F.lds;
    LAS float* smax = (LAS float*)(F.lds + MISC_OFF + 1024);
    LAS float* cfin = smax + 256;
    volatile LAS unsigned* slot = (volatile LAS unsigned*)(F.lds + MISC_OFF + 512);
    unsigned* q = (unsigned*)(F.ws + WS_CTL) + CW_Q + 512 * 5 + 64 * qi;
    const int lane = F.lane, cq = lane & 7, r8 = lane >> 3;
    int st = first;
    if (DYN) { if (F.tid == 0) slot[0] = __hip_atomic_fetch_add(q, 1u, __ATOMIC_RELAXED, __HIP_MEMORY_SCOPE_AGENT);
        __syncthreads(); st = (int)slot[0]; __syncthreads(); }
    if (st >= end) return;
    StripJob J = strip_make(PA, F.ws, l, base + st);
    u32x4 va[16], vb[16]; float gq[4];
#define W8_ISSUE(JJ, LIVE) do { const __amdgpu_buffer_rsrc_t rs_ = __builtin_amdgcn_make_buffer_rsrc((void*)(JJ).src, 0, (LIVE) ? (D - 1) * (JJ).srcld * 4 + 128 : 0, 0x00020000);     \
        const int voff_ = (r8 * (JJ).srcld + 4 * cq) * 4, sbase_ = F.wave * 256 * (JJ).srcld * 4, sstep_ = 8 * (JJ).srcld * 4; \
        { const float* ksp_ = (JJ).ks ? (JJ).ks : PA.in[11]; const float one_ = (JJ).ks ? 0.0f : 1.0f, keep_ = (JJ).ks ? 1.0f : 0.0f;     \
          _Pragma("unroll") for (int t = 0; t < 4; ++t) gq[t] = ksp_[F.wave * 256 + t * 64 + lane] * keep_ + one_; } \
        _Pragma("unroll") for (int it = 0; it < 16; ++it) va[it] = __builtin_amdgcn_raw_buffer_load_b128(rs_, voff_, sbase_ + it * sstep_, 0); \
        _Pragma("unroll") for (int it = 0; it < 16; ++it) vb[it] = __builtin_amdgcn_raw_buffer_load_b128(rs_, voff_, sbase_ + (16 + it) * sstep_, 0); } while (0)
    W8_ISSUE(J, true);
    for (;;) {
        f32x4 cm = (f32x4){0.f, 0.f, 0.f, 0.f};
#pragma unroll
        for (int ch = 0; ch < 2; ++ch)
#pragma unroll
            for (int it = 0; it < 16; ++it) { const int j = ch * 16 + it, kk = F.wave * 256 + j * 8 + r8;
                const float g = __shfl(gq[j >> 3], (j & 7) * 8 + r8);
                const f32x4 w = __builtin_bit_cast(f32x4, ch ? vb[it] : va[it]) * g;
                cm[0] = fmaxf(cm[0], fabsf(w[0])); cm[1] = fmaxf(cm[1], fabsf(w[1])); cm[2] = fmaxf(cm[2], fabsf(w[2])); cm[3] = fmaxf(cm[3], fabsf(w[3]));
                const unsigned p01 = cvt_pk_bf16(w[0], w[1]), p23 = cvt_pk_bf16(w[2], w[3]);
                LAS unsigned short* p = (LAS unsigned short*)(T + (4 * cq) * PITCH + kk * 2);
                p[0] = (unsigned short)p01; p[PITCH / 2] = (unsigned short)(p01 >> 16); p[PITCH] = (unsigned short)p23; p[3 * PITCH / 2] = (unsigned short)(p23 >> 16); }
        if (DYN) { if (F.tid == 0) slot[0] = __hip_atomic_fetch_add(q, 1u, __ATOMIC_RELAXED, __HIP_MEMORY_SCOPE_AGENT); }
#pragma unroll
        for (int j = 0; j < 4; ++j) { cm[j] = fmaxf(cm[j], __shfl_xor(cm[j], 8)); cm[j] = fmaxf(cm[j], __shfl_xor(cm[j], 16)); cm[j] = fmaxf(cm[j], __shfl_xor(cm[j], 32)); }
        if (lane < 8) { LAS float* p = smax + F.wave * 32 + lane * 4; p[0] = cm[0]; p[1] = cm[1]; p[2] = cm[2]; p[3] = cm[3]; }
        LDS_WAIT(); __syncthreads();
        const int nx = DYN ? (int)slot[0] : st + step;
        const bool has = nx < end;
        const StripJob Jn = strip_make(PA, F.ws, l, base + (has ? nx : st));
        W8_ISSUE(Jn, has);
        if (F.tid < 32) { float m = 1e-30f;
#pragma unroll
            for (int w = 0; w < 8; ++w) m = fmaxf(m, smax[w * 32 + F.tid]);
            cfin[F.tid] = m; J.sw[F.tid] = m * (1.0f / 127.0f); }
        LDS_WAIT(); __syncthreads();
#pragma unroll
        for (int rr = 0; rr < 4; ++rr) { const int c = F.wave * 4 + rr; const float qs = 127.0f / cfin[c];
#pragma unroll
            for (int i = 0; i < 4; ++i) { const int k0 = (i * 64 + lane) * 8;
                const u32x2 a = *(const LAS u32x2*)(T + c * PITCH + k0 * 2), b = *(const LAS u32x2*)(T + c * PITCH + k0 * 2 + 8);
                u32x2 o; o.x = (unsigned)pack_i8x4(bf4(a) * qs); o.y = (unsigned)pack_i8x4(bf4(b) * qs);
                *(u32x2*)(J.dst + (size_t)c * D + k0) = o; } }
        LDS_WAIT(); __syncthreads();
        if (!has) break;
        J = Jn; st = nx;
    }
#undef W8_ISSUE
}
__device__ __forceinline__ void p0_prologue(Frame& F_, const Params& PA) {
    Frame F = F_; { int t_ = mk_tid(F_.wv); asm volatile("" : "+v"(t_)); F.tid = t_; F.lane = t_ & 63; F.wave = __builtin_amdgcn_readfirstlane(t_ >> 6); }
    unsigned char* ws = F.ws;
    const int gw = F.bid * 8 + F.wave, NGW = F.G * 8;
    {
        const int n1 = (I8A1 & 1) ? 384 : 0, n4 = (I8A4 & 1) ? 352 : 0;
        if (n1 + n4 > 0) strip_loop<false>(F_, PA, 0, F.bid, n1 + n4, F.G, (I8A1 & 1) ? 0 : 384, 0);
    }
    conv_queue(F_, PA, 0);
    bf16_t* X = (bf16_t*)(ws + WS_X); bf16_t* XB = (bf16_t*)(ws + WS_XB);
    for (int row = gw; row < NT; row += NGW) {
        const f32x4* xr = (const f32x4*)(PA.in[0] + (size_t)row * D) + F.lane; f32x4 v[8]; float s = 0.f;
#pragma unroll
        for (int j = 0; j < 8; ++j) { v[j] = xr[64 * j]; s += (v[j][0] * v[j][0] + v[j][1] * v[j][1]) + (v[j][2] * v[j][2] + v[j][3] * v[j][3]); }
        const float inv = 1.0f / sqrtf(wave_sum(s) * (1.0f / D) + EPS);
        if (I8A1 & 1) {
            float mx = 0.f;
#pragma unroll
            for (int j = 0; j < 8; ++j) mx = fmaxf(mx, fmaxf(fmaxf(fabsf(v[j][0]), fabsf(v[j][1])), fmaxf(fabsf(v[j][2]), fabsf(v[j][3]))));
            mx = fmaxf(wave_max(mx) * inv, 1e-20f); const float q = inv * 127.0f / mx;
#pragma unroll
            for (int j = 0; j < 8; ++j) { { u32x2 w; w.x = cvt_pk_bf16(v[j][0], v[j][1]); w.y = cvt_pk_bf16(v[j][2], v[j][3]); ((u32x2*)(X + (size_t)row * D) + F.lane)[64 * j] = w; }
                ((int*)((unsigned char*)XB + (size_t)row * D) + F.lane)[64 * j] = pack_i8x4(v[j] * q); }
            if (F.lane == 0) ((float*)(ws + WS_SA))[row] = mx * (1.0f / 127.0f);
        } else
#pragma unroll
        for (int j = 0; j < 8; ++j) { { u32x2 w; w.x = cvt_pk_bf16(v[j][0], v[j][1]); w.y = cvt_pk_bf16(v[j][2], v[j][3]); ((u32x2*)(X + (size_t)row * D) + F.lane)[64 * j] = w; }
            u32x2 w; w.x = cvt_pk_bf16(v[j][0] * inv, v[j][1] * inv); w.y = cvt_pk_bf16(v[j][2] * inv, v[j][3] * inv); ((u32x2*)(XB + (size_t)row * D) + F.lane)[64 * j] = w; }
    }
    float* COS = (float*)(ws + WS_COS); float* SIN = (float*)(ws + WS_SIN);
    for (int i = F.bid * 512 + F.tid; i < SEQ * 128; i += F.G * 512) { const int pos = i >> 7, p = i & 127;
        const float t = (float)p / 127.0f; const float fr = 1.0f / powf(10000.0f, t); const float ang = (float)pos * fr;
        COS[i] = (float)cos((double)ang); SIN[i] = (float)sin((double)ang); }
    if (F.bid == 0) { float* DQ = (float*)(ws + WS_DQ); float* DKS = (float*)(ws + WS_DKS);
        for (int i = F.tid; i < NH * 128; i += 512) { const int h = i >> 7, j = i & 127; const double lg = log1p(-exp2(-5.0 - (double)h));
            DQ[i] = (float)exp((double)j * lg); DKS[i] = (float)(exp(-(double)j * lg) * 0.0625);
            ((float*)(ws + WS_DQ8))[i] = (float)exp((double)(j - 64) * lg); ((float*)(ws + WS_DKS8))[i] = (float)(exp((double)(64 - j) * lg) * 0.0625); if (j == 0) ((float*)(ws + WS_LG2))[h] = (float)(lg * 1.4426950408889634); } }
}

__device__ __forceinline__ void retention_phase(Frame& F, const bf16_t* QB, const bf16_t* KB, const bf16_t* VT, const bf16_t* GB, const float* normg, bf16_t* OG, const int og8) {
    using namespace pg8;
    LAS unsigned char* lds = F.lds;
    int tid = mk_tid(F.wv); asm volatile("" : "+v"(tid));
    const int wid = __builtin_amdgcn_readfirstlane(tid >> 6), lane = tid & 63, wr = wid >> 2, wc = wid & 3;
    unsigned voffQ[2], voffV[2];
#pragma unroll
    for (int i = 0; i < 2; ++i) { int R, C; stage_rc(tid * 16 + i * 8192, R, C); const int Rb = (R & ~31) + perm32(R & 31);
        voffQ[i] = (unsigned)(R * QKW + C) * 2u; voffV[i] = (unsigned)(Rb * NT + C) * 2u; }
    const unsigned ldsw = (unsigned)wid * 1024u;
    const int aoff = lds_byte(wr * 64 + (lane & 15), (lane >> 4) * 8), boff = lds_byte(wc * 32 + (lane & 15), (lane >> 4) * 8);
    constexpr int PIMG = 6 * HTB;
    LAS float* red = (LAS float*)(lds + MISC_OFF + 256);
    const __amdgpu_buffer_rsrc_t rsQ = __builtin_amdgcn_make_buffer_rsrc((void*)QB, 0, NT * QKW * 2, 0x00020000);
    const __amdgpu_buffer_rsrc_t rsK = __builtin_amdgcn_make_buffer_rsrc((void*)KB, 0, NT * QKW * 2, 0x00020000);
    const __amdgpu_buffer_rsrc_t rsV = __builtin_amdgcn_make_buffer_rsrc((void*)VT, 0, VW * NT * 2, 0x00020000);
#define RT_STAGE(bufoff, rsrc, soff, voff) do { _Pragma("unroll") for (int _i = 0; _i < 2; ++_i) \
        __builtin_amdgcn_raw_ptr_buffer_load_lds((rsrc), (LAS unsigned*)(lds + (bufoff) + ldsw + _i * 8192), 16, (voff)[_i], (soff), 0, 0); } while (0)
#define RT_BAR __builtin_amdgcn_s_barrier()
    for (int it = F.bid; it < 256; it += F.G) {
        const int item = (it & 7) * 32 + (it >> 3);
        const int b = item >> 6, h = (item >> 3) & 7, x = item & 7;
        const float lg2 = ((const float*)(F.ws + WS_LG2))[h];
        const int koff = (b * SEQ * QKW + h * DK) * 2, voff0 = (h * DV * NT + b * SEQ) * 2;
        for (int qs = 0; qs < 2; ++qs) {
            const int qc = qs == 0 ? 15 - x : x, nkv = qc + 1, total = 8 * nkv;
            const int qoff = ((b * SEQ + qc * 128) * QKW + h * DK) * 2;
            f32x4 O[4][4][2], P[4][2];
#pragma unroll
            for (int c = 0; c < 4; ++c)
#pragma unroll
                for (int m = 0; m < 4; ++m)
#pragma unroll
                    for (int n = 0; n < 2; ++n) O[c][m][n] = (f32x4){0.f, 0.f, 0.f, 0.f};
#define RT_STAGE_STEP(sv) do { const int _s = (sv); const int _kt = _s >> 3, _sub = _s & 7, _bo = (_s % 3) * 2 * HTB; \
                if (_sub < 4) { RT_STAGE(_bo, rsQ, qoff + _sub * 128, voffQ); RT_STAGE(_bo + HTB, rsK, koff + _kt * (128 * QKW * 2) + _sub * 128, voffQ); } \
                else { const int _vo = voff0 + (_sub - 4) * (128 * NT * 2) + _kt * 256; RT_STAGE(_bo, rsV, _vo, voffV); RT_STAGE(_bo + HTB, rsV, _vo + 128, voffV); } } while (0)
            RT_STAGE_STEP(0); RT_STAGE_STEP(1);
            asm volatile("s_waitcnt vmcnt(4)" ::: "memory"); RT_BAR;
            int s = 0;
            for (int kt = 0; kt < nkv; ++kt) {
                const float tscale = __builtin_amdgcn_exp2f((float)(128 * (qc - kt)) * lg2);
                const bool diag = (kt == qc);
#pragma unroll
                for (int sub = 0; sub < 8; ++sub, ++s) {
                    __builtin_amdgcn_sched_barrier(0);
                    if (s + 2 < total) RT_STAGE_STEP(s + 2);
                    const int bo = (s % 3) * 2 * HTB;
                    if (sub < 4) {
                        if (sub == 0) {
#pragma unroll
                            for (int m = 0; m < 4; ++m)
#pragma unroll
                                for (int n = 0; n < 2; ++n) P[m][n] = (f32x4){0.f, 0.f, 0.f, 0.f};
                        }
                        bf16x8 Bt[2][2];
#pragma unroll
                        for (int n = 0; n < 2; ++n)
#pragma unroll
                            for (int k = 0; k < 2; ++k) Bt[n][k] = *(const LAS bf16x8*)(lds + bo + HTB + boff + n * 2048 + k * 1024);
#pragma unroll
                        for (int mh = 0; mh < 2; ++mh) {
                            bf16x8 At[2][2];
#pragma unroll
                            for (int m = 0; m < 2; ++m)
#pragma unroll
                                for (int k = 0; k < 2; ++k) At[m][k] = *(const LAS bf16x8*)(lds + bo + aoff + (mh * 2 + m) * 2048 + k * 1024);
#pragma unroll
                            for (int m = 0; m < 2; ++m)
#pragma unroll
                                for (int n = 0; n < 2; ++n)
#pragma unroll
                                    for (int k = 0; k < 2; ++k) P[mh * 2 + m][n] = __builtin_amdgcn_mfma_f32_16x16x32_bf16(Bt[n][k], At[m][k], P[mh * 2 + m][n], 0, 0, 0);
                            __builtin_amdgcn_sched_barrier(0);
                        }
                        if (sub == 3) {
                            int ln = lane; asm volatile("" : "+v"(ln)); const int fr = ln & 15, fq = ln >> 4;
#pragma unroll
                            for (int m = 0; m < 4; ++m) { const int i = wr * 64 + m * 16 + fr;
#pragma unroll
                                for (int n = 0; n < 2; ++n) { const int j0 = wc * 32 + n * 16 + fq * 4; f32x4 v = P[m][n] * tscale;
                                    if (diag) { int dd = i - j0; asm volatile("" : "+v"(dd));
#pragma unroll
                                        for (int e = 0; e < 4; ++e) v[e] = (e > dd) ? 0.f : v[e]; }
                                    u32x2 w; w.x = cvt_pk_bf16(v[0], v[1]); w.y = cvt_pk_bf16(v[2], v[3]);
                                    *(LAS u32x2*)(lds + PIMG + (wc >> 1) * HTB + lds_byte(i, (wc & 1) * 32 + n * 16 + fq * 4)) = w; } }
                        }
                    } else {
#pragma unroll
                        for (int k2 = 0; k2 < 2; ++k2) {
                            bf16x8 Bt[2][2];
#pragma unroll
                            for (int n = 0; n < 2; ++n)
#pragma unroll
                                for (int k = 0; k < 2; ++k) Bt[n][k] = *(const LAS bf16x8*)(lds + bo + k2 * HTB + boff + n * 2048 + k * 1024);
#pragma unroll
                            for (int mh = 0; mh < 2; ++mh) {
                                bf16x8 At[2][2];
#pragma unroll
                                for (int m = 0; m < 2; ++m)
#pragma unroll
                                    for (int k = 0; k < 2; ++k) At[m][k] = *(const LAS bf16x8*)(lds + PIMG + k2 * HTB + aoff + (mh * 2 + m) * 2048 + k * 1024);
#pragma unroll
                                for (int m = 0; m < 2; ++m)
#pragma unroll
                                    for (int n = 0; n < 2; ++n)
#pragma unroll
                                        for (int k = 0; k < 2; ++k) O[sub - 4][mh * 2 + m][n] = __builtin_amdgcn_mfma_f32_16x16x32_bf16(Bt[n][k], At[m][k], O[sub - 4][mh * 2 + m][n], 0, 0, 0);
                                __builtin_amdgcn_sched_barrier(0);
                            }
                        }
                    }
                    if (s + 2 < total) asm volatile("s_waitcnt vmcnt(4) lgkmcnt(0)" ::: "memory"); else asm volatile("s_waitcnt vmcnt(0) lgkmcnt(0)" ::: "memory");
                    RT_BAR;
                }
            }
            int ln = lane; asm volatile("" : "+v"(ln)); const int fr = ln & 15, fq = ln >> 4;
#pragma unroll
            for (int m = 0; m < 4; ++m) { float ss = 0.f;
#pragma unroll
                for (int c = 0; c < 4; ++c)
#pragma unroll
                    for (int n = 0; n < 2; ++n) { const f32x4 o = O[c][m][n]; ss += (o[0] * o[0] + o[1] * o[1]) + (o[2] * o[2] + o[3] * o[3]); }
                ss += __shfl_xor(ss, 16); ss += __shfl_xor(ss, 32);
                if (fq == 0) red[(wr * 64 + m * 16 + fr) * 4 + wc] = ss; }
            LDS_WAIT(); RT_BAR;
#pragma unroll
            for (int m = 0; m < 4; ++m) { const int i = wr * 64 + m * 16 + fr; const f32x4 pr = *(const LAS f32x4*)(red + i * 4);
                const float inv = __builtin_amdgcn_rsqf(((pr[0] + pr[1]) + (pr[2] + pr[3])) * (1.0f / DV) + EPS);
                const size_t tok = (size_t)b * SEQ + (size_t)qc * 128 + i;
#pragma unroll
                for (int c = 0; c < 4; ++c) { const int col = h * DV + c * 128 + wc * 32 + fq * 8;
                    const u32x4 gw = *(const u32x4*)(GB + tok * VW + col); const f32x4 n0 = *(const f32x4*)(normg + col), n1 = *(const f32x4*)(normg + col + 4);
                    const f32x4 o0 = O[c][m][0] * inv * n0, o1 = O[c][m][1] * inv * n1;
                    float gv[8] = {bf_lo(gw.x), bf_hi(gw.x), bf_lo(gw.y), bf_hi(gw.y), bf_lo(gw.z), bf_hi(gw.z), bf_lo(gw.w), bf_hi(gw.w)};
                    float r[8];
#pragma unroll
                    for (int e = 0; e < 4; ++e) { r[e] = o0[e] * gv[e] * fast_sigmoid(gv[e]); r[4 + e] = o1[e] * gv[4 + e] * fast_sigmoid(gv[4 + e]); }
                    if (og8) { int w0 = 0, w1 = 0; w0 = __builtin_amdgcn_cvt_pk_fp8_f32(r[0], r[1], w0, false); w0 = __builtin_amdgcn_cvt_pk_fp8_f32(r[2], r[3], w0, true);
                        w1 = __builtin_amdgcn_cvt_pk_fp8_f32(r[4], r[5], w1, false); w1 = __builtin_amdgcn_cvt_pk_fp8_f32(r[6], r[7], w1, true); u32x2 w; w.x = (unsigned)w0; w.y = (unsigned)w1;
                        *(u32x2*)((unsigned char*)OG + tok * VW + col) = w; }
                    else { u32x4 w; w.x = cvt_pk_bf16(r[0], r[1]); w.y = cvt_pk_bf16(r[2], r[3]); w.z = cvt_pk_bf16(r[4], r[5]); w.w = cvt_pk_bf16(r[6], r[7]);
                        *(u32x4*)(OG + tok * VW + col) = w; } } }
            VM_WAIT(); RT_BAR;
        }
    }
#undef RT_STAGE
#undef RT_STAGE_STEP
#undef RT_BAR
}

__device__ __forceinline__ void mfma8(f32x4& c, const i32x8& a, const i32x8& b, int sc) { asm volatile("v_mfma_scale_f32_16x16x128_f8f6f4 %0, %1, %2, %0, %3, %3 op_sel_hi:[0,0,0]" : "+v"(c) : "v"(a), "v"(b), "v"(sc)); }
__device__ __forceinline__ void retention8_phase(Frame& F, const unsigned char* Q8, const unsigned char* K8, const unsigned char* VT8, const bf16_t* GB, const float* normg, bf16_t* OG, const int og8) {
    using namespace pg8;
    LAS unsigned char* lds = F.lds;
    int tid = mk_tid(F.wv); asm volatile("" : "+v"(tid));
    const int wid = __builtin_amdgcn_readfirstlane(tid >> 6), lane = tid & 63, wr = wid >> 2, wc = wid & 3;
    unsigned voffQ[2], voffV[2];
#pragma unroll
    for (int i = 0; i < 2; ++i) { int R, C; stage_rc(tid * 16 + i * 8192, R, C); const int Rb = (R & ~31) + perm32(R & 31);
        voffQ[i] = (unsigned)(R * QKW + C * 2); voffV[i] = (unsigned)(Rb * NT + C * 2); }
    const unsigned ldsw = (unsigned)wid * 1024u;
    const int aoff = lds_byte(wr * 64 + (lane & 15), (lane >> 4) * 8), boff = lds_byte(wc * 32 + (lane & 15), (lane >> 4) * 8);
    constexpr int PIMG = 6 * HTB;
    LAS float* red = (LAS float*)(lds + MISC_OFF + 256);
    int f8scale = 0x7f7f7f7f; asm volatile("" : "+v"(f8scale));
    const __amdgpu_buffer_rsrc_t rsQ = __builtin_amdgcn_make_buffer_rsrc((void*)Q8, 0, NT * QKW, 0x00020000);
    const __amdgpu_buffer_rsrc_t rsK = __builtin_amdgcn_make_buffer_rsrc((void*)K8, 0, NT * QKW, 0x00020000);
    const __amdgpu_buffer_rsrc_t rsV = __builtin_amdgcn_make_buffer_rsrc((void*)VT8, 0, VW * NT, 0x00020000);
#define RT_STAGE(bufoff, rsrc, soff, voff) do { _Pragma("unroll") for (int _i = 0; _i < 2; ++_i) \
        __builtin_amdgcn_raw_ptr_buffer_load_lds((rsrc), (LAS unsigned*)(lds + (bufoff) + ldsw + _i * 8192), 16, (voff)[_i], (soff), 0, 0); } while (0)
#define RT_BAR __builtin_amdgcn_s_barrier()
#define RT_LD16(off) (*(const LAS i32x4*)(lds + (off)))
    for (int it = F.bid; it < 256; it += F.G) {
        const int item = (it & 7) * 32 + (it >> 3);
        const int b = item >> 6, h = (item >> 3) & 7, x = item & 7;
        const float lg2 = ((const float*)(F.ws + WS_LG2))[h];
        const int koff = b * SEQ * QKW + h * DK, voff0 = h * DV * NT + b * SEQ;
        for (int qs = 0; qs < 2; ++qs) {
            const int qc = qs == 0 ? 15 - x : x, nkv = qc + 1, total = 4 * nkv;
            const int qoff = (b * SEQ + qc * 128) * QKW + h * DK;
            f32x4 O[4][4][2], P[4][2]; i32x8 Apf[4];
#pragma unroll
            for (int c = 0; c < 4; ++c)
#pragma unroll
                for (int m = 0; m < 4; ++m)
#pragma unroll
                    for (int n = 0; n < 2; ++n) O[c][m][n] = (f32x4){0.f, 0.f, 0.f, 0.f};
#define RT_STAGE_STEP(sv) do { const int _s = (sv); const int _kt = _s >> 2, _sub = _s & 3, _bo = (_s % 3) * 2 * HTB; \
                if (_sub < 2) { RT_STAGE(_bo, rsQ, qoff + _sub * 128, voffQ); RT_STAGE(_bo + HTB, rsK, koff + _kt * (128 * QKW) + _sub * 128, voffQ); } \
                else { const int _vo = voff0 + (_sub - 2) * (256 * NT) + _kt * 128; RT_STAGE(_bo, rsV, _vo, voffV); RT_STAGE(_bo + HTB, rsV, _vo + 128 * NT, voffV); } } while (0)
            RT_STAGE_STEP(0); RT_STAGE_STEP(1);
            asm volatile("s_waitcnt vmcnt(4)" ::: "memory"); RT_BAR;
            int s = 0;
            for (int kt = 0; kt < nkv; ++kt) {
                const float tscale = __builtin_amdgcn_exp2f((float)(128 * (qc - kt)) * lg2);
                const bool diag = (kt == qc);
#pragma unroll
                for (int sub = 0; sub < 4; ++sub, ++s) {
                    __builtin_amdgcn_sched_barrier(0);
                    if (s + 2 < total) RT_STAGE_STEP(s + 2);
                    const int bo = (s % 3) * 2 * HTB;
                    if (sub < 2) {
                        if (sub == 0) {
#pragma unroll
                            for (int m = 0; m < 4; ++m)
#pragma unroll
                                for (int n = 0; n < 2; ++n) P[m][n] = (f32x4){0.f, 0.f, 0.f, 0.f};
                        }
                        i32x8 Bt[2], At[4];
#pragma unroll
                        for (int n = 0; n < 2; ++n) { Bt[n].lo = RT_LD16(bo + HTB + boff + n * 2048); Bt[n].hi = RT_LD16(bo + HTB + boff + n * 2048 + 1024); }
#pragma unroll
                        for (int m = 0; m < 4; ++m) { At[m].lo = RT_LD16(bo + aoff + m * 2048); At[m].hi = RT_LD16(bo + aoff + m * 2048 + 1024); }
#pragma unroll
                        for (int m = 0; m < 4; ++m)
#pragma unroll
                            for (int n = 0; n < 2; ++n) mfma8(P[m][n], Bt[n], At[m], f8scale);
                        __builtin_amdgcn_sched_barrier(0);
                        if (sub == 1) {
                            asm volatile("s_nop 15\n\ts_nop 7" ::: "memory"); __builtin_amdgcn_sched_barrier(0);
                            int ln = lane; asm volatile("" : "+v"(ln)); const int fr = ln & 15, fq = ln >> 4;
#pragma unroll
                            for (int m = 0; m < 4; ++m) { const int i = wr * 64 + m * 16 + fr;
#pragma unroll
                                for (int n = 0; n < 2; ++n) { const int j0 = wc * 32 + n * 16 + fq * 4; f32x4 v = P[m][n] * tscale;
                                    if (diag) { int dd = i - j0; asm volatile("" : "+v"(dd));
#pragma unroll
                                        for (int e = 0; e < 4; ++e) v[e] = (e > dd) ? 0.f : v[e]; }
                                    int w = 0; w = __builtin_amdgcn_cvt_pk_fp8_f32(v[0], v[1], w, false); w = __builtin_amdgcn_cvt_pk_fp8_f32(v[2], v[3], w, true);
                                    *(LAS int*)(lds + PIMG + lds_byte(i, j0 >> 1)) = w; } }
                        }
                    } else {
                        if (sub == 2) {
#pragma unroll
                            for (int m = 0; m < 4; ++m) { Apf[m].lo = RT_LD16(PIMG + aoff + m * 2048); Apf[m].hi = RT_LD16(PIMG + aoff + m * 2048 + 1024); }
                        }
#pragma unroll
                        for (int ch = 0; ch < 2; ++ch) {
                            i32x8 Bv[2];
#pragma unroll
                            for (int n = 0; n < 2; ++n) { Bv[n].lo = RT_LD16(bo + ch * HTB + boff + n * 2048); Bv[n].hi = RT_LD16(bo + ch * HTB + boff + n * 2048 + 1024); }
#pragma unroll
                            for (int m = 0; m < 4; ++m)
#pragma unroll
                                for (int n = 0; n < 2; ++n) mfma8(O[(sub - 2) * 2 + ch][m][n], Bv[n], Apf[m], f8scale);
                            __builtin_amdgcn_sched_barrier(0);
                        }
                    }
                    if (s + 2 < total) asm volatile("s_waitcnt vmcnt(4) lgkmcnt(0)" ::: "memory"); else asm volatile("s_waitcnt vmcnt(0) lgkmcnt(0)" ::: "memory");
                    RT_BAR;
                }
            }
            asm volatile("s_nop 15\n\ts_nop 7" ::: "memory"); __builtin_amdgcn_sched_barrier(0);
            int ln = lane; asm volatile("" : "+v"(ln)); const int fr = ln & 15, fq = ln >> 4;
#pragma unroll
            for (int m = 0; m < 4; ++m) { float ss = 0.f;
#pragma unroll
                for (int c = 0; c < 4; ++c)
#pragma unroll
                    for (int n = 0; n < 2; ++n) { const f32x4 o = O[c][m][n]; ss += (o[0] * o[0] + o[1] * o[1]) + (o[2] * o[2] + o[3] * o[3]); }
                ss += __shfl_xor(ss, 16); ss += __shfl_xor(ss, 32);
                if (fq == 0) red[(wr * 64 + m * 16 + fr) * 4 + wc] = ss; }
            LDS_WAIT(); RT_BAR;
#pragma unroll
            for (int m = 0; m < 4; ++m) { const int i = wr * 64 + m * 16 + fr; const f32x4 pr = *(const LAS f32x4*)(red + i * 4);
                const float inv = __builtin_amdgcn_rsqf(((pr[0] + pr[1]) + (pr[2] + pr[3])) * (1.0f / DV) + EPS);
                const size_t tok = (size_t)b * SEQ + (size_t)qc * 128 + i;
#pragma unroll
                for (int c = 0; c < 4; ++c) { const int col = h * DV + c * 128 + wc * 32 + fq * 8;
                    const u32x4 gw = *(const u32x4*)(GB + tok * VW + col); const f32x4 n0 = *(const f32x4*)(normg + col), n1 = *(const f32x4*)(normg + col + 4);
                    const f32x4 o0 = O[c][m][0] * inv * n0, o1 = O[c][m][1] * inv * n1;
                    float gv[8] = {bf_lo(gw.x), bf_hi(gw.x), bf_lo(gw.y), bf_hi(gw.y), bf_lo(gw.z), bf_hi(gw.z), bf_lo(gw.w), bf_hi(gw.w)};
                    float r[8];
#pragma unroll
                    for (int e = 0; e < 4; ++e) { r[e] = o0[e] * gv[e] * fast_sigmoid(gv[e]); r[4 + e] = o1[e] * gv[4 + e] * fast_sigmoid(gv[4 + e]); }
                    if (og8) { int w0 = 0, w1 = 0; w0 = __builtin_amdgcn_cvt_pk_fp8_f32(r[0], r[1], w0, false); w0 = __builtin_amdgcn_cvt_pk_fp8_f32(r[2], r[3], w0, true);
                        w1 = __builtin_amdgcn_cvt_pk_fp8_f32(r[4], r[5], w1, false); w1 = __builtin_amdgcn_cvt_pk_fp8_f32(r[6], r[7], w1, true); u32x2 w; w.x = (unsigned)w0; w.y = (unsigned)w1;
                        *(u32x2*)((unsigned char*)OG + tok * VW + col) = w; }
                    else { u32x4 w; w.x = cvt_pk_bf16(r[0], r[1]); w.y = cvt_pk_bf16(r[2], r[3]); w.z = cvt_pk_bf16(r[4], r[5]); w.w = cvt_pk_bf16(r[6], r[7]);
                        *(u32x4*)(OG + tok * VW + col) = w; } } }
            VM_WAIT(); RT_BAR;
        }
    }
#undef RT_STAGE
#undef RT_STAGE_STEP
#undef RT_BAR
#undef RT_LD16
}

template <int W>
__device__ __forceinline__ void pool_rows(const bf16_t* X, const LAS float* rs, bf16_t* MIX, int r0, int s0, int q, int col) {
    f32x4 v[23];
#pragma unroll
    for (int t = 0; t < 23; ++t) { if (t >= 16 - W) { int row = r0 - 15 + 8 * q + t; row = row < 0 ? 0 : row; v[t] = bf4(*(const u32x2*)(X + (size_t)row * D + col)) * rs[8 * q + t]; } }
#pragma unroll
    for (int o = 0; o < 8; ++o) { const int t = 15 + o, s = s0 + 8 * q + o; f32x4 sum = v[t];
#pragma unroll
        for (int d = 1; d < W; ++d) sum = sum + v[t - d];
        const int cnt = (s + 1) < W ? (s + 1) : W; const float ic = 1.0f / (float)cnt;
        const f32x4 mx = sum * ic - v[t];
        u32x2 w; w.x = cvt_pk_bf16(mx[0], mx[1]); w.y = cvt_pk_bf16(mx[2], mx[3]);
        *(u32x2*)(MIX + (size_t)(r0 + 8 * q + o) * D + col) = w; }
}
__device__ __forceinline__ void pool_phase(Frame& F_, const bf16_t* X, const float* ROWSS, bf16_t* MIX) {
    Frame F = F_; { int t_ = mk_tid(F_.wv); asm volatile("" : "+v"(t_)); F.tid = t_; F.lane = t_ & 63; F.wave = __builtin_amdgcn_readfirstlane(t_ >> 6); }
    LAS float* rs = (LAS float*)(F.lds);
    for (int u = F.bid; u < 1024; u += F.G) {
        const int rt = u >> 2, g = u & 3, r0 = rt * 32, s0 = r0 & (SEQ - 1);
        for (int li = F.wave; li < 47; li += 8) { const int s = s0 - 15 + li; int row = r0 - 15 + li; row = row < 0 ? 0 : row;
            float p = (F.lane < 32) ? ROWSS[(size_t)row * 32 + F.lane] : 0.f; p = wave_sum(p);
            if (F.lane == 0) rs[li] = (s >= 0) ? (1.0f / sqrtf(p * (1.0f / D) + EPS)) : 0.f; }
        LDS_WAIT(); __syncthreads();
        const int q = F.tid >> 7, col = g * 512 + (F.tid & 127) * 4;
        if (g == 0) pool_rows<2>(X, rs, MIX, r0, s0, q, col); else if (g == 1) pool_rows<4>(X, rs, MIX, r0, s0, q, col); else if (g == 2) pool_rows<8>(X, rs, MIX, r0, s0, q, col); else pool_rows<16>(X, rs, MIX, r0, s0, q, col);
        __syncthreads();
    }
}

template <int W>
__device__ __forceinline__ void pool_pair(const bf16_t* Z, const LAS float* invt, int li0  , int ra, int sa, int col, f32x4& pa, f32x4& pb) {
    f32x4 S = (f32x4){0.f, 0.f, 0.f, 0.f}, first = S, za = S, zb = S;
#pragma unroll
    for (int k = 0; k <= W; ++k) { int row = ra - W + 1 + k; row = row < 0 ? 0 : row;
        const f32x4 z = bf4(*(const u32x2*)(Z + (size_t)row * D + col)) * invt[li0 - W + 1 + k];
        if (k == 0) first = z; if (k < W) S = S + z; if (k == W - 1) za = z; if (k == W) zb = z; }
    const int ca = (sa + 1) < W ? (sa + 1) : W, cb = (sa + 2) < W ? (sa + 2) : W;
    pa = S * (1.0f / (float)ca) - za; pb = (S - first + zb) * (1.0f / (float)cb) - zb;
}
template <int fp8>
__device__ __forceinline__ void router_phase(Frame& F_, bf16_t* X, const bf16_t* Z, const float* ROWSS, const float* pscale  , const float* router  , const float* gain  , unsigned* counts  , unsigned char* XG, int* TOK, float* GATE, unsigned char* ACTM8, float* SAM) {
    Frame F = F_; { int t_ = mk_tid(F_.wv); asm volatile("" : "+v"(t_)); F.tid = t_; F.lane = t_ & 63; F.wave = __builtin_amdgcn_readfirstlane(t_ >> 6); }
    LAS float* RTt = (LAS float*)(F.lds);
    LAS float* GN = (LAS float*)(F.lds + 65536);
    LAS float* PS = (LAS float*)(F.lds + 73728);
    LAS float* invt = (LAS float*)(F.lds + 81920);
    LAS int* lcnt = (LAS int*)(F.lds + MISC_OFF + 256);
    for (int i = F.tid; i < D * 8; i += 512) { const int c = i >> 3, e = i & 7; RTt[e * D + c] = router[i] * gain[c]; }
    for (int i = F.tid; i < D; i += 512) { GN[i] = gain[i]; PS[i] = pscale[i]; }
    if (fp8 != 0) { for (int i = F.bid * 512 + F.tid; i < NE * NT * 8; i += F.G * 512) *(u32x4*)(ACTM8 + (size_t)(i >> 3) * FE8 + FE + (i & 7) * 16) = (u32x4){0u, 0u, 0u, 0u}; }
    __syncthreads();
    for (int t = F.bid; t < 256; t += F.G) {
        const int r0 = t * 32, s0 = r0 & (SEQ - 1);
        if (F.tid < 16) lcnt[F.tid] = 0;
        for (int li = F.wave; li < 47; li += 8) { const int sp = s0 - 15 + li; int row = r0 - 15 + li; row = row < 0 ? 0 : row;
            float p = (F.lane < 32) ? ROWSS[(size_t)row * 32 + F.lane] : 0.f; p = wave_sum(p);
            if (F.lane == 0) invt[li] = (sp >= 0) ? (1.0f / sqrtf(p * (1.0f / D) + EPS)) : 0.f; }
        LDS_WAIT(); __syncthreads();
        const int rbase = r0 + F.wave * 4;
        int e0[4], e1[4], p0[4], p1[4]; float g0[4], inr[4], mq[4];
#pragma unroll
        for (int pr = 0; pr < 2; ++pr) {
            const int ra = rbase + 2 * pr, sa = ra & (SEQ - 1), li0 = ra - r0 + 15;
            f32x4 xa[8], xb[8];
#pragma unroll
            for (int j = 0; j < 8; ++j) { int ln = F.lane; asm volatile("" : "+v"(ln));
                const int col = 4 * ln + 256 * j; f32x4 pa, pb;
                if (j < 2) pool_pair<2>(Z, invt, li0, ra, sa, col, pa, pb); else if (j < 4) pool_pair<4>(Z, invt, li0, ra, sa, col, pa, pb); else if (j < 6) pool_pair<8>(Z, invt, li0, ra, sa, col, pa, pb); else pool_pair<16>(Z, invt, li0, ra, sa, col, pa, pb);
                const f32x4 ps = *(const LAS f32x4*)(PS + col);
                xa[j] = bf4(*(const u32x2*)(X + (size_t)ra * D + col)) + ps * pa; xb[j] = bf4(*(const u32x2*)(X + (size_t)(ra + 1) * D + col)) + ps * pb;
                u32x2 wa, wb; wa.x = cvt_pk_bf16(xa[j][0], xa[j][1]); wa.y = cvt_pk_bf16(xa[j][2], xa[j][3]); wb.x = cvt_pk_bf16(xb[j][0], xb[j][1]); wb.y = cvt_pk_bf16(xb[j][2], xb[j][3]);
                *(u32x2*)(X + (size_t)ra * D + col) = wa; *(u32x2*)(X + (size_t)(ra + 1) * D + col) = wb;
                if (j == 3 || j == 7) __builtin_amdgcn_sched_barrier(0); }
            float sqa = 0.f, sqb = 0.f;
            if constexpr (fp8 == 2) { float ma = 0.f, mb = 0.f;
#pragma unroll
                for (int j = 0; j < 8; ++j) { const f32x4 gn = *(const LAS f32x4*)(GN + 4 * F.lane + 256 * j); const f32x4 ta = xa[j] * gn, tb = xb[j] * gn;
                    ma = fmaxf(ma, fmaxf(fmaxf(fabsf(ta[0]), fabsf(ta[1])), fmaxf(fabsf(ta[2]), fabsf(ta[3])))); mb = fmaxf(mb, fmaxf(fmaxf(fabsf(tb[0]), fabsf(tb[1])), fmaxf(fabsf(tb[2]), fabsf(tb[3])))); }
                mq[2 * pr] = fmaxf(wave_max(ma), 1e-20f); mq[2 * pr + 1] = fmaxf(wave_max(mb), 1e-20f); }
#pragma unroll
            for (int j = 0; j < 8; ++j) { sqa += (xa[j][0] * xa[j][0] + xa[j][1] * xa[j][1]) + (xa[j][2] * xa[j][2] + xa[j][3] * xa[j][3]); sqb += (xb[j][0] * xb[j][0] + xb[j][1] * xb[j][1]) + (xb[j][2] * xb[j][2] + xb[j][3] * xb[j][3]); }
            const float inva = 1.0f / sqrtf(wave_sum(sqa) * (1.0f / D) + EPS), invb = 1.0f / sqrtf(wave_sum(sqb) * (1.0f / D) + EPS);
            inr[2 * pr] = inva; inr[2 * pr + 1] = invb;
            float lg[2][8];
#pragma unroll
            for (int e = 0; e < 8; ++e) { float a0 = 0.f, a1 = 0.f;
#pragma unroll
                for (int j = 0; j < 8; ++j) { const f32x4 w = *(const LAS f32x4*)(RTt + e * D + 4 * F.lane + 256 * j);
                    a0 += (xa[j][0] * w[0] + xa[j][1] * w[1]) + (xa[j][2] * w[2] + xa[j][3] * w[3]);
                    a1 += (xb[j][0] * w[0] + xb[j][1] * w[1]) + (xb[j][2] * w[2] + xb[j][3] * w[3]); }
                lg[0][e] = wave_sum(a0) * inva; lg[1][e] = wave_sum(a1) * invb; }
#pragma unroll
            for (int q = 0; q < 2; ++q) { const int rr = 2 * pr + q;
                float v0 = lg[q][0]; int i0 = 0;
#pragma unroll
                for (int e = 1; e < 8; ++e) if (lg[q][e] > v0) { v0 = lg[q][e]; i0 = e; }
                float v1 = -3.0e38f; int i1 = 0;
#pragma unroll
                for (int e = 0; e < 8; ++e) if (e != i0 && lg[q][e] > v1) { v1 = lg[q][e]; i1 = e; }
                e0[rr] = i0; e1[rr] = i1; g0[rr] = 1.0f / (1.0f + expf(v1 - v0));
                int a = 0, bq = 0;
                if (F.lane == 0) { a = atomicAdd((int*)(lcnt + i0), 1); bq = atomicAdd((int*)(lcnt + i1), 1); }
                p0[rr] = __builtin_amdgcn_readfirstlane(a); p1[rr] = __builtin_amdgcn_readfirstlane(bq); }
            __builtin_amdgcn_sched_barrier(0);
        }
        VM_WAIT();
        __syncthreads();
        if (F.tid < 8) lcnt[8 + F.tid] = (int)__hip_atomic_fetch_add(counts + 64 * F.tid, (unsigned)lcnt[F.tid], __ATOMIC_RELAXED, __HIP_MEMORY_SCOPE_AGENT);
        __syncthreads();
#pragma unroll
        for (int rr = 0; rr < 4; ++rr) { const int row = rbase + rr;
            const int q0 = lcnt[8 + e0[rr]] + p0[rr], q1 = lcnt[8 + e1[rr]] + p1[rr];
            const size_t pitch = fp8 ? D : 2 * D;
            float q8 = 0.f; if constexpr (fp8 == 2) q8 = 127.0f / mq[rr];
            unsigned char* d0 = XG + ((size_t)e0[rr] * NT + q0) * pitch; unsigned char* d1 = XG + ((size_t)e1[rr] * NT + q1) * pitch;
            int ln = F.lane; asm volatile("" : "+v"(ln));
#pragma unroll
            for (int j = 0; j < 8; ++j) { const f32x4 gn = *(const LAS f32x4*)(GN + 4 * ln + 256 * j);
                const unsigned long long xw = __hip_atomic_load((const unsigned long long*)(X + (size_t)row * D) + ln + 64 * j, __ATOMIC_RELAXED, __HIP_MEMORY_SCOPE_AGENT);
                u32x2 xx; xx.x = (unsigned)xw; xx.y = (unsigned)(xw >> 32); const f32x4 hv = bf4(xx) * inr[rr] * gn;
                if constexpr (fp8 == 2) { const int w = pack_i8x4(bf4(xx) * gn * q8); ((unsigned*)d0 + ln)[64 * j] = (unsigned)w; ((unsigned*)d1 + ln)[64 * j] = (unsigned)w; }
                else if constexpr (fp8 != 0) { int w = 0; w = __builtin_amdgcn_cvt_pk_fp8_f32(hv[0], hv[1], w, false); w = __builtin_amdgcn_cvt_pk_fp8_f32(hv[2], hv[3], w, true);
                    ((unsigned*)d0 + ln)[64 * j] = (unsigned)w; ((unsigned*)d1 + ln)[64 * j] = (unsigned)w; }
                else { u32x2 w; w.x = cvt_pk_bf16(hv[0], hv[1]); w.y = cvt_pk_bf16(hv[2], hv[3]); ((u32x2*)d0 + ln)[64 * j] = w; ((u32x2*)d1 + ln)[64 * j] = w; } }
            if constexpr (fp8 == 2) { if (F.lane == 0) { const float sc = mq[rr] * inr[rr] * (1.0f / 127.0f); SAM[e0[rr] * NT + q0] = sc; SAM[e1[rr] * NT + q1] = sc; } }
            if (F.lane == 0) { TOK[e0[rr] * NT + q0] = row * 2; GATE[e0[rr] * NT + q0] = g0[rr]; TOK[e1[rr] * NT + q1] = row * 2 + 1; GATE[e1[rr] * NT + q1] = 1.0f - g0[rr]; }
        }
        __syncthreads();
    }
}

__device__ __forceinline__ void combine_phase(Frame& F_, bf16_t* X, const bf16_t* Y, bf16_t* XB, const float* gfinal, float* out, bool last, const int xb8  , const float ys, float* SA) {
    Frame F = F_; { int t_ = mk_tid(F_.wv); asm volatile("" : "+v"(t_)); F.tid = t_; F.lane = t_ & 63; F.wave = __builtin_amdgcn_readfirstlane(t_ >> 6); }
    const int gw = F.bid * 8 + F.wave, NGW = F.G * 8;
    for (int row = gw; row < NT; row += NGW) {
        f32x4 v[8]; float s = 0.f;
#pragma unroll
        for (int j = 0; j < 8; ++j) { const size_t o = (size_t)row * D / 4 + F.lane + 64 * j;
            const u32x2 y0 = ((const u32x2*)Y)[o], y1 = ((const u32x2*)(Y + (size_t)NT * D))[o];
            v[j] = bf4(((const u32x2*)X)[o]) + ((f32x4){bf_lo(y0.x), bf_hi(y0.x), bf_lo(y0.y), bf_hi(y0.y)} + (f32x4){bf_lo(y1.x), bf_hi(y1.x), bf_lo(y1.y), bf_hi(y1.y)}) * ys;
            s += (v[j][0] * v[j][0] + v[j][1] * v[j][1]) + (v[j][2] * v[j][2] + v[j][3] * v[j][3]); }
        const float inv = 1.0f / sqrtf(wave_sum(s) * (1.0f / D) + EPS);
        if (last) {
#pragma unroll
            for (int j = 0; j < 8; ++j) { const f32x4 g = ((const f32x4*)gfinal)[F.lane + 64 * j]; ((f32x4*)(out + (size_t)row * D))[F.lane + 64 * j] = v[j] * inv * g; }
        } else {
            float q8 = 0.f;
            if (xb8 == 2) { float mx = 0.f;
#pragma unroll
                for (int j = 0; j < 8; ++j) mx = fmaxf(mx, fmaxf(fmaxf(fabsf(v[j][0]), fabsf(v[j][1])), fmaxf(fabsf(v[j][2]), fabsf(v[j][3]))));
                mx = fmaxf(wave_max(mx) * inv, 1e-20f); q8 = inv * 127.0f / mx; if (F.lane == 0) SA[row] = mx * (1.0f / 127.0f); }
#pragma unroll
            for (int j = 0; j < 8; ++j) { { u32x2 w; w.x = cvt_pk_bf16(v[j][0], v[j][1]); w.y = cvt_pk_bf16(v[j][2], v[j][3]); ((u32x2*)(X + (size_t)row * D))[F.lane + 64 * j] = w; }
                if (xb8 == 2) ((int*)((unsigned char*)XB + (size_t)row * D) + F.lane)[64 * j] = pack_i8x4(v[j] * q8);
                else if (xb8) { int w = 0; w = __builtin_amdgcn_cvt_pk_fp8_f32(v[j][0] * inv, v[j][1] * inv, w, false); w = __builtin_amdgcn_cvt_pk_fp8_f32(v[j][2] * inv, v[j][3] * inv, w, true); ((unsigned*)((unsigned char*)XB + (size_t)row * D) + F.lane)[64 * j] = (unsigned)w; }
                else { u32x2 w; w.x = cvt_pk_bf16(v[j][0] * inv, v[j][1] * inv); w.y = cvt_pk_bf16(v[j][2] * inv, v[j][3] * inv); ((u32x2*)(XB + (size_t)row * D) + F.lane)[64 * j] = w; } }
        }
    }
}

__device__ __forceinline__ int compute_cus(int T, int G) { if (T <= 0) return G; const int R = (T + G - 1) / G; int g = (T + R - 1) / R; g = (g + 7) & ~7; return g > G ? G : g; }
__device__ __forceinline__ void quant_rows_phase(Frame& F_, const bf16_t* X, const float* ROWSS, unsigned char* XQ, float* SA) {
    Frame F = F_; { int t_ = mk_tid(F_.wv); asm volatile("" : "+v"(t_)); F.tid = t_; F.lane = t_ & 63; F.wave = __builtin_amdgcn_readfirstlane(t_ >> 6); }
    const int gw = F.bid * 8 + F.wave, NGW = F.G * 8;
    for (int row = gw; row < NT; row += NGW) {
        float p = (F.lane < 32) ? ROWSS[(size_t)row * 32 + F.lane] : 0.f; p = wave_sum(p); const float inv = 1.0f / sqrtf(p * (1.0f / D) + EPS);
        f32x4 v[8]; float mx = 0.f;
#pragma unroll
        for (int j = 0; j < 8; ++j) { v[j] = bf4(((const u32x2*)(X + (size_t)row * D) + F.lane)[64 * j]) * inv;
            mx = fmaxf(mx, fmaxf(fmaxf(fabsf(v[j][0]), fabsf(v[j][1])), fmaxf(fabsf(v[j][2]), fabsf(v[j][3])))); }
        mx = fmaxf(wave_max(mx), 1e-20f); const float q = 127.0f / mx;
#pragma unroll
        for (int j = 0; j < 8; ++j) ((int*)(XQ + (size_t)row * D) + F.lane)[64 * j] = pack_i8x4(v[j] * q);
        if (F.lane == 0) SA[row] = mx * (1.0f / 127.0f);
    }
}
__global__ void __launch_bounds__(512, 2) trunk_fwd(Params args) {
    extern __shared__ __attribute__((aligned(16))) unsigned char lds_raw[];
    Frame F;
    F.lds = (LAS unsigned char*)lds_raw;
    F.tid = 0; F.lane = 0; F.wave = 0; F.G = gridDim.x; F.bid = blockIdx.x; F.wv = __builtin_amdgcn_readfirstlane((int)(threadIdx.x >> 6));
    F.out = args.out; F.ws = args.ws;
    unsigned char* ws = args.ws;
    unsigned* ctl = (unsigned*)(ws + WS_CTL);
    volatile LAS unsigned* MISC = (volatile LAS unsigned*)(F.lds + MISC_OFF);
    if (threadIdx.x < 64) MISC[threadIdx.x] = 0u;
    __syncthreads();
    const int lo = args.ph_lo, hi = args.ph_hi;
    const bool use_bar = (hi - lo) > 1;
    XcdBarrier bar; bar.bar = ctl + CW_BAR; bar.x = 0; bar.st = MISC + 8;
    if (use_bar) bar = xcd_barrier_post(ctl + CW_BAR, MISC + 8);
    bar.wv = F.wv;
#ifndef PHMASK
#define PHMASK 0x1FFF
#endif
#ifndef REPSLOT
#define REPSLOT -1
#endif
#ifndef REPCNT
#define REPCNT 2
#endif
#define NREP(j) (((j) == (REPSLOT)) ? (REPCNT) : 1)
#define EN(j) (((PHMASK) >> (j)) & 1)
#define IN(k) (lo <= (k) && (k) < hi)
#define WS_FRESH do { } while (0)
#define SEAM(k) do { if (IN(k) && IN((k) + 1)) xcd_barrier(bar); } while (0)
    bf16_t* X = (bf16_t*)(ws + WS_X); bf16_t* XB = (bf16_t*)(ws + WS_XB); float* ROWSS = (float*)(ws + WS_ROWSS);
    LAS unsigned char* ring = F.lds;

    if (EN(0) && IN(0)) { _Pragma("unroll 1") for (int rep = 0; rep < NREP(0); ++rep) { p0_prologue(F, args); __syncthreads(); } }
    SEAM(0);

#pragma unroll 1
    for (int l = 0; l < 2; ++l) {
        const int pb = 1 + 11 * l;
        asm volatile("" : "+s"(ws));
        WS_FRESH;
        if (EN(1) && IN(pb + 0)) _Pragma("unroll 1") for (int rep = 0; rep < NREP(1); ++rep) {
            const bool p8 = (PROJ8 >> l) & 1; const int r8 = (RET8 >> l) & 1;
            A1Order S; S.XB = (unsigned)WS_XB; S.WQKG = (unsigned)(WS_WQKG + l * SZ_WQKG); S.WVT = (unsigned)(WS_WVT + l * SZ_WVT); S.G = F.G; S.c = F.bid; S.t = p8 ? 256u * D : 256u * D * 2;
            const bool i8 = (I8A1 >> l) & 1; if (i8) S.t = 256u * D;
            EpiA1 E{(bf16_t*)(ws + WS_QB), (bf16_t*)(ws + WS_KB), (bf16_t*)(ws + WS_GB), (bf16_t*)(ws + WS_VT), (const float*)(ws + WS_COS), (const float*)(ws + WS_SIN), (const float*)(ws + (r8 ? WS_DQ8 : WS_DQ)), (const float*)(ws + (r8 ? WS_DKS8 : WS_DKS)), (p8 && !i8) ? 1.0f / 32.0f : 1.0f, r8,
                    i8 ? (const float*)(ws + WS_SA) : nullptr, (const float*)(ws + WS_SWQ + l * SZ_SWL), (const float*)(ws + WS_SWV + l * SZ_SWL)};
            if (i8) pg8::gemm_phase<EpiA1, A1Order, 2>(ring, ws, D, D, D, S, E, F.wv);
            else if (!p8) pg8::gemm_phase<EpiA1, A1Order>(ring, ws, D, D, D, S, E, F.wv);
            else pg8::gemm_phase<EpiA1, A1Order, true>(ring, ws, D, D, D, S, E, F.wv);
        }
        SEAM(pb + 0);
        WS_FRESH;
        if (EN(2) && IN(pb + 1)) _Pragma("unroll 1") for (int rep = 0; rep < NREP(2); ++rep) { if (!((RET8 >> l) & 1)) retention_phase(F, (const bf16_t*)(ws + WS_QB), (const bf16_t*)(ws + WS_KB), (const bf16_t*)(ws + WS_VT), (const bf16_t*)(ws + WS_GB), args.in[2] + (size_t)l * VW, (bf16_t*)(ws + WS_OG), (PROJ8 >> l) & 1);
            else retention8_phase(F, ws + WS_QB, ws + WS_KB, ws + WS_VT, (const bf16_t*)(ws + WS_GB), args.in[2] + (size_t)l * VW, (bf16_t*)(ws + WS_OG), (PROJ8 >> l) & 1); }
        SEAM(pb + 1);
        WS_FRESH;
        if (EN(3) && IN(pb + 2)) _Pragma("unroll 1") for (int rep = 0; rep < NREP(3); ++rep) {
            const bool d8 = ((DENSE8 >> l) & 1) && !((I8A4 >> l) & 1);
            const bool p8 = (PROJ8 >> l) & 1;
            DenseOrder S; S.init(WS_OG, p8 ? VW / 2 : VW, WS_WOUT + l * SZ_WOUT, p8 ? VW / 2 : VW, NT, D, F.G, F.bid);
            EpiRes E{X, nullptr, ROWSS, nullptr, 0, rep ? 0.f : (p8 ? 1.0f / 32.0f : 1.0f), d8 ? (unsigned char*)XB : nullptr};
            if (!p8) pg8::gemm_phase<EpiRes, DenseOrder>(ring, ws, VW, VW, VW, S, E, F.wv);
            else pg8::gemm_phase<EpiRes, DenseOrder, true>(ring, ws, VW, VW, VW, S, E, F.wv);
        }
        SEAM(pb + 2);
        if ((I8A4 >> l) & 1) {
            WS_FRESH;
        if (EN(12) && IN(pb + 3)) _Pragma("unroll 1") for (int rep = 0; rep < NREP(12); ++rep) quant_rows_phase(F, X, ROWSS, ws + WS_XB, (float*)(ws + WS_SA));
            SEAM(pb + 3);
        }
        WS_FRESH;
        if (EN(4) && IN(pb + 4)) _Pragma("unroll 1") for (int rep = 0; rep < NREP(4); ++rep) {
            const int Gc = compute_cus(32 * 44, F.G);
            if (F.bid < Gc) {
                if ((I8A4 >> l) & 1) {
                    DenseOrder S; S.init(WS_XB, D / 2, WS_WGU + l * SZ_WGU, D / 2, NT, 2 * FF, Gc, F.bid);
                    EpiGUi8 E{(bf16_t*)(ws + WS_ACT), FF, (const float*)(ws + WS_SA), (const float*)(ws + WS_SWGU + l * SZ_SWL), (DENSE8 >> l) & 1, 0, 0, 0};
                    pg8::gemm_phase<EpiGUi8, DenseOrder, 2>(ring, ws, D, D, D, S, E, F.wv);
                } else if (!((DENSE8 >> l) & 1)) {
                    DenseOrder S; S.init(WS_X, D, WS_WGU + l * SZ_WGU, D, NT, 2 * FF, Gc, F.bid);
                    EpiGU E{(bf16_t*)(ws + WS_ACT), FF, ROWSS, 0};
                    pg8::gemm_phase<EpiGU, DenseOrder>(ring, ws, D, D, D, S, E, F.wv);
                } else {
                    DenseOrder S; S.init(WS_XB, D / 2, WS_WGU + l * SZ_WGU, D / 2, NT, 2 * FF, Gc, F.bid);
                    EpiGU8 E{ws + WS_ACT, FF, 0, 1.0f / 32.0f, ROWSS};
                    pg8::gemm_phase<EpiGU8, DenseOrder, true>(ring, ws, D, D, D, S, E, F.wv);
                }
            }
            if ((I8B4 >> l) & 1) strip_loop<true>(F, args, l, 0, 704, 0, 736, 1 + l);
            conv_queue(F, args, l == 0 ? 1 : 4); __syncthreads();
        }
        SEAM(pb + 4);
        WS_FRESH;
        if (EN(5) && IN(pb + 5)) _Pragma("unroll 1") for (int rep = 0; rep < NREP(5); ++rep) {
            const bool d8 = (DENSE8 >> l) & 1;
            DenseOrder S; S.init(WS_ACT, d8 ? FF / 2 : FF, WS_WDN + l * SZ_WDN, d8 ? FF / 2 : FF, NT, D, F.G, F.bid);
            EpiRes E{X, nullptr, ROWSS, nullptr, 0, rep ? 0.f : (d8 ? 1.0f / 32.0f : 1.0f), nullptr};
            if (!d8) pg8::gemm_phase<EpiRes, DenseOrder>(ring, ws, FF, FF, FF, S, E, F.wv);
            else pg8::gemm_phase<EpiRes, DenseOrder, true>(ring, ws, FF, FF, FF, S, E, F.wv);
        }
        SEAM(pb + 5);
        WS_FRESH;
        if (EN(6) && IN(pb + 6)) _Pragma("unroll 1") for (int rep = 0; rep < NREP(6); ++rep) {
            PoolOrder S; S.MIX = (unsigned)WS_X; S.W = (unsigned)(WS_WPOOL + l * SZ_WPOOL); S.G = F.G; S.c = F.bid;
            EpiZ E{(bf16_t*)(ws + WS_MIX)};
            pg8::gemm_phase<EpiZ, PoolOrder>(ring, ws, 512, D, 512, S, E, F.wv);
        }
        SEAM(pb + 6);
        unsigned* counts = ctl + CW_CNT + l * 512;
        WS_FRESH;
        if (EN(8) && IN(pb + 7)) _Pragma("unroll 1") for (int rep = 0; rep < NREP(8); ++rep) {
            const float* a_ps = args.in[5] + (size_t)l * D; const float* a_rt = args.in[8] + (size_t)l * D * NE; const float* a_gn = args.in[12] + (size_t)(2 * l + 1) * D;
            constexpr bool all_i8 = (I8B4 & 3) == 3, all_f8 = (F8MASK & 3) == 3;
            if (all_i8 || ((I8B4 >> l) & 1)) router_phase<2>(F, X, (const bf16_t*)(ws + WS_MIX), ROWSS, a_ps, a_rt, a_gn, counts, ws + WS_XG, (int*)(ws + WS_TOK), (float*)(ws + WS_GATE), ws + WS_ACTM, (float*)(ws + WS_SAM));
            else if (all_f8 || ((F8MASK >> l) & 1)) router_phase<1>(F, X, (const bf16_t*)(ws + WS_MIX), ROWSS, a_ps, a_rt, a_gn, counts, ws + WS_XG, (int*)(ws + WS_TOK), (float*)(ws + WS_GATE), ws + WS_ACTM, nullptr);
            else router_phase<0>(F, X, (const bf16_t*)(ws + WS_MIX), ROWSS, a_ps, a_rt, a_gn, counts, ws + WS_XG, (int*)(ws + WS_TOK), (float*)(ws + WS_GATE), ws + WS_ACTM, nullptr);
        }
        SEAM(pb + 7);
        WS_FRESH;
        if (EN(9) && IN(pb + 8)) _Pragma("unroll 1") for (int rep = 0; rep < NREP(9); ++rep) {
            const bool f8 = (F8MASK >> l) & 1;
            MoeOrder S;
            if (!f8) S.init(WS_XG, (size_t)NT * D * 2, D, WS_WMGU + l * SZ_WMGU, (size_t)2 * FE * D * 2, D, 2 * FE / 256, counts, F.G, F.bid);
            else S.init(WS_XG, (size_t)NT * D, D, WS_WMGU + l * SZ_WMGU, (size_t)2 * FE * D, D, 2 * FE / 256, counts, F.G, F.bid, 1);
#ifndef B4GC
#define B4GC 0
#endif
            const int Gc = (l == 0) ? (B4GC ? B4GC : compute_cus(S.total, F.G)) : F.G; S.G = Gc;
            if (F.bid < Gc) {
                if (!f8) { EpiGU E{(bf16_t*)(ws + WS_ACTM), FE, nullptr, (size_t)NT * FE}; pg8::gemm_phase<EpiGU, MoeOrder>(ring, ws, D, D, D, S, E, F.wv); }
                else if ((I8B4 >> l) & 1) { EpiGUi8 E{(bf16_t*)(ws + WS_ACTM), FE8, (const float*)(ws + WS_SAM), (const float*)(ws + WS_SWM) + l * NE * 2 * FE, 1, (size_t)NT * FE8, NT, 2 * FE};
                    pg8::gemm_phase<EpiGUi8, MoeOrder, 2>(ring, ws, D, D, D, S, E, F.wv); }
                else { EpiGU8 E{ws + WS_ACTM, FE8, (size_t)NT * FE8, 1.0f / 32.0f, nullptr}; pg8::gemm_phase<EpiGU8, MoeOrder, true>(ring, ws, D, D, D, S, E, F.wv); }
            }
            if (l == 0) { if (I8A1 & 2) strip_loop<true>(F, args, 1, 0, 384, 0, 0, 0); conv_queue(F, args, 2); }
            __syncthreads();
        }
        SEAM(pb + 8);
        WS_FRESH;
        if (EN(10) && IN(pb + 9)) _Pragma("unroll 1") for (int rep = 0; rep < NREP(10); ++rep) {
            const bool f8 = (F8MASK >> l) & 1;
            MoeOrder S;
            if (!f8) S.init(WS_ACTM, (size_t)NT * FE * 2, FE, WS_WMDN + l * SZ_WMDN, (size_t)D * FE * 2, FE, D / 256, counts, F.G, F.bid);
            else S.init(WS_ACTM, (size_t)NT * FE8, FE8, WS_WMDN + l * SZ_WMDN, (size_t)D * FE8, FE8, D / 256, counts, F.G, F.bid, 1);
            const int Gc = (l == 0) ? compute_cus(S.total, F.G) : F.G; S.G = Gc;
            if (F.bid < Gc) {
                EpiMoeDown E{(bf16_t*)(ws + WS_Y), (const int*)(ws + WS_TOK), (const float*)(ws + WS_GATE), f8 ? 1.0f / 32.0f : 1.0f};
                if (!f8) pg8::gemm_phase<EpiMoeDown, MoeOrder>(ring, ws, FE, FE, FE, S, E, F.wv);
                else pg8::gemm_phase<EpiMoeDown, MoeOrder, true>(ring, ws, FE8, FE8, FE8, S, E, F.wv);
            }
            if (l == 0) conv_queue(F, args, 3);
            __syncthreads();
        }
        SEAM(pb + 9);
        WS_FRESH;
        if (EN(11) && IN(pb + 10)) _Pragma("unroll 1") for (int rep = 0; rep < NREP(11); ++rep) combine_phase(F, X, (const bf16_t*)(ws + WS_Y), XB, args.in[13], F.out, l == 1, ((I8A1 >> (l + 1)) & 1) ? 2 : ((PROJ8 >> (l + 1)) & 1), rep ? 0.f : 1.0f, (float*)(ws + WS_SA));
        if (l == 0) SEAM(pb + 10);
    }
#undef IN
#undef SEAM
}

extern "C" void kernel_launch(void* const* d_in, const int* in_sizes, int n_in, void* d_out, int out_size, void* d_ws, size_t ws_size, hipStream_t stream) {
    static int grid = 0;
    if (grid == 0) {
        if (n_in != 14 || in_sizes[0] != NT * D || out_size != NT * D || ws_size < WS_END) { fprintf(stderr, "kernel_launch: unexpected shapes (n_in %d, in0 %d, out %d, ws %zu < %zu)\n", n_in, n_in > 0 ? in_sizes[0] : -1, out_size, ws_size, (size_t)WS_END); grid = -1; return; }
        int dev = 0, cus = 0, per_cu = 0;
        if (hipGetDevice(&dev) != hipSuccess || hipDeviceGetAttribute(&cus, hipDeviceAttributeMultiprocessorCount, dev) != hipSuccess) { grid = -1; return; }
        if (hipFuncSetAttribute((const void*)trunk_fwd, hipFuncAttributeMaxDynamicSharedMemorySize, LDS_BYTES) != hipSuccess) { fprintf(stderr, "kernel_launch: hipFuncSetAttribute failed\n"); grid = -1; return; }
        if (hipOccupancyMaxActiveBlocksPerMultiprocessor(&per_cu, (const void*)trunk_fwd, 512, LDS_BYTES) != hipSuccess || per_cu < 1) fprintf(stderr, "kernel_launch: occupancy query reports %d\n", per_cu);
        (void)hipGetLastError();
        grid = cus;
    }
    if (grid < 0) return;
    if (hipMemsetAsync((char*)d_ws + WS_CTL, 0, CTL_BYTES, stream) != hipSuccess) return;
    Params p{};
    for (int i = 0; i < 14; ++i) p.in[i] = (const float*)d_in[i];
    p.out = (float*)d_out; p.ws = (unsigned char*)d_ws;
#if MK_N_LAUNCHES == 1
    p.ph_lo = 0; p.ph_hi = NPHASE;
    hipLaunchKernelGGL(trunk_fwd, dim3(grid), dim3(512), LDS_BYTES, stream, p);
#else
    for (int k = 0; k < NPHASE; ++k) { p.ph_lo = k; p.ph_hi = k + 1; hipLaunchKernelGGL(trunk_fwd, dim3(grid), dim3(512), LDS_BYTES, stream, p); }
#endif
}
```

```cpp
#include <hip/hip_runtime.h>
#include <cstdio>

#define LAS __attribute__((address_space(3)))
#define GAS __attribute__((address_space(1)))
typedef unsigned short bf16_t;
typedef short bf16x8 __attribute__((ext_vector_type(8)));
typedef float f32x4 __attribute__((ext_vector_type(4)));
typedef float f32x2 __attribute__((ext_vector_type(2)));
typedef unsigned u32x4 __attribute__((ext_vector_type(4)));
typedef unsigned u32x2 __attribute__((ext_vector_type(2)));
typedef int i32x4 __attribute__((ext_vector_type(4)));
typedef int i32x8 __attribute__((ext_vector_type(8)));

#ifndef MK_N_LAUNCHES
#define MK_N_LAUNCHES 1
#endif

constexpr int NT = 8192, SEQ = 2048, D = 2048, NH = 8, DK = 256, DV = 512, QKW = 2048, VW = 4096, FF = 5632, NE = 8, FE = 1408;
constexpr float EPS = 1e-6f;
constexpr int NPHASE = 23;
#ifndef DENSE8
#define DENSE8 3
#endif
#ifndef PROJ8
#define PROJ8 2
#endif
#ifndef I8A1
#define I8A1 3
#endif
#ifndef I8A4
#define I8A4 1
#endif
#ifndef I8B4
#define I8B4 0
#endif
#ifndef RET8
#define RET8 2
#endif
#ifndef F8MASK
#define F8MASK 3
#endif
constexpr int FE8 = 1536;

constexpr size_t MiB = 1u << 20;
constexpr size_t WS_CTL = 0, CTL_BYTES = 1 * MiB;
constexpr size_t WS_COS = 1 * MiB, WS_SIN = 2 * MiB, WS_DQ = 3 * MiB, WS_DKS = 3 * MiB + 4096, WS_LG2 = 3 * MiB + 8192, WS_DQ8 = 3 * MiB + 12288, WS_DKS8 = 3 * MiB + 16384;
constexpr size_t WS_ROWSS = 4 * MiB, WS_TOK = 5 * MiB, WS_GATE = 5 * MiB + 512 * 1024;
constexpr size_t WS_SA = 6 * MiB, WS_SWGU = 6 * MiB + 64 * 1024;
constexpr size_t WS_SWQ = WS_SA + 128 * 1024, WS_SWV = WS_SA + 160 * 1024, SZ_SWL = 256 * 1024;
constexpr size_t WS_SAM = WS_SA + 1024 * 1024, WS_SWM = WS_SA + 1536 * 1024;
constexpr size_t WS_WQKG = 8 * MiB, SZ_WQKG = 32 * MiB;
constexpr size_t WS_WVT = 72 * MiB, SZ_WVT = 16 * MiB;
constexpr size_t WS_WOUT = 104 * MiB, SZ_WOUT = 16 * MiB;
constexpr size_t WS_WGU = 136 * MiB, SZ_WGU = 44 * MiB;
constexpr size_t WS_WDN = 224 * MiB, SZ_WDN = 22 * MiB;
constexpr size_t WS_WPOOL = 268 * MiB, SZ_WPOOL = 2 * MiB;
constexpr size_t WS_WMGU = 272 * MiB, SZ_WMGU = 88 * MiB;
constexpr size_t WS_WMDN = 448 * MiB, SZ_WMDN = 44 * MiB;
constexpr size_t WS_X = 536 * MiB, WS_XB = 600 * MiB, WS_S = 632 * MiB;
constexpr size_t WS_QB = WS_S, WS_KB = WS_S + 32 * MiB, WS_VT = WS_S + 64 * MiB, WS_GB = WS_S + 128 * MiB, WS_OG = WS_S + 192 * MiB, WS_ACT = WS_S;
constexpr size_t WS_MIX = WS_S, WS_XG = WS_S + 32 * MiB, WS_ACTM = WS_S + 288 * MiB, WS_Y = WS_S + 464 * MiB;
constexpr size_t WS_END = WS_S + 592 * MiB;
constexpr unsigned WS_END_32 = (unsigned)WS_END;
constexpr int CW_BAR = 4096;
constexpr int CW_Q = 8192;
constexpr int CW_CNT = 1024;

constexpr int RING_BYTES = 131072, MISC_OFF = 139264, LDS_BYTES = 143360;

__device__ __forceinline__ unsigned cvt_pk_bf16(float lo, float hi) { unsigned r; asm volatile("v_cvt_pk_bf16_f32 %0, %1, %2" : "=v"(r) : "v"(lo), "v"(hi)); return r; }
__device__ __forceinline__ float bf_lo(unsigned w) { return __uint_as_float(w << 16); }
__device__ __forceinline__ float bf_hi(unsigned w) { return __uint_as_float(w & 0xffff0000u); }
__device__ __forceinline__ f32x4 bf4(u32x2 w) { return (f32x4){bf_lo(w.x), bf_hi(w.x), bf_lo(w.y), bf_hi(w.y)}; }
__device__ __forceinline__ float fast_sigmoid(float a) { return __builtin_amdgcn_rcpf(1.0f + __builtin_amdgcn_exp2f(-1.4426950408889634f * a)); }
__device__ __forceinline__ float wave_sum(float v) {
#pragma unroll
    for (int o = 1; o < 64; o <<= 1) v += __shfl_xor(v, o);
    return v;
}
#define LDS_WAIT() asm volatile("s_waitcnt lgkmcnt(0)" ::: "memory")
__device__ __forceinline__ int mk_tid(int wv) { unsigned z = 0u; asm volatile("" : "+s"(z)); return wv * 64 + (int)__builtin_amdgcn_mbcnt_hi(~0u, __builtin_amdgcn_mbcnt_lo(~0u, z)); }
#define VM_WAIT() asm volatile("s_waitcnt vmcnt(0)" ::: "memory")

namespace pg8 {
constexpr int BM = 256, BK = 64, HALF = 128, HTB = HALF * BK * 2, STAGE_BYTES = 8 * HTB;
__host__ __device__ __forceinline__ int lds_byte(int r, int c) { const int st = (r >> 4) * 2 + (c >> 5), rr = r & 15, cc = c & 31, ob = rr * 64 + cc * 2; return st * 1024 + (ob ^ (((ob >> 9) & 1) << 5)); }
__host__ __device__ __forceinline__ void stage_rc(int b, int& R, int& C) { const int st = b / 1024, sb = b % 1024, swz = sb ^ (((sb >> 9) & 1) << 5); R = (st >> 1) * 16 + swz / 64; C = (st & 1) * 32 + (swz % 64) / 2; }
__host__ __device__ __forceinline__ int perm32(int rho) { const int n = rho >> 4, i = rho & 15; return 8 * (i >> 2) + 4 * n + (i & 3); }

struct Unit { unsigned a, b; int pm, pn, grp, rows; };

__device__ __forceinline__ int xcd_remap(int L, int nwg) { const int q = nwg / 8, r = nwg % 8, xcd = L % 8, off = L / 8; return (xcd < r ? xcd * (q + 1) : r * (q + 1) + (xcd - r) * q) + off; }
__device__ __forceinline__ void walk2d(int w, int nM, int nN, int& pm, int& pn) { const int nig = 8 * nN, gid = w / nig, fm = gid * 8, gsz = (nM - fm) < 8 ? (nM - fm) : 8; pm = fm + ((w % nig) % gsz); pn = (w % nig) / gsz; }

template <class Epi, class Sched, int FP8 = 0>
__device__ __forceinline__ void gemm_phase(LAS unsigned char* lds, const unsigned char* wsbase, const int K, const int lda, const int ldb, const Sched& S, const Epi& E, const int wv) {
    int tid = mk_tid(wv); asm volatile("" : "+v"(tid));
    const int wid = __builtin_amdgcn_readfirstlane(tid >> 6), lane = tid & 63, wr = wid >> 2, wc = wid & 3, fr = lane & 15, fq = lane >> 4;
    constexpr int ES = FP8 ? 1 : 2;
    const int nt = K * ES / 128;
    unsigned voffA[2], voffB[2];
#pragma unroll
    for (int i = 0; i < 2; ++i) { int R, C; stage_rc(tid * 16 + i * 8192, R, C); const int Rb = (R & ~31) + perm32(R & 31);
        voffA[i] = (unsigned)(R * lda * ES + C * 2); voffB[i] = (unsigned)(Rb * ldb * ES + C * 2); }
    const unsigned kstep = (unsigned)(BK * 2);
    const unsigned hstepA = (unsigned)HALF * lda * ES, hstepB = (unsigned)HALF * ldb * ES;
    const unsigned ldsw = (unsigned)wid * 1024u;
    const __amdgpu_buffer_rsrc_t rsrc = __builtin_amdgcn_make_buffer_rsrc((void*)wsbase, 0, (int)WS_END_32, 0x00020000);
    const int aoff = lds_byte(wr * 64 + fr, fq * 8); int boff = lds_byte(wc * 32 + fr, fq * 8) + 4 * HTB;
    asm volatile("" : "+v"(boff));
#define PG8_SBR(b, h) (((b) * 2 + (h)) * HTB)
#define PG8_SA(b, h) (((b) * 2 + (h)) * HTB)
#define PG8_SB(b, h) ((4 + (b) * 2 + (h)) * HTB)
#define PG8_STAGE(bufoff, soff, voff) do { _Pragma("unroll") for (int _i = 0; _i < 2; ++_i) \
        __builtin_amdgcn_raw_ptr_buffer_load_lds(rsrc, (LAS unsigned*)(lds + (bufoff) + ldsw + _i * 8192), 16, (voff)[_i], (int)(soff), 0, 0); } while (0)
#define PG8_LD16(off) (*(const LAS i32x4*)(lds + (off)))
#define PG8_LDA(dst, b, h) do { _Pragma("unroll") for (int m = 0; m < 4; ++m) { \
        if constexpr (FP8 == 1) { dst##8[m].lo = PG8_LD16(PG8_SA(b, h) + aoff + m * 2048); dst##8[m].hi = PG8_LD16(PG8_SA(b, h) + aoff + m * 2048 + 1024); } \
        else { _Pragma("unroll") for (int k = 0; k < 2; ++k) dst[m][k] = *(const LAS bf16x8*)(lds + PG8_SA(b, h) + aoff + m * 2048 + k * 1024); } } } while (0)
#define PG8_LDB(dst, b, h) do { _Pragma("unroll") for (int n = 0; n < 2; ++n) { \
        if constexpr (FP8 == 1) { dst##8[n].lo = PG8_LD16(PG8_SBR(b, h) + boff + n * 2048); dst##8[n].hi = PG8_LD16(PG8_SBR(b, h) + boff + n * 2048 + 1024); } \
        else { _Pragma("unroll") for (int k = 0; k < 2; ++k) dst[n][k] = *(const LAS bf16x8*)(lds + PG8_SBR(b, h) + boff + n * 2048 + k * 1024); } } } while (0)
#define PG8_MMA(ai, bj, At, Bt) do { __builtin_amdgcn_s_setprio(1); _Pragma("unroll") for (int m = 0; m < 4; ++m) _Pragma("unroll") for (int n = 0; n < 2; ++n) { \
        if constexpr (FP8 == 1) asm volatile("v_mfma_scale_f32_16x16x128_f8f6f4 %0, %1, %2, %0, %3, %3 op_sel_hi:[0,0,0]" : "+v"(acc[ai][bj][m][n]) : "v"(Bt##8[n]), "v"(At##8[m]), "v"(f8scale)); \
        else if constexpr (FP8 == 2) { _Pragma("unroll") for (int k = 0; k < 2; ++k) acc[ai][bj][m][n] = __builtin_bit_cast(f32x4, __builtin_amdgcn_mfma_i32_16x16x64_i8(__builtin_bit_cast(i32x4, Bt[n][k]), __builtin_bit_cast(i32x4, At[m][k]), __builtin_bit_cast(i32x4, acc[ai][bj][m][n]), 0, 0, 0)); } \
        else { _Pragma("unroll") for (int k = 0; k < 2; ++k) acc[ai][bj][m][n] = __builtin_amdgcn_mfma_f32_16x16x32_bf16(Bt[n][k], At[m][k], acc[ai][bj][m][n], 0, 0, 0); } } \
        __builtin_amdgcn_s_setprio(0); } while (0)
#define PG8_WAIT_V(n) asm volatile("s_waitcnt vmcnt(" #n ")" ::: "memory")
#define PG8_WAIT_L(n) asm volatile("s_waitcnt lgkmcnt(" #n ")" ::: "memory")
#define PG8_BAR __builtin_amdgcn_s_barrier()
#define PG8_SCHED __builtin_amdgcn_sched_barrier(0)
    Unit cur, nxt; int ui = 0;
    if (!S.next(0, cur)) return;
    f32x4 acc[2][2][4][2];
#pragma unroll
    for (int a = 0; a < 2; ++a)
#pragma unroll
        for (int b = 0; b < 2; ++b)
#pragma unroll
            for (int m = 0; m < 4; ++m)
#pragma unroll
                for (int n = 0; n < 2; ++n) acc[a][b][m][n] = (f32x4){0.f, 0.f, 0.f, 0.f};
    bf16x8 At[4][2], B0[2][2], B1[2][2]; i32x8 At8[4], B08[2], B18[2];
    int f8scale = 0x7f7f7f7f; asm volatile("" : "+v"(f8scale));
    unsigned cA = cur.a, cB = cur.b;
    PG8_STAGE(PG8_SB(0, 0), cB, voffB); PG8_STAGE(PG8_SB(0, 1), cB + hstepB, voffB); PG8_STAGE(PG8_SA(0, 0), cA, voffA); PG8_STAGE(PG8_SA(0, 1), cA + hstepA, voffA);
    if (wr == 1) PG8_BAR;
    PG8_WAIT_V(2); PG8_BAR;
    PG8_STAGE(PG8_SB(1, 0), cB + kstep, voffB); PG8_STAGE(PG8_SA(1, 0), cA + kstep, voffA); PG8_STAGE(PG8_SB(1, 1), cB + hstepB + kstep, voffB);
    PG8_WAIT_V(6); PG8_BAR;
    for (;;) {
        const bool has_next = S.next(ui + 1, nxt);
        const unsigned nA = has_next ? nxt.a : cA, nB = has_next ? nxt.b : cB;
        for (int t = 0; t < nt; t += 2) {
            const bool last = (t == nt - 2);
            const unsigned a1 = cA + (unsigned)(t + 1) * kstep;
            const unsigned a2 = last ? nA : cA + (unsigned)(t + 2) * kstep, b2 = last ? nB : cB + (unsigned)(t + 2) * kstep;
            const unsigned a3 = a2 + kstep, b3 = b2 + kstep;
            PG8_LDB(B0, 0, 0); PG8_LDB(B1, 0, 1); PG8_SCHED; PG8_LDA(At, 0, 0); PG8_STAGE(PG8_SA(1, 1), a1 + hstepA, voffA);
            PG8_WAIT_V(8); PG8_WAIT_L(0); PG8_BAR; PG8_MMA(0, 0, At, B0); PG8_MMA(0, 1, At, B1); PG8_BAR; PG8_SCHED;
            PG8_LDA(At, 0, 1); PG8_STAGE(PG8_SB(0, 0), b2, voffB); PG8_STAGE(PG8_SB(0, 1), b2 + hstepB, voffB); PG8_STAGE(PG8_SA(0, 0), a2, voffA);
            PG8_WAIT_V(8); PG8_WAIT_L(0); PG8_BAR; PG8_MMA(1, 0, At, B0); PG8_MMA(1, 1, At, B1); PG8_BAR; PG8_SCHED;
            PG8_LDB(B0, 1, 0); PG8_LDB(B1, 1, 1); PG8_SCHED; PG8_LDA(At, 1, 0); PG8_STAGE(PG8_SA(0, 1), a2 + hstepA, voffA);
            PG8_WAIT_V(8); PG8_WAIT_L(0); PG8_BAR; PG8_MMA(0, 0, At, B0); PG8_MMA(0, 1, At, B1); PG8_BAR; PG8_SCHED;
            PG8_LDA(At, 1, 1); PG8_STAGE(PG8_SB(1, 0), b3, voffB); PG8_STAGE(PG8_SB(1, 1), b3 + hstepB, voffB); PG8_STAGE(PG8_SA(1, 0), a3, voffA);
            PG8_WAIT_V(8); PG8_WAIT_L(0); PG8_BAR; PG8_MMA(1, 0, At, B0); PG8_MMA(1, 1, At, B1); PG8_BAR; PG8_SCHED;
        }
        if (wr == 0) PG8_BAR;
        if constexpr (FP8 == 1) { asm volatile("s_nop 15\n\ts_nop 7" ::: "memory"); PG8_SCHED; }
        if constexpr (FP8 == 2) {
            _Pragma("unroll") for (int a = 0; a < 2; ++a) _Pragma("unroll") for (int b = 0; b < 2; ++b) _Pragma("unroll") for (int m = 0; m < 4; ++m) _Pragma("unroll") for (int n = 0; n < 2; ++n)
                acc[a][b][m][n] = __builtin_convertvector(__builtin_bit_cast(i32x4, acc[a][b][m][n]), f32x4); }
        E(acc, cur, wr, wc, fr, fq);
        if (!has_next) break;
#pragma unroll
        for (int a = 0; a < 2; ++a)
#pragma unroll
            for (int b = 0; b < 2; ++b)
#pragma unroll
                for (int m = 0; m < 4; ++m)
#pragma unroll
                    for (int n = 0; n < 2; ++n) acc[a][b][m][n] = (f32x4){0.f, 0.f, 0.f, 0.f};
        cur = nxt; cA = nA; cB = nB; ++ui;
        if (wr == 1) PG8_BAR;
    }
    PG8_WAIT_V(0);
    PG8_BAR;
#undef PG8_SA
#undef PG8_SB
#undef PG8_SBR
#undef PG8_STAGE
#undef PG8_LDA
#undef PG8_LD16
#undef PG8_LDB
#undef PG8_MMA
#undef PG8_WAIT_V
#undef PG8_WAIT_L
#undef PG8_BAR
#undef PG8_SCHED
}
}

#define XB_TMO      128
#define XB_XCNT(j)  (256  + 64 * (j))
#define XB_XSUB(j)  (1280 + 64 * (j))
#define XB_XGEN(j)  (2304 + 64 * (j))
#define XB_TOP      3328
#define XB_TOPGEN   3392
#define XCD_BAR_WORDS 3456
#define XB_SPIN_CAP (1u << 18)

__device__ __forceinline__ unsigned xb_ld(unsigned* p)              { return __hip_atomic_load(p, __ATOMIC_RELAXED, __HIP_MEMORY_SCOPE_AGENT); }
__device__ __forceinline__ unsigned xb_add(unsigned* p, unsigned v) { return __hip_atomic_fetch_add(p, v, __ATOMIC_RELAXED, __HIP_MEMORY_SCOPE_AGENT); }
__device__ __forceinline__ unsigned xb_xcc_id() { return (unsigned)__builtin_amdgcn_s_getreg((3 << 11) | 20) & 0xFu; }
#define XB_SPIN(cond, bar) do { unsigned _sp = 0; while (cond) { __builtin_amdgcn_s_sleep(1); \
    if ((++_sp & 255u) == 0u) { if (xb_ld(&(bar)[XB_TMO])) break; if (_sp > XB_SPIN_CAP) { atomicAdd(&(bar)[XB_TMO], 1u); break; } } } } while (0)

struct XcdBarrier { unsigned* bar; unsigned x; volatile LAS unsigned* st; int wv; };

__device__ __forceinline__ XcdBarrier xcd_barrier_post(unsigned* bar, volatile LAS unsigned* st) {
    XcdBarrier b; b.bar = bar; b.x = xb_xcc_id(); b.st = st;
    if (threadIdx.x == 0) (void)xb_add(&bar[XB_XCNT(b.x)], 1u);
    return b;
}
__device__ __forceinline__ void xcd_barrier_complete(unsigned* bar, unsigned x, unsigned& nloc, unsigned& nx) {
    const unsigned G = gridDim.x * gridDim.y * gridDim.z;
    unsigned sum, cnt, mine, sp = 0u;
    for (;;) {
        sum = 0u; cnt = 0u; mine = 0u;
#pragma unroll
        for (unsigned j = 0; j < 16; ++j) { const unsigned c = xb_ld(&bar[XB_XCNT(j)]); sum += c; cnt += (c > 0u) ? 1u : 0u; mine = (j == x) ? c : mine; }
        if (sum == G) break;
        __builtin_amdgcn_s_sleep(1);
        if ((++sp & 255u) == 0u) { if (xb_ld(&bar[XB_TMO])) break; if (sp > XB_SPIN_CAP) { atomicAdd(&bar[XB_TMO], 1u); break; } }
    }
    nloc = mine > 0u ? mine : 1u; nx = cnt > 0u ? cnt : 1u;
}
__device__ __forceinline__ void xcd_barrier(const XcdBarrier& b) {
    asm volatile("s_waitcnt vmcnt(0)" ::: "memory");
    __syncthreads();
    if (mk_tid(b.wv) == 0) {
        unsigned* bar = b.bar;
        __builtin_amdgcn_s_waitcnt(0);
        unsigned nloc = b.st[0], nx = b.st[1];
        if (nloc == 0u) { xcd_barrier_complete(bar, b.x, nloc, nx); b.st[0] = nloc; b.st[1] = nx; }
        const unsigned old = xb_add(&bar[XB_XSUB(b.x)], 1u);
        const unsigned gen = old / nloc;
        if (old + 1u == (gen + 1u) * nloc) {
            __builtin_amdgcn_fence(__ATOMIC_RELEASE, "agent");
            asm volatile("s_waitcnt vmcnt(0)" ::: "memory");
            const unsigned og = xb_add(&bar[XB_TOP], 1u);
            const unsigned tg = og / nx;
            if (og + 1u == (tg + 1u) * nx) xb_add(&bar[XB_TOPGEN], 1u);
            else XB_SPIN(xb_ld(&bar[XB_TOPGEN]) == tg, bar);
            __builtin_amdgcn_fence(__ATOMIC_ACQUIRE, "agent");
            xb_add(&bar[XB_XGEN(b.x)], 1u);
            asm volatile("s_waitcnt vmcnt(0)" ::: "memory");
        } else {
            XB_SPIN(xb_ld(&bar[XB_XGEN(b.x)]) == gen, bar);
            __builtin_amdgcn_fence(__ATOMIC_ACQUIRE, "agent");
            asm volatile("s_waitcnt vmcnt(0)" ::: "memory");
        }
    }
    __syncthreads();
}

using pg8::Unit;
struct DenseOrder {
    unsigned A, B; int nM, nN, nwg, G, c; unsigned tA, tB;
    __device__ __forceinline__ void init(size_t A_, int lda, size_t B_, int ldb, int M, int N, int G_, int c_) { A = (unsigned)A_; B = (unsigned)B_; nM = M / 256; nN = N / 256; nwg = nM * nN; G = G_; c = c_; tA = 256u * lda * 2; tB = 256u * ldb * 2; }
    __device__ __forceinline__ bool next(int i, Unit& u) const {
        const long L = (long)i * G + c; if (L >= nwg) return false;
        const int w = pg8::xcd_remap((int)L, nwg); pg8::walk2d(w, nM, nN, u.pm, u.pn);
        u.a = A + (unsigned)u.pm * tA; u.b = B + (unsigned)u.pn * tB; u.grp = 0; u.rows = 256; return true;
    }
};
struct A1Order {
    unsigned XB, WQKG, WVT, t; int G, c;
    __device__ __forceinline__ bool next(int i, Unit& u) const {
        const long L = (long)i * G + c; if (L >= 32 * 48) return false;
        const int w = pg8::xcd_remap((int)L, 32 * 48); pg8::walk2d(w, 32, 48, u.pm, u.pn);
        if (u.pn < 32) { u.a = XB + (unsigned)u.pm * t; u.b = WQKG + (unsigned)u.pn * t; } else { u.a = WVT + (unsigned)(u.pn - 32) * t; u.b = XB + (unsigned)u.pm * t; }
        u.grp = 0; u.rows = 256; return true;
    }
};
struct PoolOrder {
    unsigned MIX, W; int G, c;
    __device__ __forceinline__ bool next(int i, Unit& u) const {
        const long L = (long)i * G + c; if (L >= 256) return false;
        const int rem = (int)L & 7; u.pm = (int)L >> 3; u.grp = rem >> 1; u.pn = rem & 1;
        u.a = MIX + ((unsigned)u.pm * 256 * D + (unsigned)u.grp * 512) * 2; u.b = W + ((unsigned)u.grp * 512 * 512 + (unsigned)u.pn * 256 * 512) * 2; u.rows = 256; return true;
    }
};
struct MoeOrder {
    unsigned A, B; int G, c, nN, total; int cnt[8], pre[9]; unsigned eA, eB, tA, tB;
    __device__ __forceinline__ void init(size_t A_, size_t eA_, int lda, size_t B_, size_t eB_, int ldb, int nN_, const unsigned* counts, int G_, int c_, int es = 2) {
        A = (unsigned)A_; B = (unsigned)B_; eA = (unsigned)eA_; eB = (unsigned)eB_; tA = 256u * lda * es; tB = 256u * ldb * es; nN = nN_; G = G_; c = c_;
        int p = 0;
#pragma unroll
        for (int e = 0; e < 8; ++e) { int n = (int)__builtin_amdgcn_readfirstlane(__hip_atomic_load(counts + 64 * e, __ATOMIC_RELAXED, __HIP_MEMORY_SCOPE_AGENT)); n = n > NT ? NT : n; cnt[e] = n; pre[e] = p; p += (n + 255) >> 8; }
        pre[8] = p; total = p * nN;
    }
    __device__ __forceinline__ bool next(int i, Unit& u) const {
        const long L = (long)i * G + c; if (L >= total) return false;
        const int w = pg8::xcd_remap((int)L, total);
        int e = 0;
#pragma unroll
        for (int j = 1; j < 8; ++j) e += (w >= pre[j] * nN) ? 1 : 0;
        int pe = 0, ce = 0, te = 0;
#pragma unroll
        for (int j = 0; j < 8; ++j) { if (j == e) { pe = pre[j]; ce = cnt[j]; te = pre[j + 1] - pre[j]; } }
        pg8::walk2d(w - pe * nN, te, nN, u.pm, u.pn);
        u.grp = e; u.rows = ce - u.pm * 256;
        u.a = A + (unsigned)e * eA + (unsigned)u.pm * tA; u.b = B + (unsigned)e * eB + (unsigned)u.pn * tB; return true;
    }
};

struct EpiA1 {
    bf16_t* QB; bf16_t* KB; bf16_t* GB; bf16_t* VT; const float* COS; const float* SIN; const float* DQ; const float* DKS; float ascale; int r8; const float* SA; const float* SWQ; const float* SWV;
    __device__ __forceinline__ void operator()(const f32x4 (&acc)[2][2][4][2], const Unit& u, int wr, int wc, int fr, int fq) const {
        if (u.pn < 32) {
            const int kind = u.pn < 8 ? 0 : (u.pn < 16 ? 1 : 2), h = u.pn & 7;
#pragma unroll
            for (int ai = 0; ai < 2; ++ai)
#pragma unroll
                for (int m = 0; m < 4; ++m) {
                    const int row = u.pm * 256 + ai * 128 + wr * 64 + m * 16 + fr, pos = row & (SEQ - 1);
                    float rf = ascale; if (kind < 2) rf = ascale * (kind == 0 ? DQ : DKS)[h * 128 + (pos & 127)];
                    if (SA) rf *= SA[row];
#pragma unroll
                    for (int bj = 0; bj < 2; ++bj) {
                        const int cc = bj * 128 + wc * 32 + fq * 8;
                        f32x4 v0 = acc[ai][bj][m][0], v1 = acc[ai][bj][m][1];
                        if (SA) { v0 = v0 * *(const f32x4*)(SWQ + u.pn * 256 + cc); v1 = v1 * *(const f32x4*)(SWQ + u.pn * 256 + cc + 4); }
                        bf16_t* dst;
                        if (kind < 2) {
                            const f32x4 cs = *(const f32x4*)(COS + pos * 128 + (cc >> 1)), sn = *(const f32x4*)(SIN + pos * 128 + (cc >> 1));
                            f32x4 o0, o1;
                            o0[0] = v0[0] * cs[0] - v0[1] * sn[0]; o0[1] = v0[1] * cs[0] + v0[0] * sn[0];
                            o0[2] = v0[2] * cs[1] - v0[3] * sn[1]; o0[3] = v0[3] * cs[1] + v0[2] * sn[1];
                            o1[0] = v1[0] * cs[2] - v1[1] * sn[2]; o1[1] = v1[1] * cs[2] + v1[0] * sn[2];
                            o1[2] = v1[2] * cs[3] - v1[3] * sn[3]; o1[3] = v1[3] * cs[3] + v1[2] * sn[3];
                            v0 = o0 * rf; v1 = o1 * rf;
                            dst = (kind == 0 ? QB : KB) + (size_t)row * QKW + h * 256 + cc;
                        } else { v0 = v0 * rf; v1 = v1 * rf; dst = GB + (size_t)row * VW + (u.pn - 16) * 256 + cc; }
                        if (r8 && kind < 2) { int w0 = 0, w1 = 0; w0 = __builtin_amdgcn_cvt_pk_fp8_f32(v0[0], v0[1], w0, false); w0 = __builtin_amdgcn_cvt_pk_fp8_f32(v0[2], v0[3], w0, true);
                            w1 = __builtin_amdgcn_cvt_pk_fp8_f32(v1[0], v1[1], w1, false); w1 = __builtin_amdgcn_cvt_pk_fp8_f32(v1[2], v1[3], w1, true); u32x2 w; w.x = (unsigned)w0; w.y = (unsigned)w1;
                            *(u32x2*)((unsigned char*)(kind == 0 ? QB : KB) + (size_t)row * QKW + h * 256 + cc) = w; }
                        else { u32x4 w; w.x = cvt_pk_bf16(v0[0], v0[1]); w.y = cvt_pk_bf16(v0[2], v0[3]); w.z = cvt_pk_bf16(v1[0], v1[1]); w.w = cvt_pk_bf16(v1[2], v1[3]);
                            *(u32x4*)dst = w; }
                    }
                }
        } else {
#pragma unroll
            for (int ai = 0; ai < 2; ++ai)
#pragma unroll
                for (int m = 0; m < 4; ++m) {
                    const int vrow = (u.pn - 32) * 256 + ai * 128 + wr * 64 + m * 16 + fr; const float rsv = SA ? ascale * SWV[vrow] : ascale;
#pragma unroll
                    for (int bj = 0; bj < 2; ++bj) {
                        const int tok = u.pm * 256 + bj * 128 + wc * 32 + fq * 8;
                        f32x4 v0 = acc[ai][bj][m][0] * rsv, v1 = acc[ai][bj][m][1] * rsv;
                        if (SA) { v0 = v0 * *(const f32x4*)(SA + tok); v1 = v1 * *(const f32x4*)(SA + tok + 4); }
                        if (r8) { int w0 = 0, w1 = 0; w0 = __builtin_amdgcn_cvt_pk_fp8_f32(v0[0], v0[1], w0, false); w0 = __builtin_amdgcn_cvt_pk_fp8_f32(v0[2], v0[3], w0, true);
                            w1 = __builtin_amdgcn_cvt_pk_fp8_f32(v1[0], v1[1], w1, false); w1 = __builtin_amdgcn_cvt_pk_fp8_f32(v1[2], v1[3], w1, true); u32x2 w; w.x = (unsigned)w0; w.y = (unsigned)w1;
                            *(u32x2*)((unsigned char*)VT + (size_t)vrow * NT + tok) = w; }
                        else { u32x4 w; w.x = cvt_pk_bf16(v0[0], v0[1]); w.y = cvt_pk_bf16(v0[2], v0[3]); w.z = cvt_pk_bf16(v1[0], v1[1]); w.w = cvt_pk_bf16(v1[2], v1[3]);
                            *(u32x4*)(VT + (size_t)vrow * NT + tok) = w; }
                    }
                }
        }
    }
};
struct EpiRes {
    bf16_t* X; bf16_t* XB; float* ROWSS; const float* colscale; int pool; float ascale; unsigned char* XB8;
    __device__ __forceinline__ void operator()(const f32x4 (&acc)[2][2][4][2], const Unit& u, int wr, int wc, int fr, int fq) const {
        const int colbase = pool ? (u.grp * 512 + u.pn * 256) : u.pn * 256;
        f32x4 cs[2][2];
#pragma unroll
        for (int bj = 0; bj < 2; ++bj)
#pragma unroll
            for (int n = 0; n < 2; ++n) cs[bj][n] = (colscale ? *(const f32x4*)(colscale + colbase + bj * 128 + wc * 32 + fq * 8 + n * 4) : (f32x4){1.f, 1.f, 1.f, 1.f}) * ascale;
#pragma unroll
        for (int ai = 0; ai < 2; ++ai)
#pragma unroll
            for (int m = 0; m < 4; ++m) {
                const int row = u.pm * 256 + ai * 128 + wr * 64 + m * 16 + fr;
                float ss = 0.f;
#pragma unroll
                for (int bj = 0; bj < 2; ++bj) {
                    const size_t off = (size_t)row * D + colbase + bj * 128 + wc * 32 + fq * 8;
                    const u32x4 xw = *(const u32x4*)(X + off); const f32x4 x0 = bf4((u32x2){xw.x, xw.y}), x1 = bf4((u32x2){xw.z, xw.w});
                    const f32x4 v0 = x0 + acc[ai][bj][m][0] * cs[bj][0], v1 = x1 + acc[ai][bj][m][1] * cs[bj][1];
                    { u32x4 w; w.x = cvt_pk_bf16(v0[0], v0[1]); w.y = cvt_pk_bf16(v0[2], v0[3]); w.z = cvt_pk_bf16(v1[0], v1[1]); w.w = cvt_pk_bf16(v1[2], v1[3]); *(u32x4*)(X + off) = w; }
                    if (XB) { u32x4 w; w.x = cvt_pk_bf16(v0[0], v0[1]); w.y = cvt_pk_bf16(v0[2], v0[3]); w.z = cvt_pk_bf16(v1[0], v1[1]); w.w = cvt_pk_bf16(v1[2], v1[3]); *(u32x4*)(XB + off) = w; }
                    if (XB8) { int w0 = 0, w1 = 0; w0 = __builtin_amdgcn_cvt_pk_fp8_f32(v0[0], v0[1], w0, false); w0 = __builtin_amdgcn_cvt_pk_fp8_f32(v0[2], v0[3], w0, true);
                        w1 = __builtin_amdgcn_cvt_pk_fp8_f32(v1[0], v1[1], w1, false); w1 = __builtin_amdgcn_cvt_pk_fp8_f32(v1[2], v1[3], w1, true); u32x2 w; w.x = (unsigned)w0; w.y = (unsigned)w1; *(u32x2*)(XB8 + off) = w; }
                    ss += (v0[0] * v0[0] + v0[1] * v0[1]) + (v0[2] * v0[2] + v0[3] * v0[3]) + (v1[0] * v1[0] + v1[1] * v1[1]) + (v1[2] * v1[2] + v1[3] * v1[3]);
                }
                ss += __shfl_xor(ss, 16); ss += __shfl_xor(ss, 32);
                if (fq == 0) ROWSS[(size_t)row * 32 + (colbase >> 8) * 4 + wc] = ss;
                if (m & 1) asm volatile("" ::: "memory");
            }
    }
};
struct EpiZ {
    bf16_t* Z;
    __device__ __forceinline__ void operator()(const f32x4 (&acc)[2][2][4][2], const Unit& u, int wr, int wc, int fr, int fq) const {
#pragma unroll
        for (int ai = 0; ai < 2; ++ai)
#pragma unroll
            for (int m = 0; m < 4; ++m) { const int row = u.pm * 256 + ai * 128 + wr * 64 + m * 16 + fr;
#pragma unroll
                for (int bj = 0; bj < 2; ++bj) { const f32x4 v0 = acc[ai][bj][m][0], v1 = acc[ai][bj][m][1];
                    u32x4 w; w.x = cvt_pk_bf16(v0[0], v0[1]); w.y = cvt_pk_bf16(v0[2], v0[3]); w.z = cvt_pk_bf16(v1[0], v1[1]); w.w = cvt_pk_bf16(v1[2], v1[3]);
                    *(u32x4*)(Z + (size_t)row * D + u.grp * 512 + u.pn * 256 + bj * 128 + wc * 32 + fq * 8) = w; } }
    }
};
struct EpiGU {
    bf16_t* ACT; int ldact; const float* ROWSS; size_t estride;
    __device__ __forceinline__ void operator()(const f32x4 (&acc)[2][2][4][2], const Unit& u, int wr, int wc, int fr, int fq) const {
        bf16_t* base = ACT + (size_t)u.grp * estride;
#pragma unroll
        for (int ai = 0; ai < 2; ++ai)
#pragma unroll
            for (int m = 0; m < 4; ++m) {
                const int row = u.pm * 256 + ai * 128 + wr * 64 + m * 16 + fr;
                float rs = 1.f;
                if (ROWSS) { const f32x4 p0 = *(const f32x4*)(ROWSS + (size_t)row * 32 + fq * 8), p1 = *(const f32x4*)(ROWSS + (size_t)row * 32 + fq * 8 + 4);
                    float s = (p0[0] + p0[1]) + (p0[2] + p0[3]) + (p1[0] + p1[1]) + (p1[2] + p1[3]); s += __shfl_xor(s, 16); s += __shfl_xor(s, 32); rs = __builtin_amdgcn_rsqf(s * (1.0f / D) + EPS); }
                float o[8];
#pragma unroll
                for (int n = 0; n < 2; ++n)
#pragma unroll
                    for (int j = 0; j < 4; ++j) { const float a = acc[ai][0][m][n][j] * rs, g = acc[ai][1][m][n][j] * rs; o[n * 4 + j] = a * fast_sigmoid(a) * g; }
                u32x4 w; w.x = cvt_pk_bf16(o[0], o[1]); w.y = cvt_pk_bf16(o[2], o[3]); w.z = cvt_pk_bf16(o[4], o[5]); w.w = cvt_pk_bf16(o[6], o[7]);
                *(u32x4*)(base + (size_t)row * ldact + u.pn * 128 + wc * 32 + fq * 8) = w;
            }
    }
};
struct EpiGUi8 {
    bf16_t* ACT; int ldact; const float* SA; const float* SW; int out8; size_t estride; int sastride, swstride;
    __device__ __forceinline__ void operator()(const f32x4 (&acc)[2][2][4][2], const Unit& u, int wr, int wc, int fr, int fq) const {
        f32x4 wa[2], wu[2];
#pragma unroll
        for (int n = 0; n < 2; ++n) { wa[n] = *(const f32x4*)(SW + u.grp * swstride + u.pn * 256 + wc * 32 + fq * 8 + n * 4); wu[n] = *(const f32x4*)(SW + u.grp * swstride + u.pn * 256 + 128 + wc * 32 + fq * 8 + n * 4); }
#pragma unroll
        for (int ai = 0; ai < 2; ++ai)
#pragma unroll
            for (int m = 0; m < 4; ++m) {
                const int row = u.pm * 256 + ai * 128 + wr * 64 + m * 16 + fr; const float sa = SA[u.grp * sastride + row];
                float o[8];
#pragma unroll
                for (int n = 0; n < 2; ++n)
#pragma unroll
                    for (int j = 0; j < 4; ++j) { const float a = acc[ai][0][m][n][j] * sa * wa[n][j], g = acc[ai][1][m][n][j] * sa * wu[n][j]; o[n * 4 + j] = a * fast_sigmoid(a) * g; }
                if (out8) { u32x2 w; w.x = 0u; w.y = 0u;
                    w.x = (unsigned)__builtin_amdgcn_cvt_pk_fp8_f32(o[0], o[1], (int)w.x, false); w.x = (unsigned)__builtin_amdgcn_cvt_pk_fp8_f32(o[2], o[3], (int)w.x, true);
                    w.y = (unsigned)__builtin_amdgcn_cvt_pk_fp8_f32(o[4], o[5], (int)w.y, false); w.y = (unsigned)__builtin_amdgcn_cvt_pk_fp8_f32(o[6], o[7], (int)w.y, true);
                    *(u32x2*)((unsigned char*)ACT + (size_t)u.grp * estride + (size_t)row * ldact + u.pn * 128 + wc * 32 + fq * 8) = w; }
                else { u32x4 w; w.x = cvt_pk_bf16(o[0], o[1]); w.y = cvt_pk_bf16(o[2], o[3]); w.z = cvt_pk_bf16(o[4], o[5]); w.w = cvt_pk_bf16(o[6], o[7]);
                    *(u32x4*)(ACT + (size_t)row * ldact + u.pn * 128 + wc * 32 + fq * 8) = w; }
            }
    }
};
struct EpiGU8 {
    unsigned char* ACT; int ldact; size_t estride; float s; const float* ROWSS;
    __device__ __forceinline__ void operator()(const f32x4 (&acc)[2][2][4][2], const Unit& u, int wr, int wc, int fr, int fq) const {
        unsigned char* base = ACT + (size_t)u.grp * estride;
#pragma unroll
        for (int ai = 0; ai < 2; ++ai)
#pragma unroll
            for (int m = 0; m < 4; ++m) {
                const int row = u.pm * 256 + ai * 128 + wr * 64 + m * 16 + fr;
                float rs = s;
                if (ROWSS) { const f32x4 p0 = *(const f32x4*)(ROWSS + (size_t)row * 32 + fq * 8), p1 = *(const f32x4*)(ROWSS + (size_t)row * 32 + fq * 8 + 4);
                    float q = (p0[0] + p0[1]) + (p0[2] + p0[3]) + (p1[0] + p1[1]) + (p1[2] + p1[3]); q += __shfl_xor(q, 16); q += __shfl_xor(q, 32); rs = s * __builtin_amdgcn_rsqf(q * (1.0f / D) + EPS); }
                float o[8];
#pragma unroll
                for (int n = 0; n < 2; ++n)
#pragma unroll
                    for (int j = 0; j < 4; ++j) { const float a = acc[ai][0][m][n][j] * rs, g = acc[ai][1][m][n][j] * rs; o[n * 4 + j] = a * fast_sigmoid(a) * g; }
                u32x2 w; w.x = 0u; w.y = 0u;
                w.x = (unsigned)__builtin_amdgcn_cvt_pk_fp8_f32(o[0], o[1], (int)w.x, false); w.x = (unsigned)__builtin_amdgcn_cvt_pk_fp8_f32(o[2], o[3], (int)w.x, true);
                w.y = (unsigned)__builtin_amdgcn_cvt_pk_fp8_f32(o[4], o[5], (int)w.y, false); w.y = (unsigned)__builtin_amdgcn_cvt_pk_fp8_f32(o[6], o[7], (int)w.y, true);
                *(u32x2*)(base + (size_t)row * ldact + u.pn * 128 + wc * 32 + fq * 8) = w;
            }
    }
};
struct EpiMoeDown {
    bf16_t* Y; const int* TOK; const float* GATE; float wscale;
    __device__ __forceinline__ void operator()(const f32x4 (&acc)[2][2][4][2], const Unit& u, int wr, int wc, int fr, int fq) const {
#pragma unroll
        for (int ai = 0; ai < 2; ++ai)
#pragma unroll
            for (int m = 0; m < 4; ++m) {
                const int rloc = ai * 128 + wr * 64 + m * 16 + fr;
                if (rloc < u.rows) {
                    const int gi = u.grp * NT + u.pm * 256 + rloc; const int t2 = TOK[gi]; const float gt = GATE[gi] * wscale;
                    bf16_t* dst = Y + ((size_t)(t2 & 1) * NT + (size_t)(t2 >> 1)) * D + u.pn * 256 + wc * 32 + fq * 8;
#pragma unroll
                    for (int bj = 0; bj < 2; ++bj) { const f32x4 v0 = acc[ai][bj][m][0] * gt, v1 = acc[ai][bj][m][1] * gt;
                        u32x4 w; w.x = cvt_pk_bf16(v0[0], v0[1]); w.y = cvt_pk_bf16(v0[2], v0[3]); w.z = cvt_pk_bf16(v1[0], v1[1]); w.w = cvt_pk_bf16(v1[2], v1[3]);
                        *(u32x4*)(dst + bj * 128) = w; }
                }
            }
    }
};

struct Frame {
    LAS unsigned char* lds; int tid, lane, wave, G, bid, wv;
    float* out; unsigned char* ws;
};
struct Params { const float* in[14]; float* out; unsigned char* ws; int ph_lo, ph_hi; };

struct TrItem { const float* src; unsigned char* dst; const float* ks; int srcld, dstpitch, f8; };
__device__ __forceinline__ TrItem tr_make(int r, const float* src, int srcld, int K, int col_begin, int ncols, void* dst, int row_begin, int mode, const float* kscale, int f8 = 0, int pitch8 = 0) {
    const int nb = ncols / 64, g = r >> 2, tq = r & 3, kb = 2 * (g / (nb >> 1)) + (tq >> 1), jb = 2 * (g % (nb >> 1)) + (tq & 1), j0 = jb * 64, k0 = kb * 64;
    const int drow = mode ? (256 * (j0 >> 7) + (j0 & 127) + row_begin) : (row_begin + j0);
    TrItem t; t.src = src + (size_t)k0 * srcld + col_begin + j0; t.ks = kscale ? kscale + k0 : nullptr; t.srcld = srcld;
    if (f8) { t.dst = (unsigned char*)dst + (size_t)drow * pitch8 + k0; t.dstpitch = pitch8; t.f8 = (f8 == 2 && kb == K / 64 - 1) ? 2 : 1; }
    else { t.dst = (unsigned char*)dst + ((size_t)drow * K + k0) * 2; t.dstpitch = K * 2; t.f8 = 0; }
    return t;
}
constexpr int IT_A = 2048 * 4 + 2816 * 3, IT_B = 256 + 5632 * 3;
__device__ __forceinline__ TrItem conv_item_A(const Params& PA, unsigned char* ws, int l, int r) {
    const float* w_in = PA.in[1] + (size_t)l * D * 12288; const float* gm = PA.in[11] + (size_t)(2 * l) * D; const float* gf = PA.in[12] + (size_t)(2 * l) * D;
    bf16_t* WQKG = (bf16_t*)(ws + WS_WQKG + l * SZ_WQKG); bf16_t* WVT = (bf16_t*)(ws + WS_WVT + l * SZ_WVT);
    const int p8 = (PROJ8 >> l) & 1;
    if (r < 2048) return tr_make(r, w_in, 12288, D, 0, 4096, WQKG, 0, 0, gm, p8, D); r -= 2048;
    if (r < 2048) return tr_make(r, w_in, 12288, D, 8192, 4096, WQKG, 4096, 0, gm, p8, D); r -= 2048;
    if (r < 2048) return tr_make(r, w_in, 12288, D, 4096, 4096, WVT, 0, 0, gm, p8, D); r -= 2048;
    if (r < 2048) return tr_make(r, PA.in[3] + (size_t)l * VW * D, D, VW, 0, D, (bf16_t*)(ws + WS_WOUT + l * SZ_WOUT), 0, 0, nullptr, p8, VW); r -= 2048;
    const float* gu = PA.in[6] + (size_t)l * D * 2 * FF; bf16_t* WGU = (bf16_t*)(ws + WS_WGU + l * SZ_WGU); const int d8 = (DENSE8 >> l) & 1;
    if (r < 2816) return tr_make(r, gu, 2 * FF, D, 0, FF, WGU, 0, 1, gf, d8, D); r -= 2816;
    if (r < 2816) return tr_make(r, gu, 2 * FF, D, FF, FF, WGU, 128, 1, gf, d8, D); r -= 2816;
    return tr_make(r, PA.in[7] + (size_t)l * FF * D, D, FF, 0, D, (bf16_t*)(ws + WS_WDN + l * SZ_WDN), 0, 0, nullptr, d8, FF);
}
__device__ __forceinline__ TrItem conv_item_B(const Params& PA, unsigned char* ws, int l, int r) {
    if (r < 256) { const int g = r >> 6; return tr_make(r & 63, PA.in[4] + ((size_t)l * 4 + g) * 512 * 512, 512, 512, 0, 512, (bf16_t*)(ws + WS_WPOOL + l * SZ_WPOOL) + (size_t)g * 512 * 512, 0, 0, PA.in[11] + (size_t)(2 * l + 1) * D + g * 512); } r -= 256;
    const int f8 = (F8MASK >> l) & 1;
    if (r < 5632) { const int e = r / 704; unsigned char* d = ws + WS_WMGU + l * SZ_WMGU + (size_t)e * 2 * FE * D * (f8 ? 1 : 2); return tr_make(r % 704, PA.in[9] + ((size_t)l * NE + e) * D * 2 * FE, 2 * FE, D, 0, FE, d, 0, 1, nullptr, f8, D); } r -= 5632;
    if (r < 5632) { const int e = r / 704; unsigned char* d = ws + WS_WMGU + l * SZ_WMGU + (size_t)e * 2 * FE * D * (f8 ? 1 : 2); return tr_make(r % 704, PA.in[9] + ((size_t)l * NE + e) * D * 2 * FE, 2 * FE, D, FE, FE, d, 128, 1, nullptr, f8, D); } r -= 5632;
    { const int e = r / 704; unsigned char* d = ws + WS_WMDN + l * SZ_WMDN + (size_t)e * D * (f8 ? FE8 : FE * 2); return tr_make(r % 704, PA.in[10] + ((size_t)l * NE + e) * FE * D, D, FE, 0, D, d, 0, 0, nullptr, f8 ? 2 : 0, FE8); }
}
__device__ __forceinline__ int conv_batch_size(int b) { return b == 0 ? (IT_A - ((I8A1 & 1) ? 6144 : 0) - ((I8A4 & 1) ? 5632 : 0)) : b == 1 ? ((I8B4 & 1) ? 256 : 11520) : b == 2 ? (5632 + 8192 - ((I8A1 & 2) ? 6144 : 0)) : b == 3 ? (8448 + 256 + 5632) : ((I8B4 & 2) ? 0 : 11264); }
__device__ __forceinline__ TrItem conv_batch_item(const Params& PA, unsigned char* ws, int b, int r) {
    if (b == 0) { if (I8A1 & 1) r += 6144; if ((I8A4 & 1) && r >= 8192) r += 5632; return conv_item_A(PA, ws, 0, r); }
    if (b == 1) return conv_item_B(PA, ws, 0, r);
    if (b == 2) { if (r < 5632) return conv_item_B(PA, ws, 0, 11520 + r); return conv_item_A(PA, ws, 1, r - 5632 + ((I8A1 & 2) ? 6144 : 0)); }
    if (b == 3) { if (r < 8448) return conv_item_A(PA, ws, 1, 8192 + r); if (r < 8448 + 256) return conv_item_B(PA, ws, 1, r - 8448); return conv_item_B(PA, ws, 1, 11520 + (r - 8448 - 256)); }
    return conv_item_B(PA, ws, 1, 256 + r);
}
__device__ __forceinline__ void tr_load(const TrItem& t, f32x4 (&v)[16], int lane) {
#pragma unroll
    for (int it = 0; it < 16; ++it) { const int kk = it * 4 + (lane >> 4), cc = (lane & 15) * 4; v[it] = *(const f32x4*)(t.src + (size_t)kk * t.srcld + cc); }
}
__device__ __forceinline__ void tr_process(const TrItem& t, const f32x4 (&v)[16], LAS float* scr, int lane) {
    const int c = lane & 7;
    f32x4 k0 = (f32x4){1.f, 1.f, 1.f, 1.f}, k1 = k0; if (t.ks) { k0 = *(const f32x4*)(t.ks + 8 * c); k1 = *(const f32x4*)(t.ks + 8 * c + 4); }
    if (t.f8) { k0 = k0 * 32.0f; k1 = k1 * 32.0f; }
#pragma unroll
    for (int it = 0; it < 16; ++it) { const int kk = it * 4 + (lane >> 4), cc = (lane & 15) * 4;
        LAS float* p = scr + kk * 65 + cc; p[0] = v[it][0]; p[1] = v[it][1]; p[2] = v[it][2]; p[3] = v[it][3]; }
    LDS_WAIT(); asm volatile("" ::: "memory");
    if (t.f8 == 0) {
#pragma unroll
        for (int it = 0; it < 8; ++it) { const int n = it * 8 + (lane >> 3); const LAS float* s = scr + (8 * c) * 65 + n;
            u32x4 o; o.x = cvt_pk_bf16(s[0] * k0[0], s[65] * k0[1]); o.y = cvt_pk_bf16(s[2 * 65] * k0[2], s[3 * 65] * k0[3]); o.z = cvt_pk_bf16(s[4 * 65] * k1[0], s[5 * 65] * k1[1]); o.w = cvt_pk_bf16(s[6 * 65] * k1[2], s[7 * 65] * k1[3]);
            *(u32x4*)(t.dst + (size_t)n * t.dstpitch + 16 * c) = o; }
    } else {
#pragma unroll
        for (int it = 0; it < 8; ++it) { const int n = it * 8 + (lane >> 3); const LAS float* s = scr + (8 * c) * 65 + n;
            int w0 = 0, w1 = 0;
            w0 = __builtin_amdgcn_cvt_pk_fp8_f32(s[0] * k0[0], s[65] * k0[1], w0, false); w0 = __builtin_amdgcn_cvt_pk_fp8_f32(s[2 * 65] * k0[2], s[3 * 65] * k0[3], w0, true);
            w1 = __builtin_amdgcn_cvt_pk_fp8_f32(s[4 * 65] * k1[0], s[5 * 65] * k1[1], w1, false); w1 = __builtin_amdgcn_cvt_pk_fp8_f32(s[6 * 65] * k1[2], s[7 * 65] * k1[3], w1, true);
            u32x2 o; o.x = (unsigned)w0; o.y = (unsigned)w1;
            *(u32x2*)(t.dst + (size_t)n * t.dstpitch + 8 * c) = o;
            if (t.f8 == 2) *(u32x4*)(t.dst + (size_t)n * t.dstpitch + 64 + 16 * c) = (u32x4){0u, 0u, 0u, 0u}; }
    }
    LDS_WAIT(); asm volatile("" ::: "memory");
}
__device__ __forceinline__ void conv_queue(Frame& F_, const Params& PA, int b) {
    Frame F = F_; { int t_ = mk_tid(F_.wv); asm volatile("" : "+v"(t_)); F.tid = t_; F.lane = t_ & 63; F.wave = __builtin_amdgcn_readfirstlane(t_ >> 6); }
    LAS float* scr = (LAS float*)(F.lds + F.wave * 16640);
    unsigned* qb = (unsigned*)(F.ws + WS_CTL) + CW_Q + 512 * b; const int n = conv_batch_size(b), per = n / 8;
    for (int k = 0; k < 8; ++k) {
        const int sq = (F.bid + k) & 7; unsigned* q = qb + 64 * sq;
        for (;;) {
            unsigned r = 0; if (F.lane == 0) r = __hip_atomic_fetch_add(q, 4u, __ATOMIC_RELAXED, __HIP_MEMORY_SCOPE_AGENT);
            r = (unsigned)__builtin_amdgcn_readfirstlane((int)r);
            if (r >= (unsigned)per) break;
            const int base = sq * per + (int)r;
            f32x4 va[16], vb[16];
            TrItem ta = conv_batch_item(PA, F.ws, b, base), tb = conv_batch_item(PA, F.ws, b, base + 1);
            tr_load(ta, va, F.lane); tr_load(tb, vb, F.lane);
            tr_process(ta, va, scr, F.lane); ta = conv_batch_item(PA, F.ws, b, base + 2); tr_load(ta, va, F.lane);
            tr_process(tb, vb, scr, F.lane); tb = conv_batch_item(PA, F.ws, b, base + 3); tr_load(tb, vb, F.lane);
            tr_process(ta, va, scr, F.lane);
            tr_process(tb, vb, scr, F.lane);
        }
    }
}
__device__ __forceinline__ int pack_i8x4(f32x4 v) {
    const int a = (int)rintf(v[0]), b = (int)rintf(v[1]), c = (int)rintf(v[2]), d = (int)rintf(v[3]);
    return (a & 0xff) | ((b & 0xff) << 8) | ((c & 0xff) << 16) | (d << 24);
}
__device__ __forceinline__ float wave_max(float v) {
#pragma unroll
    for (int o = 1; o < 64; o <<= 1) v = fmaxf(v, __shfl_xor(v, o));
    return v;
}
struct StripJob { const float* src; const float* ks; unsigned char* dst; float* sw; int srcld; };
__device__ __forceinline__ StripJob strip_make(const Params& PA, unsigned char* ws, int l, int st) {
    StripJob J;
    if (st < 384) { const int c0 = st * 32; J.srcld = 12288; J.src = PA.in[1] + (size_t)l * D * 12288 + c0; J.ks = PA.in[11] + (size_t)(2 * l) * D;
        J.dst = c0 < 4096 ? ws + WS_WQKG + l * SZ_WQKG + (size_t)c0 * D : (c0 < 8192 ? ws + WS_WVT + l * SZ_WVT + (size_t)(c0 - 4096) * D : ws + WS_WQKG + l * SZ_WQKG + (size_t)(c0 - 4096) * D);
        J.sw = c0 < 4096 ? (float*)(ws + WS_SWQ + l * SZ_SWL) + c0 : (c0 < 8192 ? (float*)(ws + WS_SWV + l * SZ_SWL) + (c0 - 4096) : (float*)(ws + WS_SWQ + l * SZ_SWL) + (c0 - 4096));
    } else if (st < 736) { const int s4 = st - 384, part = s4 / 176, j0 = (s4 % 176) * 32, drow = 256 * (j0 >> 7) + (j0 & 127) + 128 * part; J.srcld = 2 * FF;
        J.src = PA.in[6] + (size_t)l * D * 2 * FF + part * FF + j0; J.ks = PA.in[12] + (size_t)(2 * l) * D; J.dst = ws + WS_WGU + l * SZ_WGU + (size_t)drow * D; J.sw = (float*)(ws + WS_SWGU + l * SZ_SWL) + drow;
    } else { const int sm = st - 736, e = sm / 88, s4 = sm % 88, part = s4 / 44, j0 = (s4 % 44) * 32, drow = 256 * (j0 >> 7) + (j0 & 127) + 128 * part; J.srcld = 2 * FE;
        J.src = PA.in[9] + ((size_t)l * NE + e) * D * 2 * FE + part * FE + j0; J.ks = nullptr; J.dst = ws + WS_WMGU + l * SZ_WMGU + (size_t)e * 2 * FE * D + (size_t)drow * D; J.sw = (float*)(ws + WS_SWM) + (l * NE + e) * 2 * FE + drow; }
    return J;
}
template <bool DYN>
__device__ __forceinline__ void strip_loop(Frame& F_, const Params& PA, int l, int first, int end, int step, int base, int qi) {
    Frame F = F_; { int t_ = mk_tid(F_.wv); asm volatile("" : "+v"(t_)); F.tid = t_; F.lane = t_ & 63; F.wave = __builtin_amdgcn_readfirstlane(t_ >> 6); }
    constexpr int PITCH = 4104;
    LAS unsigned char* T = F.lds;
    LAS float* smax = (LAS float*)(F.lds + MISC_OFF + 1024);
    LAS float* cfin = smax + 256;
    volatile LAS unsigned* slot = (volatile LAS unsigned*)(F.lds + MISC_OFF + 512);
    unsigned* q = (unsigned*)(F.ws + WS_CTL) + CW_Q + 512 * 5 + 64 * qi;
    const int lane = F.lane, cq = lane & 7, r8 = lane >> 3;
    int st = first;
    if (DYN) { if (F.tid == 0) slot[0] = __hip_atomic_fetch_add(q, 1u, __ATOMIC_RELAXED, __HIP_MEMORY_SCOPE_AGENT);
        __syncthreads(); st = (int)slot[0]; __syncthreads(); }
    if (st >= end) return;
    StripJob J = strip_make(PA, F.ws, l, base + st);
    u32x4 va[16], vb[16]; float gq[4];
#define W8_ISSUE(JJ, LIVE) do { const __amdgpu_buffer_rsrc_t rs_ = __builtin_amdgcn_make_buffer_rsrc((void*)(JJ).src, 0, (LIVE) ? (D - 1) * (JJ).srcld * 4 + 128 : 0, 0x00020000);     \
        const int voff_ = (r8 * (JJ).srcld + 4 * cq) * 4, sbase_ = F.wave * 256 * (JJ).srcld * 4, sstep_ = 8 * (JJ).srcld * 4; \
        { const float* ksp_ = (JJ).ks ? (JJ).ks : PA.in[11]; const float one_ = (JJ).ks ? 0.0f : 1.0f, keep_ = (JJ).ks ? 1.0f : 0.0f;     \
          _Pragma("unroll") for (int t = 0; t < 4; ++t) gq[t] = ksp_[F.wave * 256 + t * 64 + lane] * keep_ + one_; } \
        _Pragma("unroll") for (int it = 0; it < 16; ++it) va[it] = __builtin_amdgcn_raw_buffer_load_b128(rs_, voff_, sbase_ + it * sstep_, 0); \
        _Pragma("unroll") for (int it = 0; it < 16; ++it) vb[it] = __builtin_amdgcn_raw_buffer_load_b128(rs_, voff_, sbase_ + (16 + it) * sstep_, 0); } while (0)
    W8_ISSUE(J, true);
    for (;;) {
        f32x4 cm = (f32x4){0.f, 0.f, 0.f, 0.f};
#pragma unroll
        for (int ch = 0; ch < 2; ++ch)
#pragma unroll
            for (int it = 0; it < 16; ++it) { const int j = ch * 16 + it, kk = F.wave * 256 + j * 8 + r8;
                const float g = __shfl(gq[j >> 3], (j & 7) * 8 + r8);
                const f32x4 w = __builtin_bit_cast(f32x4, ch ? vb[it] : va[it]) * g;
                cm[0] = fmaxf(cm[0], fabsf(w[0])); cm[1] = fmaxf(cm[1], fabsf(w[1])); cm[2] = fmaxf(cm[2], fabsf(w[2])); cm[3] = fmaxf(cm[3], fabsf(w[3]));
                const unsigned p01 = cvt_pk_bf16(w[0], w[1]), p23 = cvt_pk_bf16(w[2], w[3]);
                LAS unsigned short* p = (LAS unsigned short*)(T + (4 * cq) * PITCH + kk * 2);
                p[0] = (unsigned short)p01; p[PITCH / 2] = (unsigned short)(p01 >> 16); p[PITCH] = (unsigned short)p23; p[3 * PITCH / 2] = (unsigned short)(p23 >> 16); }
        if (DYN) { if (F.tid == 0) slot[0] = __hip_atomic_fetch_add(q, 1u, __ATOMIC_RELAXED, __HIP_MEMORY_SCOPE_AGENT); }
#pragma unroll
        for (int j = 0; j < 4; ++j) { cm[j] = fmaxf(cm[j], __shfl_xor(cm[j], 8)); cm[j] = fmaxf(cm[j], __shfl_xor(cm[j], 16)); cm[j] = fmaxf(cm[j], __shfl_xor(cm[j], 32)); }
        if (lane < 8) { LAS float* p = smax + F.wave * 32 + lane * 4; p[0] = cm[0]; p[1] = cm[1]; p[2] = cm[2]; p[3] = cm[3]; }
        LDS_WAIT(); __syncthreads();
        const int nx = DYN ? (int)slot[0] : st + step;
        const bool has = nx < end;
        const StripJob Jn = strip_make(PA, F.ws, l, base + (has ? nx : st));
        W8_ISSUE(Jn, has);
        if (F.tid < 32) { float m = 1e-30f;
#pragma unroll
            for (int w = 0; w < 8; ++w) m = fmaxf(m, smax[w * 32 + F.tid]);
            cfin[F.tid] = m; J.sw[F.tid] = m * (1.0f / 127.0f); }
        LDS_WAIT(); __syncthreads();
#pragma unroll
        for (int rr = 0; rr < 4; ++rr) { const int c = F.wave * 4 + rr; const float qs = 127.0f / cfin[c];
#pragma unroll
            for (int i = 0; i < 4; ++i) { const int k0 = (i * 64 + lane) * 8;
                const u32x2 a = *(const LAS u32x2*)(T + c * PITCH + k0 * 2), b = *(const LAS u32x2*)(T + c * PITCH + k0 * 2 + 8);
                u32x2 o; o.x = (unsigned)pack_i8x4(bf4(a) * qs); o.y = (unsigned)pack_i8x4(bf4(b) * qs);
                *(u32x2*)(J.dst + (size_t)c * D + k0) = o; } }
        LDS_WAIT(); __syncthreads();
        if (!has) break;
        J = Jn; st = nx;
    }
#undef W8_ISSUE
}
__device__ __forceinline__ void p0_prologue(Frame& F_, const Params& PA) {
    Frame F = F_; { int t_ = mk_tid(F_.wv); asm volatile("" : "+v"(t_)); F.tid = t_; F.lane = t_ & 63; F.wave = __builtin_amdgcn_readfirstlane(t_ >> 6); }
    unsigned char* ws = F.ws;
    const int gw = F.bid * 8 + F.wave, NGW = F.G * 8;
    {
        const int n1 = (I8A1 & 1) ? 384 : 0, n4 = (I8A4 & 1) ? 352 : 0;
        if (n1 + n4 > 0) strip_loop<false>(F_, PA, 0, F.bid, n1 + n4, F.G, (I8A1 & 1) ? 0 : 384, 0);
    }
    conv_queue(F_, PA, 0);
    bf16_t* X = (bf16_t*)(ws + WS_X); bf16_t* XB = (bf16_t*)(ws + WS_XB);
    for (int row = gw; row < NT; row += NGW) {
        const f32x4* xr = (const f32x4*)(PA.in[0] + (size_t)row * D) + F.lane; f32x4 v[8]; float s = 0.f;
#pragma unroll
        for (int j = 0; j < 8; ++j) { v[j] = xr[64 * j]; s += (v[j][0] * v[j][0] + v[j][1] * v[j][1]) + (v[j][2] * v[j][2] + v[j][3] * v[j][3]); }
        const float inv = 1.0f / sqrtf(wave_sum(s) * (1.0f / D) + EPS);
        if (I8A1 & 1) {
            float mx = 0.f;
#pragma unroll
            for (int j = 0; j < 8; ++j) mx = fmaxf(mx, fmaxf(fmaxf(fabsf(v[j][0]), fabsf(v[j][1])), fmaxf(fabsf(v[j][2]), fabsf(v[j][3]))));
            mx = fmaxf(wave_max(mx) * inv, 1e-20f); const float q = inv * 127.0f / mx;
#pragma unroll
            for (int j = 0; j < 8; ++j) { { u32x2 w; w.x = cvt_pk_bf16(v[j][0], v[j][1]); w.y = cvt_pk_bf16(v[j][2], v[j][3]); ((u32x2*)(X + (size_t)row * D) + F.lane)[64 * j] = w; }
                ((int*)((unsigned char*)XB + (size_t)row * D) + F.lane)[64 * j] = pack_i8x4(v[j] * q); }
            if (F.lane == 0) ((float*)(ws + WS_SA))[row] = mx * (1.0f / 127.0f);
        } else
#pragma unroll
        for (int j = 0; j < 8; ++j) { { u32x2 w; w.x = cvt_pk_bf16(v[j][0], v[j][1]); w.y = cvt_pk_bf16(v[j][2], v[j][3]); ((u32x2*)(X + (size_t)row * D) + F.lane)[64 * j] = w; }
            u32x2 w; w.x = cvt_pk_bf16(v[j][0] * inv, v[j][1] * inv); w.y = cvt_pk_bf16(v[j][2] * inv, v[j][3] * inv); ((u32x2*)(XB + (size_t)row * D) + F.lane)[64 * j] = w; }
    }
    float* COS = (float*)(ws + WS_COS); float* SIN = (float*)(ws + WS_SIN);
    for (int i = F.bid * 512 + F.tid; i < SEQ * 128; i += F.G * 512) { const int pos = i >> 7, p = i & 127;
        const float t = (float)p / 127.0f; const float fr = 1.0f / powf(10000.0f, t); const float ang = (float)pos * fr;
        COS[i] = (float)cos((double)ang); SIN[i] = (float)sin((double)ang); }
    if (F.bid == 0) { float* DQ = (float*)(ws + WS_DQ); float* DKS = (float*)(ws + WS_DKS);
        for (int i = F.tid; i < NH * 128; i += 512) { const int h = i >> 7, j = i & 127; const double lg = log1p(-exp2(-5.0 - (double)h));
            DQ[i] = (float)exp((double)j * lg); DKS[i] = (float)(exp(-(double)j * lg) * 0.0625);
            ((float*)(ws + WS_DQ8))[i] = (float)exp((double)(j - 64) * lg); ((float*)(ws + WS_DKS8))[i] = (float)(exp((double)(64 - j) * lg) * 0.0625); if (j == 0) ((float*)(ws + WS_LG2))[h] = (float)(lg * 1.4426950408889634); } }
}

__device__ __forceinline__ void retention_phase(Frame& F, const bf16_t* QB, const bf16_t* KB, const bf16_t* VT, const bf16_t* GB, const float* normg, bf16_t* OG, const int og8) {
    using namespace pg8;
    LAS unsigned char* lds = F.lds;
    int tid = mk_tid(F.wv); asm volatile("" : "+v"(tid));
    const int wid = __builtin_amdgcn_readfirstlane(tid >> 6), lane = tid & 63, wr = wid >> 2, wc = wid & 3;
    unsigned voffQ[2], voffV[2];
#pragma unroll
    for (int i = 0; i < 2; ++i) { int R, C; stage_rc(tid * 16 + i * 8192, R, C); const int Rb = (R & ~31) + perm32(R & 31);
        voffQ[i] = (unsigned)(R * QKW + C) * 2u; voffV[i] = (unsigned)(Rb * NT + C) * 2u; }
    const unsigned ldsw = (unsigned)wid * 1024u;
    const int aoff = lds_byte(wr * 64 + (lane & 15), (lane >> 4) * 8), boff = lds_byte(wc * 32 + (lane & 15), (lane >> 4) * 8);
    constexpr int PIMG = 6 * HTB;
    LAS float* red = (LAS float*)(lds + MISC_OFF + 256);
    const __amdgpu_buffer_rsrc_t rsQ = __builtin_amdgcn_make_buffer_rsrc((void*)QB, 0, NT * QKW * 2, 0x00020000);
    const __amdgpu_buffer_rsrc_t rsK = __builtin_amdgcn_make_buffer_rsrc((void*)KB, 0, NT * QKW * 2, 0x00020000);
    const __amdgpu_buffer_rsrc_t rsV = __builtin_amdgcn_make_buffer_rsrc((void*)VT, 0, VW * NT * 2, 0x00020000);
#define RT_STAGE(bufoff, rsrc, soff, voff) do { _Pragma("unroll") for (int _i = 0; _i < 2; ++_i) \
        __builtin_amdgcn_raw_ptr_buffer_load_lds((rsrc), (LAS unsigned*)(lds + (bufoff) + ldsw + _i * 8192), 16, (voff)[_i], (soff), 0, 0); } while (0)
#define RT_BAR __builtin_amdgcn_s_barrier()
    for (int it = F.bid; it < 256; it += F.G) {
        const int item = (it & 7) * 32 + (it >> 3);
        const int b = item >> 6, h = (item >> 3) & 7, x = item & 7;
        const float lg2 = ((const float*)(F.ws + WS_LG2))[h];
        const int koff = (b * SEQ * QKW + h * DK) * 2, voff0 = (h * DV * NT + b * SEQ) * 2;
        for (int qs = 0; qs < 2; ++qs) {
            const int qc = qs == 0 ? 15 - x : x, nkv = qc + 1, total = 8 * nkv;
            const int qoff = ((b * SEQ + qc * 128) * QKW + h * DK) * 2;
            f32x4 O[4][4][2], P[4][2];
#pragma unroll
            for (int c = 0; c < 4; ++c)
#pragma unroll
                for (int m = 0; m < 4; ++m)
#pragma unroll
                    for (int n = 0; n < 2; ++n) O[c][m][n] = (f32x4){0.f, 0.f, 0.f, 0.f};
#define RT_STAGE_STEP(sv) do { const int _s = (sv); const int _kt = _s >> 3, _sub = _s & 7, _bo = (_s % 3) * 2 * HTB; \
                if (_sub < 4) { RT_STAGE(_bo, rsQ, qoff + _sub * 128, voffQ); RT_STAGE(_bo + HTB, rsK, koff + _kt * (128 * QKW * 2) + _sub * 128, voffQ); } \
                else { const int _vo = voff0 + (_sub - 4) * (128 * NT * 2) + _kt * 256; RT_STAGE(_bo, rsV, _vo, voffV); RT_STAGE(_bo + HTB, rsV, _vo + 128, voffV); } } while (0)
            RT_STAGE_STEP(0); RT_STAGE_STEP(1);
            asm volatile("s_waitcnt vmcnt(4)" ::: "memory"); RT_BAR;
            int s = 0;
            for (int kt = 0; kt < nkv; ++kt) {
                const float tscale = __builtin_amdgcn_exp2f((float)(128 * (qc - kt)) * lg2);
                const bool diag = (kt == qc);
#pragma unroll
                for (int sub = 0; sub < 8; ++sub, ++s) {
                    __builtin_amdgcn_sched_barrier(0);
                    if (s + 2 < total) RT_STAGE_STEP(s + 2);
                    const int bo = (s % 3) * 2 * HTB;
                    if (sub < 4) {
                        if (sub == 0) {
#pragma unroll
                            for (int m = 0; m < 4; ++m)
#pragma unroll
                                for (int n = 0; n < 2; ++n) P[m][n] = (f32x4){0.f, 0.f, 0.f, 0.f};
                        }
                        bf16x8 Bt[2][2];
#pragma unroll
                        for (int n = 0; n < 2; ++n)
#pragma unroll
                            for (int k = 0; k < 2; ++k) Bt[n][k] = *(const LAS bf16x8*)(lds + bo + HTB + boff + n * 2048 + k * 1024);
#pragma unroll
                        for (int mh = 0; mh < 2; ++mh) {
                            bf16x8 At[2][2];
#pragma unroll
                            for (int m = 0; m < 2; ++m)
#pragma unroll
                                for (int k = 0; k < 2; ++k) At[m][k] = *(const LAS bf16x8*)(lds + bo + aoff + (mh * 2 + m) * 2048 + k * 1024);
#pragma unroll
                            for (int m = 0; m < 2; ++m)
#pragma unroll
                                for (int n = 0; n < 2; ++n)
#pragma unroll
                                    for (int k = 0; k < 2; ++k) P[mh * 2 + m][n] = __builtin_amdgcn_mfma_f32_16x16x32_bf16(Bt[n][k], At[m][k], P[mh * 2 + m][n], 0, 0, 0);
                            __builtin_amdgcn_sched_barrier(0);
                        }
                        if (sub == 3) {
                            int ln = lane; asm volatile("" : "+v"(ln)); const int fr = ln & 15, fq = ln >> 4;
#pragma unroll
                            for (int m = 0; m < 4; ++m) { const int i = wr * 64 + m * 16 + fr;
#pragma unroll
                                for (int n = 0; n < 2; ++n) { const int j0 = wc * 32 + n * 16 + fq * 4; f32x4 v = P[m][n] * tscale;
                                    if (diag) { int dd = i - j0; asm volatile("" : "+v"(dd));
#pragma unroll
                                        for (int e = 0; e < 4; ++e) v[e] = (e > dd) ? 0.f : v[e]; }
                                    u32x2 w; w.x = cvt_pk_bf16(v[0], v[1]); w.y = cvt_pk_bf16(v[2], v[3]);
                                    *(LAS u32x2*)(lds + PIMG + (wc >> 1) * HTB + lds_byte(i, (wc & 1) * 32 + n * 16 + fq * 4)) = w; } }
                        }
                    } else {
#pragma unroll
                        for (int k2 = 0; k2 < 2; ++k2) {
                            bf16x8 Bt[2][2];
#pragma unroll
                            for (int n = 0; n < 2; ++n)
#pragma unroll
                                for (int k = 0; k < 2; ++k) Bt[n][k] = *(const LAS bf16x8*)(lds + bo + k2 * HTB + boff + n * 2048 + k * 1024);
#pragma unroll
                            for (int mh = 0; mh < 2; ++mh) {
                                bf16x8 At[2][2];
#pragma unroll
                                for (int m = 0; m < 2; ++m)
#pragma unroll
                                    for (int k = 0; k < 2; ++k) At[m][k] = *(const LAS bf16x8*)(lds + PIMG + k2 * HTB + aoff + (mh * 2 + m) * 2048 + k * 1024);
#pragma unroll
                                for (int m = 0; m < 2; ++m)
#pragma unroll
                                    for (int n = 0; n < 2; ++n)
#pragma unroll
                                        for (int k = 0; k < 2; ++k) O[sub - 4][mh * 2 + m][n] = __builtin_amdgcn_mfma_f32_16x16x32_bf16(Bt[n][k], At[m][k], O[sub - 4][mh * 2 + m][n], 0, 0, 0);
                                __builtin_amdgcn_sched_barrier(0);
                            }
                        }
                    }
                    if (s + 2 < total) asm volatile("s_waitcnt vmcnt(4) lgkmcnt(0)" ::: "memory"); else asm volatile("s_waitcnt vmcnt(0) lgkmcnt(0)" ::: "memory");
                    RT_BAR;
                }
            }
            int ln = lane; asm volatile("" : "+v"(ln)); const int fr = ln & 15, fq = ln >> 4;
#pragma unroll
            for (int m = 0; m < 4; ++m) { float ss = 0.f;
#pragma unroll
                for (int c = 0; c < 4; ++c)
#pragma unroll
                    for (int n = 0; n < 2; ++n) { const f32x4 o = O[c][m][n]; ss += (o[0] * o[0] + o[1] * o[1]) + (o[2] * o[2] + o[3] * o[3]); }
                ss += __shfl_xor(ss, 16); ss += __shfl_xor(ss, 32);
                if (fq == 0) red[(wr * 64 + m * 16 + fr) * 4 + wc] = ss; }
            LDS_WAIT(); RT_BAR;
#pragma unroll
            for (int m = 0; m < 4; ++m) { const int i = wr * 64 + m * 16 + fr; const f32x4 pr = *(const LAS f32x4*)(red + i * 4);
                const float inv = __builtin_amdgcn_rsqf(((pr[0] + pr[1]) + (pr[2] + pr[3])) * (1.0f / DV) + EPS);
                const size_t tok = (size_t)b * SEQ + (size_t)qc * 128 + i;
#pragma unroll
                for (int c = 0; c < 4; ++c) { const int col = h * DV + c * 128 + wc * 32 + fq * 8;
                    const u32x4 gw = *(const u32x4*)(GB + tok * VW + col); const f32x4 n0 = *(const f32x4*)(normg + col), n1 = *(const f32x4*)(normg + col + 4);
                    const f32x4 o0 = O[c][m][0] * inv * n0, o1 = O[c][m][1] * inv * n1;
                    float gv[8] = {bf_lo(gw.x), bf_hi(gw.x), bf_lo(gw.y), bf_hi(gw.y), bf_lo(gw.z), bf_hi(gw.z), bf_lo(gw.w), bf_hi(gw.w)};
                    float r[8];
#pragma unroll
                    for (int e = 0; e < 4; ++e) { r[e] = o0[e] * gv[e] * fast_sigmoid(gv[e]); r[4 + e] = o1[e] * gv[4 + e] * fast_sigmoid(gv[4 + e]); }
                    if (og8) { int w0 = 0, w1 = 0; w0 = __builtin_amdgcn_cvt_pk_fp8_f32(r[0], r[1], w0, false); w0 = __builtin_amdgcn_cvt_pk_fp8_f32(r[2], r[3], w0, true);
                        w1 = __builtin_amdgcn_cvt_pk_fp8_f32(r[4], r[5], w1, false); w1 = __builtin_amdgcn_cvt_pk_fp8_f32(r[6], r[7], w1, true); u32x2 w; w.x = (unsigned)w0; w.y = (unsigned)w1;
                        *(u32x2*)((unsigned char*)OG + tok * VW + col) = w; }
                    else { u32x4 w; w.x = cvt_pk_bf16(r[0], r[1]); w.y = cvt_pk_bf16(r[2], r[3]); w.z = cvt_pk_bf16(r[4], r[5]); w.w = cvt_pk_bf16(r[6], r[7]);
                        *(u32x4*)(OG + tok * VW + col) = w; } } }
            VM_WAIT(); RT_BAR;
        }
    }
#undef RT_STAGE
#undef RT_STAGE_STEP
#undef RT_BAR
}

__device__ __forceinline__ void mfma8(f32x4& c, const i32x8& a, const i32x8& b, int sc) { asm volatile("v_mfma_scale_f32_16x16x128_f8f6f4 %0, %1, %2, %0, %3, %3 op_sel_hi:[0,0,0]" : "+v"(c) : "v"(a), "v"(b), "v"(sc)); }
__device__ __forceinline__ void retention8_phase(Frame& F, const unsigned char* Q8, const unsigned char* K8, const unsigned char* VT8, const bf16_t* GB, const float* normg, bf16_t* OG, const int og8) {
    using namespace pg8;
    LAS unsigned char* lds = F.lds;
    int tid = mk_tid(F.wv); asm volatile("" : "+v"(tid));
    const int wid = __builtin_amdgcn_readfirstlane(tid >> 6), lane = tid & 63, wr = wid >> 2, wc = wid & 3;
    unsigned voffQ[2], voffV[2];
#pragma unroll
    for (int i = 0; i < 2; ++i) { int R, C; stage_rc(tid * 16 + i * 8192, R, C); const int Rb = (R & ~31) + perm32(R & 31);
        voffQ[i] = (unsigned)(R * QKW + C * 2); voffV[i] = (unsigned)(Rb * NT + C * 2); }
    const unsigned ldsw = (unsigned)wid * 1024u;
    const int aoff = lds_byte(wr * 64 + (lane & 15), (lane >> 4) * 8), boff = lds_byte(wc * 32 + (lane & 15), (lane >> 4) * 8);
    constexpr int PIMG = 6 * HTB;
    LAS float* red = (LAS float*)(lds + MISC_OFF + 256);
    int f8scale = 0x7f7f7f7f; asm volatile("" : "+v"(f8scale));
    const __amdgpu_buffer_rsrc_t rsQ = __builtin_amdgcn_make_buffer_rsrc((void*)Q8, 0, NT * QKW, 0x00020000);
    const __amdgpu_buffer_rsrc_t rsK = __builtin_amdgcn_make_buffer_rsrc((void*)K8, 0, NT * QKW, 0x00020000);
    const __amdgpu_buffer_rsrc_t rsV = __builtin_amdgcn_make_buffer_rsrc((void*)VT8, 0, VW * NT, 0x00020000);
#define RT_STAGE(bufoff, rsrc, soff, voff) do { _Pragma("unroll") for (int _i = 0; _i < 2; ++_i) \
        __builtin_amdgcn_raw_ptr_buffer_load_lds((rsrc), (LAS unsigned*)(lds + (bufoff) + ldsw + _i * 8192), 16, (voff)[_i], (soff), 0, 0); } while (0)
#define RT_BAR __builtin_amdgcn_s_barrier()
#define RT_LD16(off) (*(const LAS i32x4*)(lds + (off)))
    for (int it = F.bid; it < 256; it += F.G) {
        const int item = (it & 7) * 32 + (it >> 3);
        const int b = item >> 6, h = (item >> 3) & 7, x = item & 7;
        const float lg2 = ((const float*)(F.ws + WS_LG2))[h];
        const int koff = b * SEQ * QKW + h * DK, voff0 = h * DV * NT + b * SEQ;
        for (int qs = 0; qs < 2; ++qs) {
            const int qc = qs == 0 ? 15 - x : x, nkv = qc + 1, total = 4 * nkv;
            const int qoff = (b * SEQ + qc * 128) * QKW + h * DK;
            f32x4 O[4][4][2], P[4][2]; i32x8 Apf[4];
#pragma unroll
            for (int c = 0; c < 4; ++c)
#pragma unroll
                for (int m = 0; m < 4; ++m)
#pragma unroll
                    for (int n = 0; n < 2; ++n) O[c][m][n] = (f32x4){0.f, 0.f, 0.f, 0.f};
#define RT_STAGE_STEP(sv) do { const int _s = (sv); const int _kt = _s >> 2, _sub = _s & 3, _bo = (_s % 3) * 2 * HTB; \
                if (_sub < 2) { RT_STAGE(_bo, rsQ, qoff + _sub * 128, voffQ); RT_STAGE(_bo + HTB, rsK, koff + _kt * (128 * QKW) + _sub * 128, voffQ); } \
                else { const int _vo = voff0 + (_sub - 2) * (256 * NT) + _kt * 128; RT_STAGE(_bo, rsV, _vo, voffV); RT_STAGE(_bo + HTB, rsV, _vo + 128 * NT, voffV); } } while (0)
            RT_STAGE_STEP(0); RT_STAGE_STEP(1);
            asm volatile("s_waitcnt vmcnt(4)" ::: "memory"); RT_BAR;
            int s = 0;
            for (int kt = 0; kt < nkv; ++kt) {
                const float tscale = __builtin_amdgcn_exp2f((float)(128 * (qc - kt)) * lg2);
                const bool diag = (kt == qc);
#pragma unroll
                for (int sub = 0; sub < 4; ++sub, ++s) {
                    __builtin_amdgcn_sched_barrier(0);
                    if (s + 2 < total) RT_STAGE_STEP(s + 2);
                    const int bo = (s % 3) * 2 * HTB;
                    if (sub < 2) {
                        if (sub == 0) {
#pragma unroll
                            for (int m = 0; m < 4; ++m)
#pragma unroll
                                for (int n = 0; n < 2; ++n) P[m][n] = (f32x4){0.f, 0.f, 0.f, 0.f};
                        }
                        i32x8 Bt[2], At[4];
#pragma unroll
                        for (int n = 0; n < 2; ++n) { Bt[n].lo = RT_LD16(bo + HTB + boff + n * 2048); Bt[n].hi = RT_LD16(bo + HTB + boff + n * 2048 + 1024); }
#pragma unroll
                        for (int m = 0; m < 4; ++m) { At[m].lo = RT_LD16(bo + aoff + m * 2048); At[m].hi = RT_LD16(bo + aoff + m * 2048 + 1024); }
#pragma unroll
                        for (int m = 0; m < 4; ++m)
#pragma unroll
                            for (int n = 0; n < 2; ++n) mfma8(P[m][n], Bt[n], At[m], f8scale);
                        __builtin_amdgcn_sched_barrier(0);
                        if (sub == 1) {
                            asm volatile("s_nop 15\n\ts_nop 7" ::: "memory"); __builtin_amdgcn_sched_barrier(0);
                            int ln = lane; asm volatile("" : "+v"(ln)); const int fr = ln & 15, fq = ln >> 4;
#pragma unroll
                            for (int m = 0; m < 4; ++m) { const int i = wr * 64 + m * 16 + fr;
#pragma unroll
                                for (int n = 0; n < 2; ++n) { const int j0 = wc * 32 + n * 16 + fq * 4; f32x4 v = P[m][n] * tscale;
                                    if (diag) { int dd = i - j0; asm volatile("" : "+v"(dd));
#pragma unroll
                                        for (int e = 0; e < 4; ++e) v[e] = (e > dd) ? 0.f : v[e]; }
                                    int w = 0; w = __builtin_amdgcn_cvt_pk_fp8_f32(v[0], v[1], w, false); w = __builtin_amdgcn_cvt_pk_fp8_f32(v[2], v[3], w, true);
                                    *(LAS int*)(lds + PIMG + lds_byte(i, j0 >> 1)) = w; } }
                        }
                    } else {
                        if (sub == 2) {
#pragma unroll
                            for (int m = 0; m < 4; ++m) { Apf[m].lo = RT_LD16(PIMG + aoff + m * 2048); Apf[m].hi = RT_LD16(PIMG + aoff + m * 2048 + 1024); }
                        }
#pragma unroll
                        for (int ch = 0; ch < 2; ++ch) {
                            i32x8 Bv[2];
#pragma unroll
                            for (int n = 0; n < 2; ++n) { Bv[n].lo = RT_LD16(bo + ch * HTB + boff + n * 2048); Bv[n].hi = RT_LD16(bo + ch * HTB + boff + n * 2048 + 1024); }
#pragma unroll
                            for (int m = 0; m < 4; ++m)
#pragma unroll
                                for (int n = 0; n < 2; ++n) mfma8(O[(sub - 2) * 2 + ch][m][n], Bv[n], Apf[m], f8scale);
                            __builtin_amdgcn_sched_barrier(0);
                        }
                    }
                    if (s + 2 < total) asm volatile("s_waitcnt vmcnt(4) lgkmcnt(0)" ::: "memory"); else asm volatile("s_waitcnt vmcnt(0) lgkmcnt(0)" ::: "memory");
                    RT_BAR;
                }
            }
            asm volatile("s_nop 15\n\ts_nop 7" ::: "memory"); __builtin_amdgcn_sched_barrier(0);
            int ln = lane; asm volatile("" : "+v"(ln)); const int fr = ln & 15, fq = ln >> 4;
#pragma unroll
            for (int m = 0; m < 4; ++m) { float ss = 0.f;
#pragma unroll
                for (int c = 0; c < 4; ++c)
#pragma unroll
                    for (int n = 0; n < 2; ++n) { const f32x4 o = O[c][m][n]; ss += (o[0] * o[0] + o[1] * o[1]) + (o[2] * o[2] + o[3] * o[3]); }
                ss += __shfl_xor(ss, 16); ss += __shfl_xor(ss, 32);
                if (fq == 0) red[(wr * 64 + m * 16 + fr) * 4 + wc] = ss; }
            LDS_WAIT(); RT_BAR;
#pragma unroll
            for (int m = 0; m < 4; ++m) { const int i = wr * 64 + m * 16 + fr; const f32x4 pr = *(const LAS f32x4*)(red + i * 4);
                const float inv = __builtin_amdgcn_rsqf(((pr[0] + pr[1]) + (pr[2] + pr[3])) * (1.0f / DV) + EPS);
                const size_t tok = (size_t)b * SEQ + (size_t)qc * 128 + i;
#pragma unroll
                for (int c = 0; c < 4; ++c) { const int col = h * DV + c * 128 + wc * 32 + fq * 8;
                    const u32x4 gw = *(const u32x4*)(GB + tok * VW + col); const f32x4 n0 = *(const f32x4*)(normg + col), n1 = *(const f32x4*)(normg + col + 4);
                    const f32x4 o0 = O[c][m][0] * inv * n0, o1 = O[c][m][1] * inv * n1;
                    float gv[8] = {bf_lo(gw.x), bf_hi(gw.x), bf_lo(gw.y), bf_hi(gw.y), bf_lo(gw.z), bf_hi(gw.z), bf_lo(gw.w), bf_hi(gw.w)};
                    float r[8];
#pragma unroll
                    for (int e = 0; e < 4; ++e) { r[e] = o0[e] * gv[e] * fast_sigmoid(gv[e]); r[4 + e] = o1[e] * gv[4 + e] * fast_sigmoid(gv[4 + e]); }
                    if (og8) { int w0 = 0, w1 = 0; w0 = __builtin_amdgcn_cvt_pk_fp8_f32(r[0], r[1], w0, false); w0 = __builtin_amdgcn_cvt_pk_fp8_f32(r[2], r[3], w0, true);
                        w1 = __builtin_amdgcn_cvt_pk_fp8_f32(r[4], r[5], w1, false); w1 = __builtin_amdgcn_cvt_pk_fp8_f32(r[6], r[7], w1, true); u32x2 w; w.x = (unsigned)w0; w.y = (unsigned)w1;
                        *(u32x2*)((unsigned char*)OG + tok * VW + col) = w; }
                    else { u32x4 w; w.x = cvt_pk_bf16(r[0], r[1]); w.y = cvt_pk_bf16(r[2], r[3]); w.z = cvt_pk_bf16(r[4], r[5]); w.w = cvt_pk_bf16(r[6], r[7]);
                        *(u32x4*)(OG + tok * VW + col) = w; } } }
            VM_WAIT(); RT_BAR;
        }
    }
#undef RT_STAGE
#undef RT_STAGE_STEP
#undef RT_BAR
#undef RT_LD16
}

template <int W>
__device__ __forceinline__ void pool_rows(const bf16_t* X, const LAS float* rs, bf16_t* MIX, int r0, int s0, int q, int col) {
    f32x4 v[23];
#pragma unroll
    for (int t = 0; t < 23; ++t) { if (t >= 16 - W) { int row = r0 - 15 + 8 * q + t; row = row < 0 ? 0 : row; v[t] = bf4(*(const u32x2*)(X + (size_t)row * D + col)) * rs[8 * q + t]; } }
#pragma unroll
    for (int o = 0; o < 8; ++o) { const int t = 15 + o, s = s0 + 8 * q + o; f32x4 sum = v[t];
#pragma unroll
        for (int d = 1; d < W; ++d) sum = sum + v[t - d];
        const int cnt = (s + 1) < W ? (s + 1) : W; const float ic = 1.0f / (float)cnt;
        const f32x4 mx = sum * ic - v[t];
        u32x2 w; w.x = cvt_pk_bf16(mx[0], mx[1]); w.y = cvt_pk_bf16(mx[2], mx[3]);
        *(u32x2*)(MIX + (size_t)(r0 + 8 * q + o) * D + col) = w; }
}
__device__ __forceinline__ void pool_phase(Frame& F_, const bf16_t* X, const float* ROWSS, bf16_t* MIX) {
    Frame F = F_; { int t_ = mk_tid(F_.wv); asm volatile("" : "+v"(t_)); F.tid = t_; F.lane = t_ & 63; F.wave = __builtin_amdgcn_readfirstlane(t_ >> 6); }
    LAS float* rs = (LAS float*)(F.lds);
    for (int u = F.bid; u < 1024; u += F.G) {
        const int rt = u >> 2, g = u & 3, r0 = rt * 32, s0 = r0 & (SEQ - 1);
        for (int li = F.wave; li < 47; li += 8) { const int s = s0 - 15 + li; int row = r0 - 15 + li; row = row < 0 ? 0 : row;
            float p = (F.lane < 32) ? ROWSS[(size_t)row * 32 + F.lane] : 0.f; p = wave_sum(p);
            if (F.lane == 0) rs[li] = (s >= 0) ? (1.0f / sqrtf(p * (1.0f / D) + EPS)) : 0.f; }
        LDS_WAIT(); __syncthreads();
        const int q = F.tid >> 7, col = g * 512 + (F.tid & 127) * 4;
        if (g == 0) pool_rows<2>(X, rs, MIX, r0, s0, q, col); else if (g == 1) pool_rows<4>(X, rs, MIX, r0, s0, q, col); else if (g == 2) pool_rows<8>(X, rs, MIX, r0, s0, q, col); else pool_rows<16>(X, rs, MIX, r0, s0, q, col);
        __syncthreads();
    }
}

template <int W>
__device__ __forceinline__ void pool_pair(const bf16_t* Z, const LAS float* invt, int li0  , int ra, int sa, int col, f32x4& pa, f32x4& pb) {
    f32x4 S = (f32x4){0.f, 0.f, 0.f, 0.f}, first = S, za = S, zb = S;
#pragma unroll
    for (int k = 0; k <= W; ++k) { int row = ra - W + 1 + k; row = row < 0 ? 0 : row;
        const f32x4 z = bf4(*(const u32x2*)(Z + (size_t)row * D + col)) * invt[li0 - W + 1 + k];
        if (k == 0) first = z; if (k < W) S = S + z; if (k == W - 1) za = z; if (k == W) zb = z; }
    const int ca = (sa + 1) < W ? (sa + 1) : W, cb = (sa + 2) < W ? (sa + 2) : W;
    pa = S * (1.0f / (float)ca) - za; pb = (S - first + zb) * (1.0f / (float)cb) - zb;
}
template <int fp8>
__device__ __forceinline__ void router_phase(Frame& F_, bf16_t* X, const bf16_t* Z, const float* ROWSS, const float* pscale  , const float* router  , const float* gain  , unsigned* counts  , unsigned char* XG, int* TOK, float* GATE, unsigned char* ACTM8, float* SAM) {
    Frame F = F_; { int t_ = mk_tid(F_.wv); asm volatile("" : "+v"(t_)); F.tid = t_; F.lane = t_ & 63; F.wave = __builtin_amdgcn_readfirstlane(t_ >> 6); }
    LAS float* RTt = (LAS float*)(F.lds);
    LAS float* GN = (LAS float*)(F.lds + 65536);
    LAS float* PS = (LAS float*)(F.lds + 73728);
    LAS float* invt = (LAS float*)(F.lds + 81920);
    LAS int* lcnt = (LAS int*)(F.lds + MISC_OFF + 256);
    for (int i = F.tid; i < D * 8; i += 512) { const int c = i >> 3, e = i & 7; RTt[e * D + c] = router[i] * gain[c]; }
    for (int i = F.tid; i < D; i += 512) { GN[i] = gain[i]; PS[i] = pscale[i]; }
    if (fp8 != 0) { for (int i = F.bid * 512 + F.tid; i < NE * NT * 8; i += F.G * 512) *(u32x4*)(ACTM8 + (size_t)(i >> 3) * FE8 + FE + (i & 7) * 16) = (u32x4){0u, 0u, 0u, 0u}; }
    __syncthreads();
    for (int t = F.bid; t < 256; t += F.G) {
        const int r0 = t * 32, s0 = r0 & (SEQ - 1);
        if (F.tid < 16) lcnt[F.tid] = 0;
        for (int li = F.wave; li < 47; li += 8) { const int sp = s0 - 15 + li; int row = r0 - 15 + li; row = row < 0 ? 0 : row;
            float p = (F.lane < 32) ? ROWSS[(size_t)row * 32 + F.lane] : 0.f; p = wave_sum(p);
            if (F.lane == 0) invt[li] = (sp >= 0) ? (1.0f / sqrtf(p * (1.0f / D) + EPS)) : 0.f; }
        LDS_WAIT(); __syncthreads();
        const int rbase = r0 + F.wave * 4;
        int e0[4], e1[4], p0[4], p1[4]; float g0[4], inr[4], mq[4];
#pragma unroll
        for (int pr = 0; pr < 2; ++pr) {
            const int ra = rbase + 2 * pr, sa = ra & (SEQ - 1), li0 = ra - r0 + 15;
            f32x4 xa[8], xb[8];
#pragma unroll
            for (int j = 0; j < 8; ++j) { int ln = F.lane; asm volatile("" : "+v"(ln));
                const int col = 4 * ln + 256 * j; f32x4 pa, pb;
                if (j < 2) pool_pair<2>(Z, invt, li0, ra, sa, col, pa, pb); else if (j < 4) pool_pair<4>(Z, invt, li0, ra, sa, col, pa, pb); else if (j < 6) pool_pair<8>(Z, invt, li0, ra, sa, col, pa, pb); else pool_pair<16>(Z, invt, li0, ra, sa, col, pa, pb);
                const f32x4 ps = *(const LAS f32x4*)(PS + col);
                xa[j] = bf4(*(const u32x2*)(X + (size_t)ra * D + col)) + ps * pa; xb[j] = bf4(*(const u32x2*)(X + (size_t)(ra + 1) * D + col)) + ps * pb;
                u32x2 wa, wb; wa.x = cvt_pk_bf16(xa[j][0], xa[j][1]); wa.y = cvt_pk_bf16(xa[j][2], xa[j][3]); wb.x = cvt_pk_bf16(xb[j][0], xb[j][1]); wb.y = cvt_pk_bf16(xb[j][2], xb[j][3]);
                *(u32x2*)(X + (size_t)ra * D + col) = wa; *(u32x2*)(X + (size_t)(ra + 1) * D + col) = wb;
                if (j == 3 || j == 7) __builtin_amdgcn_sched_barrier(0); }
            float sqa = 0.f, sqb = 0.f;
            if constexpr (fp8 == 2) { float ma = 0.f, mb = 0.f;
#pragma unroll
                for (int j = 0; j < 8; ++j) { const f32x4 gn = *(const LAS f32x4*)(GN + 4 * F.lane + 256 * j); const f32x4 ta = xa[j] * gn, tb = xb[j] * gn;
                    ma = fmaxf(ma, fmaxf(fmaxf(fabsf(ta[0]), fabsf(ta[1])), fmaxf(fabsf(ta[2]), fabsf(ta[3])))); mb = fmaxf(mb, fmaxf(fmaxf(fabsf(tb[0]), fabsf(tb[1])), fmaxf(fabsf(tb[2]), fabsf(tb[3])))); }
                mq[2 * pr] = fmaxf(wave_max(ma), 1e-20f); mq[2 * pr + 1] = fmaxf(wave_max(mb), 1e-20f); }
#pragma unroll
            for (int j = 0; j < 8; ++j) { sqa += (xa[j][0] * xa[j][0] + xa[j][1] * xa[j][1]) + (xa[j][2] * xa[j][2] + xa[j][3] * xa[j][3]); sqb += (xb[j][0] * xb[j][0] + xb[j][1] * xb[j][1]) + (xb[j][2] * xb[j][2] + xb[j][3] * xb[j][3]); }
            const float inva = 1.0f / sqrtf(wave_sum(sqa) * (1.0f / D) + EPS), invb = 1.0f / sqrtf(wave_sum(sqb) * (1.0f / D) + EPS);
            inr[2 * pr] = inva; inr[2 * pr + 1] = invb;
            float lg[2][8];
#pragma unroll
            for (int e = 0; e < 8; ++e) { float a0 = 0.f, a1 = 0.f;
#pragma unroll
                for (int j = 0; j < 8; ++j) { const f32x4 w = *(const LAS f32x4*)(RTt + e * D + 4 * F.lane + 256 * j);
                    a0 += (xa[j][0] * w[0] + xa[j][1] * w[1]) + (xa[j][2] * w[2] + xa[j][3] * w[3]);
                    a1 += (xb[j][0] * w[0] + xb[j][1] * w[1]) + (xb[j][2] * w[2] + xb[j][3] * w[3]); }
                lg[0][e] = wave_sum(a0) * inva; lg[1][e] = wave_sum(a1) * invb; }
#pragma unroll
            for (int q = 0; q < 2; ++q) { const int rr = 2 * pr + q;
                float v0 = lg[q][0]; int i0 = 0;
#pragma unroll
                for (int e = 1; e < 8; ++e) if (lg[q][e] > v0) { v0 = lg[q][e]; i0 = e; }
                float v1 = -3.0e38f; int i1 = 0;
#pragma unroll
                for (int e = 0; e < 8; ++e) if (e != i0 && lg[q][e] > v1) { v1 = lg[q][e]; i1 = e; }
                e0[rr] = i0; e1[rr] = i1; g0[rr] = 1.0f / (1.0f + expf(v1 - v0));
                int a = 0, bq = 0;
                if (F.lane == 0) { a = atomicAdd((int*)(lcnt + i0), 1); bq = atomicAdd((int*)(lcnt + i1), 1); }
                p0[rr] = __builtin_amdgcn_readfirstlane(a); p1[rr] = __builtin_amdgcn_readfirstlane(bq); }
            __builtin_amdgcn_sched_barrier(0);
        }
        VM_WAIT();
        __syncthreads();
        if (F.tid < 8) lcnt[8 + F.tid] = (int)__hip_atomic_fetch_add(counts + 64 * F.tid, (unsigned)lcnt[F.tid], __ATOMIC_RELAXED, __HIP_MEMORY_SCOPE_AGENT);
        __syncthreads();
#pragma unroll
        for (int rr = 0; rr < 4; ++rr) { const int row = rbase + rr;
            const int q0 = lcnt[8 + e0[rr]] + p0[rr], q1 = lcnt[8 + e1[rr]] + p1[rr];
            const size_t pitch = fp8 ? D : 2 * D;
            float q8 = 0.f; if constexpr (fp8 == 2) q8 = 127.0f / mq[rr];
            unsigned char* d0 = XG + ((size_t)e0[rr] * NT + q0) * pitch; unsigned char* d1 = XG + ((size_t)e1[rr] * NT + q1) * pitch;
            int ln = F.lane; asm volatile("" : "+v"(ln));
#pragma unroll
            for (int j = 0; j < 8; ++j) { const f32x4 gn = *(const LAS f32x4*)(GN + 4 * ln + 256 * j);
                const unsigned long long xw = __hip_atomic_load((const unsigned long long*)(X + (size_t)row * D) + ln + 64 * j, __ATOMIC_RELAXED, __HIP_MEMORY_SCOPE_AGENT);
                u32x2 xx; xx.x = (unsigned)xw; xx.y = (unsigned)(xw >> 32); const f32x4 hv = bf4(xx) * inr[rr] * gn;
                if constexpr (fp8 == 2) { const int w = pack_i8x4(bf4(xx) * gn * q8); ((unsigned*)d0 + ln)[64 * j] = (unsigned)w; ((unsigned*)d1 + ln)[64 * j] = (unsigned)w; }
                else if constexpr (fp8 != 0) { int w = 0; w = __builtin_amdgcn_cvt_pk_fp8_f32(hv[0], hv[1], w, false); w = __builtin_amdgcn_cvt_pk_fp8_f32(hv[2], hv[3], w, true);
                    ((unsigned*)d0 + ln)[64 * j] = (unsigned)w; ((unsigned*)d1 + ln)[64 * j] = (unsigned)w; }
                else { u32x2 w; w.x = cvt_pk_bf16(hv[0], hv[1]); w.y = cvt_pk_bf16(hv[2], hv[3]); ((u32x2*)d0 + ln)[64 * j] = w; ((u32x2*)d1 + ln)[64 * j] = w; } }
            if constexpr (fp8 == 2) { if (F.lane == 0) { const float sc = mq[rr] * inr[rr] * (1.0f / 127.0f); SAM[e0[rr] * NT + q0] = sc; SAM[e1[rr] * NT + q1] = sc; } }
            if (F.lane == 0) { TOK[e0[rr] * NT + q0] = row * 2; GATE[e0[rr] * NT + q0] = g0[rr]; TOK[e1[rr] * NT + q1] = row * 2 + 1; GATE[e1[rr] * NT + q1] = 1.0f - g0[rr]; }
        }
        __syncthreads();
    }
}

__device__ __forceinline__ void cb_row(const int lane, const int row, const u32x2 (&rx)[8], const u32x2 (&ry0)[8], const u32x2 (&ry1)[8], bf16_t* X, bf16_t* XB, const float* gfinal, float* out, const bool last, const int xb8, const float ys, float* SA) {
    f32x4 v[8]; float s = 0.f;
#pragma unroll
    for (int j = 0; j < 8; ++j) { const u32x2 y0 = ry0[j], y1 = ry1[j];
        v[j] = bf4(rx[j]) + ((f32x4){bf_lo(y0.x), bf_hi(y0.x), bf_lo(y0.y), bf_hi(y0.y)} + (f32x4){bf_lo(y1.x), bf_hi(y1.x), bf_lo(y1.y), bf_hi(y1.y)}) * ys;
        s += (v[j][0] * v[j][0] + v[j][1] * v[j][1]) + (v[j][2] * v[j][2] + v[j][3] * v[j][3]); }
    const float inv = 1.0f / sqrtf(wave_sum(s) * (1.0f / D) + EPS);
    if (last) {
#pragma unroll
        for (int j = 0; j < 8; ++j) { const f32x4 g = ((const f32x4*)gfinal)[lane + 64 * j]; ((f32x4*)(out + (size_t)row * D))[lane + 64 * j] = v[j] * inv * g; }
    } else {
        float q8 = 0.f;
        if (xb8 == 2) { float mx = 0.f;
#pragma unroll
            for (int j = 0; j < 8; ++j) mx = fmaxf(mx, fmaxf(fmaxf(fabsf(v[j][0]), fabsf(v[j][1])), fmaxf(fabsf(v[j][2]), fabsf(v[j][3]))));
            mx = fmaxf(wave_max(mx) * inv, 1e-20f); q8 = inv * 127.0f / mx; if (lane == 0) SA[row] = mx * (1.0f / 127.0f); }
#pragma unroll
        for (int j = 0; j < 8; ++j) { { u32x2 w; w.x = cvt_pk_bf16(v[j][0], v[j][1]); w.y = cvt_pk_bf16(v[j][2], v[j][3]); ((u32x2*)(X + (size_t)row * D))[lane + 64 * j] = w; }
            if (xb8 == 2) ((int*)((unsigned char*)XB + (size_t)row * D) + lane)[64 * j] = pack_i8x4(v[j] * q8);
            else if (xb8) { int w = 0; w = __builtin_amdgcn_cvt_pk_fp8_f32(v[j][0] * inv, v[j][1] * inv, w, false); w = __builtin_amdgcn_cvt_pk_fp8_f32(v[j][2] * inv, v[j][3] * inv, w, true); ((unsigned*)((unsigned char*)XB + (size_t)row * D) + lane)[64 * j] = (unsigned)w; }
            else { u32x2 w; w.x = cvt_pk_bf16(v[j][0] * inv, v[j][1] * inv); w.y = cvt_pk_bf16(v[j][2] * inv, v[j][3] * inv); ((u32x2*)(XB + (size_t)row * D) + lane)[64 * j] = w; } }
    }
}
__device__ __forceinline__ void combine_phase(Frame& F_, bf16_t* X, const bf16_t* Y, bf16_t* XB, const float* gfinal, float* out, bool last, const int xb8  , const float ys, float* SA) {
    Frame F = F_; { int t_ = mk_tid(F_.wv); asm volatile("" : "+v"(t_)); F.tid = t_; F.lane = t_ & 63; F.wave = __builtin_amdgcn_readfirstlane(t_ >> 6); }
    const int gw = F.bid * 8 + F.wave, NGW = F.G * 8;
#define CB_LOAD(RX, RY0, RY1, row_) do { _Pragma("unroll") for (int j = 0; j < 8; ++j) { const size_t o = (size_t)(row_) * D / 4 + F.lane + 64 * j; \
        RX[j] = ((const u32x2*)X)[o]; RY0[j] = ((const u32x2*)Y)[o]; RY1[j] = ((const u32x2*)(Y + (size_t)NT * D))[o]; } } while (0)
    int row = gw; if (row >= NT) return;
    u32x2 ax[8], ay0[8], ay1[8], bx[8], by0[8], by1[8];
    CB_LOAD(ax, ay0, ay1, row);
    for (;;) {
        int nrow = row + NGW; bool has = nrow < NT;
        if (has) CB_LOAD(bx, by0, by1, nrow);
        cb_row(F.lane, row, ax, ay0, ay1, X, XB, gfinal, out, last, xb8, ys, SA);
        if (!has) break;
        row = nrow; nrow = row + NGW; has = nrow < NT;
        if (has) CB_LOAD(ax, ay0, ay1, nrow);
        cb_row(F.lane, row, bx, by0, by1, X, XB, gfinal, out, last, xb8, ys, SA);
        if (!has) break;
        row = nrow;
    }
#undef CB_LOAD
}

__device__ __forceinline__ int compute_cus(int T, int G) { if (T <= 0) return G; const int R = (T + G - 1) / G; int g = (T + R - 1) / R; g = (g + 7) & ~7; return g > G ? G : g; }
__device__ __forceinline__ void quant_rows_phase(Frame& F_, const bf16_t* X, const float* ROWSS, unsigned char* XQ, float* SA) {
    Frame F = F_; { int t_ = mk_tid(F_.wv); asm volatile("" : "+v"(t_)); F.tid = t_; F.lane = t_ & 63; F.wave = __builtin_amdgcn_readfirstlane(t_ >> 6); }
    const int gw = F.bid * 8 + F.wave, NGW = F.G * 8;
    for (int row = gw; row < NT; row += NGW) {
        float p = (F.lane < 32) ? ROWSS[(size_t)row * 32 + F.lane] : 0.f; p = wave_sum(p); const float inv = 1.0f / sqrtf(p * (1.0f / D) + EPS);
        f32x4 v[8]; float mx = 0.f;
#pragma unroll
        for (int j = 0; j < 8; ++j) { v[j] = bf4(((const u32x2*)(X + (size_t)row * D) + F.lane)[64 * j]) * inv;
            mx = fmaxf(mx, fmaxf(fmaxf(fabsf(v[j][0]), fabsf(v[j][1])), fmaxf(fabsf(v[j][2]), fabsf(v[j][3])))); }
        mx = fmaxf(wave_max(mx), 1e-20f); const float q = 127.0f / mx;
#pragma unroll
        for (int j = 0; j < 8; ++j) ((int*)(XQ + (size_t)row * D) + F.lane)[64 * j] = pack_i8x4(v[j] * q);
        if (F.lane == 0) SA[row] = mx * (1.0f / 127.0f);
    }
}
__global__ void __launch_bounds__(512, 2) trunk_fwd(Params args) {
    extern __shared__ __attribute__((aligned(16))) unsigned char lds_raw[];
    Frame F;
    F.lds = (LAS unsigned char*)lds_raw;
    F.tid = 0; F.lane = 0; F.wave = 0; F.G = gridDim.x; F.bid = blockIdx.x; F.wv = __builtin_amdgcn_readfirstlane((int)(threadIdx.x >> 6));
    F.out = args.out; F.ws = args.ws;
    unsigned char* ws = args.ws;
    unsigned* ctl = (unsigned*)(ws + WS_CTL);
    volatile LAS unsigned* MISC = (volatile LAS unsigned*)(F.lds + MISC_OFF);
    if (threadIdx.x < 64) MISC[threadIdx.x] = 0u;
    __syncthreads();
    const int lo = args.ph_lo, hi = args.ph_hi;
    const bool use_bar = (hi - lo) > 1;
    XcdBarrier bar; bar.bar = ctl + CW_BAR; bar.x = 0; bar.st = MISC + 8;
    if (use_bar) bar = xcd_barrier_post(ctl + CW_BAR, MISC + 8);
    bar.wv = F.wv;
#ifndef PHMASK
#define PHMASK 0x1FFF
#endif
#ifndef REPSLOT
#define REPSLOT -1
#endif
#ifndef REPCNT
#define REPCNT 2
#endif
#define NREP(j) (((j) == (REPSLOT)) ? (REPCNT) : 1)
#define EN(j) (((PHMASK) >> (j)) & 1)
#define IN(k) (lo <= (k) && (k) < hi)
#define WS_FRESH do { } while (0)
#define SEAM(k) do { if (IN(k) && IN((k) + 1)) xcd_barrier(bar); } while (0)
    bf16_t* X = (bf16_t*)(ws + WS_X); bf16_t* XB = (bf16_t*)(ws + WS_XB); float* ROWSS = (float*)(ws + WS_ROWSS);
    LAS unsigned char* ring = F.lds;

    if (EN(0) && IN(0)) { _Pragma("unroll 1") for (int rep = 0; rep < NREP(0); ++rep) { p0_prologue(F, args); __syncthreads(); } }
    SEAM(0);

#pragma unroll 1
    for (int l = 0; l < 2; ++l) {
        const int pb = 1 + 11 * l;
        asm volatile("" : "+s"(ws));
        WS_FRESH;
        if (EN(1) && IN(pb + 0)) _Pragma("unroll 1") for (int rep = 0; rep < NREP(1); ++rep) {
            const bool p8 = (PROJ8 >> l) & 1; const int r8 = (RET8 >> l) & 1;
            A1Order S; S.XB = (unsigned)WS_XB; S.WQKG = (unsigned)(WS_WQKG + l * SZ_WQKG); S.WVT = (unsigned)(WS_WVT + l * SZ_WVT); S.G = F.G; S.c = F.bid; S.t = p8 ? 256u * D : 256u * D * 2;
            const bool i8 = (I8A1 >> l) & 1; if (i8) S.t = 256u * D;
            EpiA1 E{(bf16_t*)(ws + WS_QB), (bf16_t*)(ws + WS_KB), (bf16_t*)(ws + WS_GB), (bf16_t*)(ws + WS_VT), (const float*)(ws + WS_COS), (const float*)(ws + WS_SIN), (const float*)(ws + (r8 ? WS_DQ8 : WS_DQ)), (const float*)(ws + (r8 ? WS_DKS8 : WS_DKS)), (p8 && !i8) ? 1.0f / 32.0f : 1.0f, r8,
                    i8 ? (const float*)(ws + WS_SA) : nullptr, (const float*)(ws + WS_SWQ + l * SZ_SWL), (const float*)(ws + WS_SWV + l * SZ_SWL)};
            if (i8) pg8::gemm_phase<EpiA1, A1Order, 2>(ring, ws, D, D, D, S, E, F.wv);
            else if (!p8) pg8::gemm_phase<EpiA1, A1Order>(ring, ws, D, D, D, S, E, F.wv);
            else pg8::gemm_phase<EpiA1, A1Order, true>(ring, ws, D, D, D, S, E, F.wv);
        }
        SEAM(pb + 0);
        WS_FRESH;
        if (EN(2) && IN(pb + 1)) _Pragma("unroll 1") for (int rep = 0; rep < NREP(2); ++rep) { if (!((RET8 >> l) & 1)) retention_phase(F, (const bf16_t*)(ws + WS_QB), (const bf16_t*)(ws + WS_KB), (const bf16_t*)(ws + WS_VT), (const bf16_t*)(ws + WS_GB), args.in[2] + (size_t)l * VW, (bf16_t*)(ws + WS_OG), (PROJ8 >> l) & 1);
            else retention8_phase(F, ws + WS_QB, ws + WS_KB, ws + WS_VT, (const bf16_t*)(ws + WS_GB), args.in[2] + (size_t)l * VW, (bf16_t*)(ws + WS_OG), (PROJ8 >> l) & 1); }
        SEAM(pb + 1);
        WS_FRESH;
        if (EN(3) && IN(pb + 2)) _Pragma("unroll 1") for (int rep = 0; rep < NREP(3); ++rep) {
            const bool d8 = ((DENSE8 >> l) & 1) && !((I8A4 >> l) & 1);
            const bool p8 = (PROJ8 >> l) & 1;
            DenseOrder S; S.init(WS_OG, p8 ? VW / 2 : VW, WS_WOUT + l * SZ_WOUT, p8 ? VW / 2 : VW, NT, D, F.G, F.bid);
            EpiRes E{X, nullptr, ROWSS, nullptr, 0, rep ? 0.f : (p8 ? 1.0f / 32.0f : 1.0f), d8 ? (unsigned char*)XB : nullptr};
            if (!p8) pg8::gemm_phase<EpiRes, DenseOrder>(ring, ws, VW, VW, VW, S, E, F.wv);
            else pg8::gemm_phase<EpiRes, DenseOrder, true>(ring, ws, VW, VW, VW, S, E, F.wv);
        }
        SEAM(pb + 2);
        if ((I8A4 >> l) & 1) {
            WS_FRESH;
        if (EN(12) && IN(pb + 3)) _Pragma("unroll 1") for (int rep = 0; rep < NREP(12); ++rep) quant_rows_phase(F, X, ROWSS, ws + WS_XB, (float*)(ws + WS_SA));
            SEAM(pb + 3);
        }
        WS_FRESH;
        if (EN(4) && IN(pb + 4)) _Pragma("unroll 1") for (int rep = 0; rep < NREP(4); ++rep) {
            const int Gc = compute_cus(32 * 44, F.G);
            if (F.bid < Gc) {
                if ((I8A4 >> l) & 1) {
                    DenseOrder S; S.init(WS_XB, D / 2, WS_WGU + l * SZ_WGU, D / 2, NT, 2 * FF, Gc, F.bid);
                    EpiGUi8 E{(bf16_t*)(ws + WS_ACT), FF, (const float*)(ws + WS_SA), (const float*)(ws + WS_SWGU + l * SZ_SWL), (DENSE8 >> l) & 1, 0, 0, 0};
                    pg8::gemm_phase<EpiGUi8, DenseOrder, 2>(ring, ws, D, D, D, S, E, F.wv);
                } else if (!((DENSE8 >> l) & 1)) {
                    DenseOrder S; S.init(WS_X, D, WS_WGU + l * SZ_WGU, D, NT, 2 * FF, Gc, F.bid);
                    EpiGU E{(bf16_t*)(ws + WS_ACT), FF, ROWSS, 0};
                    pg8::gemm_phase<EpiGU, DenseOrder>(ring, ws, D, D, D, S, E, F.wv);
                } else {
                    DenseOrder S; S.init(WS_XB, D / 2, WS_WGU + l * SZ_WGU, D / 2, NT, 2 * FF, Gc, F.bid);
                    EpiGU8 E{ws + WS_ACT, FF, 0, 1.0f / 32.0f, ROWSS};
                    pg8::gemm_phase<EpiGU8, DenseOrder, true>(ring, ws, D, D, D, S, E, F.wv);
                }
            }
            if ((I8B4 >> l) & 1) strip_loop<true>(F, args, l, 0, 704, 0, 736, 1 + l);
            conv_queue(F, args, l == 0 ? 1 : 4); __syncthreads();
        }
        SEAM(pb + 4);
        WS_FRESH;
        if (EN(5) && IN(pb + 5)) _Pragma("unroll 1") for (int rep = 0; rep < NREP(5); ++rep) {
            const bool d8 = (DENSE8 >> l) & 1;
            DenseOrder S; S.init(WS_ACT, d8 ? FF / 2 : FF, WS_WDN + l * SZ_WDN, d8 ? FF / 2 : FF, NT, D, F.G, F.bid);
            EpiRes E{X, nullptr, ROWSS, nullptr, 0, rep ? 0.f : (d8 ? 1.0f / 32.0f : 1.0f), nullptr};
            if (!d8) pg8::gemm_phase<EpiRes, DenseOrder>(ring, ws, FF, FF, FF, S, E, F.wv);
            else pg8::gemm_phase<EpiRes, DenseOrder, true>(ring, ws, FF, FF, FF, S, E, F.wv);
        }
        SEAM(pb + 5);
        WS_FRESH;
        if (EN(6) && IN(pb + 6)) _Pragma("unroll 1") for (int rep = 0; rep < NREP(6); ++rep) {
            PoolOrder S; S.MIX = (unsigned)WS_X; S.W = (unsigned)(WS_WPOOL + l * SZ_WPOOL); S.G = F.G; S.c = F.bid;
            EpiZ E{(bf16_t*)(ws + WS_MIX)};
            pg8::gemm_phase<EpiZ, PoolOrder>(ring, ws, 512, D, 512, S, E, F.wv);
        }
        SEAM(pb + 6);
        unsigned* counts = ctl + CW_CNT + l * 512;
        WS_FRESH;
        if (EN(8) && IN(pb + 7)) _Pragma("unroll 1") for (int rep = 0; rep < NREP(8); ++rep) {
            const float* a_ps = args.in[5] + (size_t)l * D; const float* a_rt = args.in[8] + (size_t)l * D * NE; const float* a_gn = args.in[12] + (size_t)(2 * l + 1) * D;
            constexpr bool all_i8 = (I8B4 & 3) == 3, all_f8 = (F8MASK & 3) == 3;
            if (all_i8 || ((I8B4 >> l) & 1)) router_phase<2>(F, X, (const bf16_t*)(ws + WS_MIX), ROWSS, a_ps, a_rt, a_gn, counts, ws + WS_XG, (int*)(ws + WS_TOK), (float*)(ws + WS_GATE), ws + WS_ACTM, (float*)(ws + WS_SAM));
            else if (all_f8 || ((F8MASK >> l) & 1)) router_phase<1>(F, X, (const bf16_t*)(ws + WS_MIX), ROWSS, a_ps, a_rt, a_gn, counts, ws + WS_XG, (int*)(ws + WS_TOK), (float*)(ws + WS_GATE), ws + WS_ACTM, nullptr);
            else router_phase<0>(F, X, (const bf16_t*)(ws + WS_MIX), ROWSS, a_ps, a_rt, a_gn, counts, ws + WS_XG, (int*)(ws + WS_TOK), (float*)(ws + WS_GATE), ws + WS_ACTM, nullptr);
        }
        SEAM(pb + 7);
        WS_FRESH;
        if (EN(9) && IN(pb + 8)) _Pragma("unroll 1") for (int rep = 0; rep < NREP(9); ++rep) {
            const bool f8 = (F8MASK >> l) & 1;
            MoeOrder S;
            if (!f8) S.init(WS_XG, (size_t)NT * D * 2, D, WS_WMGU + l * SZ_WMGU, (size_t)2 * FE * D * 2, D, 2 * FE / 256, counts, F.G, F.bid);
            else S.init(WS_XG, (size_t)NT * D, D, WS_WMGU + l * SZ_WMGU, (size_t)2 * FE * D, D, 2 * FE / 256, counts, F.G, F.bid, 1);
#ifndef B4GC
#define B4GC 0
#endif
            const int Gc = (l == 0) ? (B4GC ? B4GC : compute_cus(S.total, F.G)) : F.G; S.G = Gc;
            if (F.bid < Gc) {
                if (!f8) { EpiGU E{(bf16_t*)(ws + WS_ACTM), FE, nullptr, (size_t)NT * FE}; pg8::gemm_phase<EpiGU, MoeOrder>(ring, ws, D, D, D, S, E, F.wv); }
                else if ((I8B4 >> l) & 1) { EpiGUi8 E{(bf16_t*)(ws + WS_ACTM), FE8, (const float*)(ws + WS_SAM), (const float*)(ws + WS_SWM) + l * NE * 2 * FE, 1, (size_t)NT * FE8, NT, 2 * FE};
                    pg8::gemm_phase<EpiGUi8, MoeOrder, 2>(ring, ws, D, D, D, S, E, F.wv); }
                else { EpiGU8 E{ws + WS_ACTM, FE8, (size_t)NT * FE8, 1.0f / 32.0f, nullptr}; pg8::gemm_phase<EpiGU8, MoeOrder, true>(ring, ws, D, D, D, S, E, F.wv); }
            }
            if (l == 0) { if (I8A1 & 2) strip_loop<true>(F, args, 1, 0, 384, 0, 0, 0); conv_queue(F, args, 2); }
            __syncthreads();
        }
        SEAM(pb + 8);
        WS_FRESH;
        if (EN(10) && IN(pb + 9)) _Pragma("unroll 1") for (int rep = 0; rep < NREP(10); ++rep) {
            const bool f8 = (F8MASK >> l) & 1;
            MoeOrder S;
            if (!f8) S.init(WS_ACTM, (size_t)NT * FE * 2, FE, WS_WMDN + l * SZ_WMDN, (size_t)D * FE * 2, FE, D / 256, counts, F.G, F.bid);
            else S.init(WS_ACTM, (size_t)NT * FE8, FE8, WS_WMDN + l * SZ_WMDN, (size_t)D * FE8, FE8, D / 256, counts, F.G, F.bid, 1);
            const int Gc = (l == 0) ? compute_cus(S.total, F.G) : F.G; S.G = Gc;
            if (F.bid < Gc) {
                EpiMoeDown E{(bf16_t*)(ws + WS_Y), (const int*)(ws + WS_TOK), (const float*)(ws + WS_GATE), f8 ? 1.0f / 32.0f : 1.0f};
                if (!f8) pg8::gemm_phase<EpiMoeDown, MoeOrder>(ring, ws, FE, FE, FE, S, E, F.wv);
                else pg8::gemm_phase<EpiMoeDown, MoeOrder, true>(ring, ws, FE8, FE8, FE8, S, E, F.wv);
            }
            if (l == 0) conv_queue(F, args, 3);
            __syncthreads();
        }
        SEAM(pb + 9);
        WS_FRESH;
        if (EN(11) && IN(pb + 10)) _Pragma("unroll 1") for (int rep = 0; rep < NREP(11); ++rep) combine_phase(F, X, (const bf16_t*)(ws + WS_Y), XB, args.in[13], F.out, l == 1, ((I8A1 >> (l + 1)) & 1) ? 2 : ((PROJ8 >> (l + 1)) & 1), rep ? 0.f : 1.0f, (float*)(ws + WS_SA));
        if (l == 0) SEAM(pb + 10);
    }
#undef IN
#undef SEAM
}

extern "C" void kernel_launch(void* const* d_in, const int* in_sizes, int n_in, void* d_out, int out_size, void* d_ws, size_t ws_size, hipStream_t stream) {
    static int grid = 0;
    if (grid == 0) {
        if (n_in != 14 || in_sizes[0] != NT * D || out_size != NT * D || ws_size < WS_END) { fprintf(stderr, "kernel_launch: unexpected shapes (n_in %d, in0 %d, out %d, ws %zu < %zu)\n", n_in, n_in > 0 ? in_sizes[0] : -1, out_size, ws_size, (size_t)WS_END); grid = -1; return; }
        int dev = 0, cus = 0, per_cu = 0;
        if (hipGetDevice(&dev) != hipSuccess || hipDeviceGetAttribute(&cus, hipDeviceAttributeMultiprocessorCount, dev) != hipSuccess) { grid = -1; return; }
        if (hipFuncSetAttribute((const void*)trunk_fwd, hipFuncAttributeMaxDynamicSharedMemorySize, LDS_BYTES) != hipSuccess) { fprintf(stderr, "kernel_launch: hipFuncSetAttribute failed\n"); grid = -1; return; }
        if (hipOccupancyMaxActiveBlocksPerMultiprocessor(&per_cu, (const void*)trunk_fwd, 512, LDS_BYTES) != hipSuccess || per_cu < 1) fprintf(stderr, "kernel_launch: occupancy query reports %d\n", per_cu);
        (void)hipGetLastError();
        grid = cus;
    }
    if (grid < 0) return;
    if (hipMemsetAsync((char*)d_ws + WS_CTL, 0, CTL_BYTES, stream) != hipSuccess) return;
    Params p{};
    for (int i = 0; i < 14; ++i) p.in[i] = (const float*)d_in[i];
    p.out = (float*)d_out; p.ws = (unsigned char*)d_ws;
#if MK_N_LAUNCHES == 1
    p.ph_lo = 0; p.ph_hi = NPHASE;
    hipLaunchKernelGGL(trunk_fwd, dim3(grid), dim3(512), LDS_BYTES, stream, p);
#else
    for (int k = 0; k < NPHASE; ++k) { p.ph_lo = k; p.ph_hi = k + 1; hipLaunchKernelGGL(trunk_fwd, dim3(grid), dim3(512), LDS_BYTES, stream, p); }
#endif
}
```

```cpp
#include <hip/hip_runtime.h>
#include <cstdio>

#define LAS __attribute__((address_space(3)))
#define GAS __attribute__((address_space(1)))
typedef unsigned short bf16_t;
typedef short bf16x8 __attribute__((ext_vector_type(8)));
typedef float f32x4 __attribute__((ext_vector_type(4)));
typedef float f32x2 __attribute__((ext_vector_type(2)));
typedef unsigned u32x4 __attribute__((ext_vector_type(4)));
typedef unsigned u32x2 __attribute__((ext_vector_type(2)));
typedef int i32x4 __attribute__((ext_vector_type(4)));
typedef int i32x8 __attribute__((ext_vector_type(8)));

#ifndef MK_N_LAUNCHES
#define MK_N_LAUNCHES 1
#endif

constexpr int NT = 8192, SEQ = 2048, D = 2048, NH = 8, DK = 256, DV = 512, QKW = 2048, VW = 4096, FF = 5632, NE = 8, FE = 1408;
constexpr float EPS = 1e-6f;
constexpr int NPHASE = 23;
#ifndef DENSE8
#define DENSE8 3
#endif
#ifndef PROJ8
#define PROJ8 2
#endif
#ifndef I8A1
#define I8A1 3
#endif
#ifndef I8A4
#define I8A4 1
#endif
#ifndef I8B4
#define I8B4 0
#endif
#ifndef RET8
#define RET8 2
#endif
#ifndef F8MASK
#define F8MASK 3
#endif
constexpr int FE8 = 1536;

constexpr size_t MiB = 1u << 20;
constexpr size_t WS_CTL = 0, CTL_BYTES = 1 * MiB;
constexpr size_t WS_COS = 1 * MiB, WS_SIN = 2 * MiB, WS_DQ = 3 * MiB, WS_DKS = 3 * MiB + 4096, WS_LG2 = 3 * MiB + 8192, WS_DQ8 = 3 * MiB + 12288, WS_DKS8 = 3 * MiB + 16384;
constexpr size_t WS_ROWSS = 4 * MiB, WS_TOK = 5 * MiB, WS_GATE = 5 * MiB + 512 * 1024;
constexpr size_t WS_SA = 6 * MiB, WS_SWGU = 6 * MiB + 64 * 1024;
constexpr size_t WS_SWQ = WS_SA + 128 * 1024, WS_SWV = WS_SA + 160 * 1024, SZ_SWL = 256 * 1024;
constexpr size_t WS_SAM = WS_SA + 1024 * 1024, WS_SWM = WS_SA + 1536 * 1024;
constexpr size_t WS_WQKG = 8 * MiB, SZ_WQKG = 32 * MiB;
constexpr size_t WS_WVT = 72 * MiB, SZ_WVT = 16 * MiB;
constexpr size_t WS_WOUT = 104 * MiB, SZ_WOUT = 16 * MiB;
constexpr size_t WS_WGU = 136 * MiB, SZ_WGU = 44 * MiB;
constexpr size_t WS_WDN = 224 * MiB, SZ_WDN = 22 * MiB;
constexpr size_t WS_WPOOL = 268 * MiB, SZ_WPOOL = 2 * MiB;
constexpr size_t WS_WMGU = 272 * MiB, SZ_WMGU = 88 * MiB;
constexpr size_t WS_WMDN = 448 * MiB, SZ_WMDN = 44 * MiB;
constexpr size_t WS_X = 536 * MiB, WS_XB = 600 * MiB, WS_S = 632 * MiB;
constexpr size_t WS_QB = WS_S, WS_KB = WS_S + 32 * MiB, WS_VT = WS_S + 64 * MiB, WS_GB = WS_S + 128 * MiB, WS_OG = WS_S + 192 * MiB, WS_ACT = WS_S;
constexpr size_t WS_MIX = WS_S, WS_XG = WS_S + 32 * MiB, WS_ACTM = WS_S + 288 * MiB, WS_Y = WS_S + 464 * MiB;
constexpr size_t WS_END = WS_S + 592 * MiB;
constexpr unsigned WS_END_32 = (unsigned)WS_END;
constexpr int CW_BAR = 4096;
constexpr int CW_Q = 8192;
constexpr int CW_CNT = 1024;

constexpr int RING_BYTES = 131072, MISC_OFF = 139264, LDS_BYTES = 143360;

__device__ __forceinline__ unsigned cvt_pk_bf16(float lo, float hi) { unsigned r; asm volatile("v_cvt_pk_bf16_f32 %0, %1, %2" : "=v"(r) : "v"(lo), "v"(hi)); return r; }
__device__ __forceinline__ float bf_lo(unsigned w) { return __uint_as_float(w << 16); }
__device__ __forceinline__ float bf_hi(unsigned w) { return __uint_as_float(w & 0xffff0000u); }
__device__ __forceinline__ f32x4 bf4(u32x2 w) { return (f32x4){bf_lo(w.x), bf_hi(w.x), bf_lo(w.y), bf_hi(w.y)}; }
__device__ __forceinline__ float fast_sigmoid(float a) { return __builtin_amdgcn_rcpf(1.0f + __builtin_amdgcn_exp2f(-1.4426950408889634f * a)); }
__device__ __forceinline__ float wave_sum(float v) {
#pragma unroll
    for (int o = 1; o < 64; o <<= 1) v += __shfl_xor(v, o);
    return v;
}
#define LDS_WAIT() asm volatile("s_waitcnt lgkmcnt(0)" ::: "memory")
__device__ __forceinline__ int mk_tid(int wv) { unsigned z = 0u; asm volatile("" : "+s"(z)); return wv * 64 + (int)__builtin_amdgcn_mbcnt_hi(~0u, __builtin_amdgcn_mbcnt_lo(~0u, z)); }
#define VM_WAIT() asm volatile("s_waitcnt vmcnt(0)" ::: "memory")

namespace pg8 {
constexpr int BM = 256, BK = 64, HALF = 128, HTB = HALF * BK * 2, STAGE_BYTES = 8 * HTB;
__host__ __device__ __forceinline__ int lds_byte(int r, int c) { const int st = (r >> 4) * 2 + (c >> 5), rr = r & 15, cc = c & 31, ob = rr * 64 + cc * 2; return st * 1024 + (ob ^ (((ob >> 9) & 1) << 5)); }
__host__ __device__ __forceinline__ void stage_rc(int b, int& R, int& C) { const int st = b / 1024, sb = b % 1024, swz = sb ^ (((sb >> 9) & 1) << 5); R = (st >> 1) * 16 + swz / 64; C = (st & 1) * 32 + (swz % 64) / 2; }
__host__ __device__ __forceinline__ int perm32(int rho) { const int n = rho >> 4, i = rho & 15; return 8 * (i >> 2) + 4 * n + (i & 3); }

struct Unit { unsigned a, b; int pm, pn, grp, rows; };

__device__ __forceinline__ int xcd_remap(int L, int nwg) { const int q = nwg / 8, r = nwg % 8, xcd = L % 8, off = L / 8; return (xcd < r ? xcd * (q + 1) : r * (q + 1) + (xcd - r) * q) + off; }
__device__ __forceinline__ void walk2d(int w, int nM, int nN, int& pm, int& pn) { const int nig = 8 * nN, gid = w / nig, fm = gid * 8, gsz = (nM - fm) < 8 ? (nM - fm) : 8; pm = fm + ((w % nig) % gsz); pn = (w % nig) / gsz; }

template <class Epi, class Sched, int FP8 = 0>
__device__ __forceinline__ void gemm_phase(LAS unsigned char* lds, const unsigned char* wsbase, const int K, const int lda, const int ldb, const Sched& S, const Epi& E, const int wv) {
    int tid = mk_tid(wv); asm volatile("" : "+v"(tid));
    const int wid = __builtin_amdgcn_readfirstlane(tid >> 6), lane = tid & 63, wr = wid >> 2, wc = wid & 3, fr = lane & 15, fq = lane >> 4;
    constexpr int ES = FP8 ? 1 : 2;
    const int nt = K * ES / 128;
    unsigned voffA[2], voffB[2];
#pragma unroll
    for (int i = 0; i < 2; ++i) { int R, C; stage_rc(tid * 16 + i * 8192, R, C); const int Rb = (R & ~31) + perm32(R & 31);
        voffA[i] = (unsigned)(R * lda * ES + C * 2); voffB[i] = (unsigned)(Rb * ldb * ES + C * 2); }
    const unsigned kstep = (unsigned)(BK * 2);
    const unsigned hstepA = (unsigned)HALF * lda * ES, hstepB = (unsigned)HALF * ldb * ES;
    const unsigned ldsw = (unsigned)wid * 1024u;
    const __amdgpu_buffer_rsrc_t rsrc = __builtin_amdgcn_make_buffer_rsrc((void*)wsbase, 0, (int)WS_END_32, 0x00020000);
    const int aoff = lds_byte(wr * 64 + fr, fq * 8); int boff = lds_byte(wc * 32 + fr, fq * 8) + 4 * HTB;
    asm volatile("" : "+v"(boff));
#define PG8_SBR(b, h) (((b) * 2 + (h)) * HTB)
#define PG8_SA(b, h) (((b) * 2 + (h)) * HTB)
#define PG8_SB(b, h) ((4 + (b) * 2 + (h)) * HTB)
#define PG8_STAGE(bufoff, soff, voff) do { _Pragma("unroll") for (int _i = 0; _i < 2; ++_i) \
        __builtin_amdgcn_raw_ptr_buffer_load_lds(rsrc, (LAS unsigned*)(lds + (bufoff) + ldsw + _i * 8192), 16, (voff)[_i], (int)(soff), 0, 0); } while (0)
#define PG8_LD16(off) (*(const LAS i32x4*)(lds + (off)))
#define PG8_LDA(dst, b, h) do { _Pragma("unroll") for (int m = 0; m < 4; ++m) { \
        if constexpr (FP8 == 1) { dst##8[m].lo = PG8_LD16(PG8_SA(b, h) + aoff + m * 2048); dst##8[m].hi = PG8_LD16(PG8_SA(b, h) + aoff + m * 2048 + 1024); } \
        else { _Pragma("unroll") for (int k = 0; k < 2; ++k) dst[m][k] = *(const LAS bf16x8*)(lds + PG8_SA(b, h) + aoff + m * 2048 + k * 1024); } } } while (0)
#define PG8_LDB(dst, b, h) do { _Pragma("unroll") for (int n = 0; n < 2; ++n) { \
        if constexpr (FP8 == 1) { dst##8[n].lo = PG8_LD16(PG8_SBR(b, h) + boff + n * 2048); dst##8[n].hi = PG8_LD16(PG8_SBR(b, h) + boff + n * 2048 + 1024); } \
        else { _Pragma("unroll") for (int k = 0; k < 2; ++k) dst[n][k] = *(const LAS bf16x8*)(lds + PG8_SBR(b, h) + boff + n * 2048 + k * 1024); } } } while (0)
#define PG8_MMA(ai, bj, At, Bt) do { __builtin_amdgcn_s_setprio(1); _Pragma("unroll") for (int m = 0; m < 4; ++m) _Pragma("unroll") for (int n = 0; n < 2; ++n) { \
        if constexpr (FP8 == 1) asm volatile("v_mfma_scale_f32_16x16x128_f8f6f4 %0, %1, %2, %0, %3, %3 op_sel_hi:[0,0,0]" : "+v"(acc[ai][bj][m][n]) : "v"(Bt##8[n]), "v"(At##8[m]), "v"(f8scale)); \
        else if constexpr (FP8 == 2) { _Pragma("unroll") for (int k = 0; k < 2; ++k) acc[ai][bj][m][n] = __builtin_bit_cast(f32x4, __builtin_amdgcn_mfma_i32_16x16x64_i8(__builtin_bit_cast(i32x4, Bt[n][k]), __builtin_bit_cast(i32x4, At[m][k]), __builtin_bit_cast(i32x4, acc[ai][bj][m][n]), 0, 0, 0)); } \
        else { _Pragma("unroll") for (int k = 0; k < 2; ++k) acc[ai][bj][m][n] = __builtin_amdgcn_mfma_f32_16x16x32_bf16(Bt[n][k], At[m][k], acc[ai][bj][m][n], 0, 0, 0); } } \
        __builtin_amdgcn_s_setprio(0); } while (0)
#define PG8_WAIT_V(n) asm volatile("s_waitcnt vmcnt(" #n ")" ::: "memory")
#define PG8_WAIT_L(n) asm volatile("s_waitcnt lgkmcnt(" #n ")" ::: "memory")
#define PG8_BAR __builtin_amdgcn_s_barrier()
#define PG8_SCHED __builtin_amdgcn_sched_barrier(0)
    Unit cur, nxt; int ui = 0;
    if (!S.next(0, cur)) return;
    f32x4 acc[2][2][4][2];
#pragma unroll
    for (int a = 0; a < 2; ++a)
#pragma unroll
        for (int b = 0; b < 2; ++b)
#pragma unroll
            for (int m = 0; m < 4; ++m)
#pragma unroll
                for (int n = 0; n < 2; ++n) acc[a][b][m][n] = (f32x4){0.f, 0.f, 0.f, 0.f};
    bf16x8 At[4][2], B0[2][2], B1[2][2]; i32x8 At8[4], B08[2], B18[2];
    int f8scale = 0x7f7f7f7f; asm volatile("" : "+v"(f8scale));
    unsigned cA = cur.a, cB = cur.b;
    PG8_STAGE(PG8_SB(0, 0), cB, voffB); PG8_STAGE(PG8_SB(0, 1), cB + hstepB, voffB); PG8_STAGE(PG8_SA(0, 0), cA, voffA); PG8_STAGE(PG8_SA(0, 1), cA + hstepA, voffA);
    if (wr == 1) PG8_BAR;
    PG8_WAIT_V(2); PG8_BAR;
    PG8_STAGE(PG8_SB(1, 0), cB + kstep, voffB); PG8_STAGE(PG8_SA(1, 0), cA + kstep, voffA); PG8_STAGE(PG8_SB(1, 1), cB + hstepB + kstep, voffB);
    PG8_WAIT_V(6); PG8_BAR;
    for (;;) {
        const bool has_next = S.next(ui + 1, nxt);
        const unsigned nA = has_next ? nxt.a : cA, nB = has_next ? nxt.b : cB;
        for (int t = 0; t < nt; t += 2) {
            const bool last = (t == nt - 2);
            const unsigned a1 = cA + (unsigned)(t + 1) * kstep;
            const unsigned a2 = last ? nA : cA + (unsigned)(t + 2) * kstep, b2 = last ? nB : cB + (unsigned)(t + 2) * kstep;
            const unsigned a3 = a2 + kstep, b3 = b2 + kstep;
            PG8_LDB(B0, 0, 0); PG8_LDB(B1, 0, 1); PG8_SCHED; PG8_LDA(At, 0, 0); PG8_STAGE(PG8_SA(1, 1), a1 + hstepA, voffA);
            PG8_WAIT_V(8); PG8_WAIT_L(0); PG8_BAR; PG8_MMA(0, 0, At, B0); PG8_MMA(0, 1, At, B1); PG8_BAR; PG8_SCHED;
            PG8_LDA(At, 0, 1); PG8_STAGE(PG8_SB(0, 0), b2, voffB); PG8_STAGE(PG8_SB(0, 1), b2 + hstepB, voffB); PG8_STAGE(PG8_SA(0, 0), a2, voffA);
            PG8_WAIT_V(8); PG8_WAIT_L(0); PG8_BAR; PG8_MMA(1, 0, At, B0); PG8_MMA(1, 1, At, B1); PG8_BAR; PG8_SCHED;
            PG8_LDB(B0, 1, 0); PG8_LDB(B1, 1, 1); PG8_SCHED; PG8_LDA(At, 1, 0); PG8_STAGE(PG8_SA(0, 1), a2 + hstepA, voffA);
            PG8_WAIT_V(8); PG8_WAIT_L(0); PG8_BAR; PG8_MMA(0, 0, At, B0); PG8_MMA(0, 1, At, B1); PG8_BAR; PG8_SCHED;
            PG8_LDA(At, 1, 1); PG8_STAGE(PG8_SB(1, 0), b3, voffB); PG8_STAGE(PG8_SB(1, 1), b3 + hstepB, voffB); PG8_STAGE(PG8_SA(1, 0), a3, voffA);
            PG8_WAIT_V(8); PG8_WAIT_L(0); PG8_BAR; PG8_MMA(1, 0, At, B0); PG8_MMA(1, 1, At, B1); PG8_BAR; PG8_SCHED;
        }
        if (wr == 0) PG8_BAR;
        if constexpr (FP8 == 1) { asm volatile("s_nop 15\n\ts_nop 7" ::: "memory"); PG8_SCHED; }
        if constexpr (FP8 == 2) {
            _Pragma("unroll") for (int a = 0; a < 2; ++a) _Pragma("unroll") for (int b = 0; b < 2; ++b) _Pragma("unroll") for (int m = 0; m < 4; ++m) _Pragma("unroll") for (int n = 0; n < 2; ++n)
                acc[a][b][m][n] = __builtin_convertvector(__builtin_bit_cast(i32x4, acc[a][b][m][n]), f32x4); }
        E(acc, cur, wr, wc, fr, fq);
        if (!has_next) break;
#pragma unroll
        for (int a = 0; a < 2; ++a)
#pragma unroll
            for (int b = 0; b < 2; ++b)
#pragma unroll
                for (int m = 0; m < 4; ++m)
#pragma unroll
                    for (int n = 0; n < 2; ++n) acc[a][b][m][n] = (f32x4){0.f, 0.f, 0.f, 0.f};
        cur = nxt; cA = nA; cB = nB; ++ui;
        if (wr == 1) PG8_BAR;
    }
    PG8_WAIT_V(0);
    PG8_BAR;
#undef PG8_SA
#undef PG8_SB
#undef PG8_SBR
#undef PG8_STAGE
#undef PG8_LDA
#undef PG8_LD16
#undef PG8_LDB
#undef PG8_MMA
#undef PG8_WAIT_V
#undef PG8_WAIT_L
#undef PG8_BAR
#undef PG8_SCHED
}
}

#define XB_TMO      128
#define XB_XCNT(j)  (256  + 64 * (j))
#define XB_XSUB(j)  (1280 + 64 * (j))
#define XB_XGEN(j)  (2304 + 64 * (j))
#define XB_TOP      3328
#define XB_TOPGEN   3392
#define XCD_BAR_WORDS 3456
#define XB_SPIN_CAP (1u << 18)

__device__ __forceinline__ unsigned xb_ld(unsigned* p)              { return __hip_atomic_load(p, __ATOMIC_RELAXED, __HIP_MEMORY_SCOPE_AGENT); }
__device__ __forceinline__ unsigned xb_add(unsigned* p, unsigned v) { return __hip_atomic_fetch_add(p, v, __ATOMIC_RELAXED, __HIP_MEMORY_SCOPE_AGENT); }
__device__ __forceinline__ unsigned xb_xcc_id() { return (unsigned)__builtin_amdgcn_s_getreg((3 << 11) | 20) & 0xFu; }
#define XB_SPIN(cond, bar) do { unsigned _sp = 0; while (cond) { __builtin_amdgcn_s_sleep(1); \
    if ((++_sp & 255u) == 0u) { if (xb_ld(&(bar)[XB_TMO])) break; if (_sp > XB_SPIN_CAP) { atomicAdd(&(bar)[XB_TMO], 1u); break; } } } } while (0)

struct XcdBarrier { unsigned* bar; unsigned x; volatile LAS unsigned* st; int wv; };

__device__ __forceinline__ XcdBarrier xcd_barrier_post(unsigned* bar, volatile LAS unsigned* st) {
    XcdBarrier b; b.bar = bar; b.x = xb_xcc_id(); b.st = st;
    if (threadIdx.x == 0) (void)xb_add(&bar[XB_XCNT(b.x)], 1u);
    return b;
}
__device__ __forceinline__ void xcd_barrier_complete(unsigned* bar, unsigned x, unsigned& nloc, unsigned& nx) {
    const unsigned G = gridDim.x * gridDim.y * gridDim.z;
    unsigned sum, cnt, mine, sp = 0u;
    for (;;) {
        sum = 0u; cnt = 0u; mine = 0u;
#pragma unroll
        for (unsigned j = 0; j < 16; ++j) { const unsigned c = xb_ld(&bar[XB_XCNT(j)]); sum += c; cnt += (c > 0u) ? 1u : 0u; mine = (j == x) ? c : mine; }
        if (sum == G) break;
        __builtin_amdgcn_s_sleep(1);
        if ((++sp & 255u) == 0u) { if (xb_ld(&bar[XB_TMO])) break; if (sp > XB_SPIN_CAP) { atomicAdd(&bar[XB_TMO], 1u); break; } }
    }
    nloc = mine > 0u ? mine : 1u; nx = cnt > 0u ? cnt : 1u;
}
__device__ __forceinline__ void xcd_barrier(const XcdBarrier& b) {
    asm volatile("s_waitcnt vmcnt(0)" ::: "memory");
    __syncthreads();
    if (mk_tid(b.wv) == 0) {
        unsigned* bar = b.bar;
        __builtin_amdgcn_s_waitcnt(0);
        unsigned nloc = b.st[0], nx = b.st[1];
        if (nloc == 0u) { xcd_barrier_complete(bar, b.x, nloc, nx); b.st[0] = nloc; b.st[1] = nx; }
        const unsigned old = xb_add(&bar[XB_XSUB(b.x)], 1u);
        const unsigned gen = old / nloc;
        if (old + 1u == (gen + 1u) * nloc) {
            __builtin_amdgcn_fence(__ATOMIC_RELEASE, "agent");
            asm volatile("s_waitcnt vmcnt(0)" ::: "memory");
            const unsigned og = xb_add(&bar[XB_TOP], 1u);
            const unsigned tg = og / nx;
            if (og + 1u == (tg + 1u) * nx) xb_add(&bar[XB_TOPGEN], 1u);
            else XB_SPIN(xb_ld(&bar[XB_TOPGEN]) == tg, bar);
            __builtin_amdgcn_fence(__ATOMIC_ACQUIRE, "agent");
            xb_add(&bar[XB_XGEN(b.x)], 1u);
            asm volatile("s_waitcnt vmcnt(0)" ::: "memory");
        } else {
            XB_SPIN(xb_ld(&bar[XB_XGEN(b.x)]) == gen, bar);
            __builtin_amdgcn_fence(__ATOMIC_ACQUIRE, "agent");
            asm volatile("s_waitcnt vmcnt(0)" ::: "memory");
        }
    }
    __syncthreads();
}

using pg8::Unit;
struct DenseOrder {
    unsigned A, B; int nM, nN, nwg, G, c; unsigned tA, tB;
    __device__ __forceinline__ void init(size_t A_, int lda, size_t B_, int ldb, int M, int N, int G_, int c_) { A = (unsigned)A_; B = (unsigned)B_; nM = M / 256; nN = N / 256; nwg = nM * nN; G = G_; c = c_; tA = 256u * lda * 2; tB = 256u * ldb * 2; }
    __device__ __forceinline__ bool next(int i, Unit& u) const {
        const long L = (long)i * G + c; if (L >= nwg) return false;
        const int w = pg8::xcd_remap((int)L, nwg); pg8::walk2d(w, nM, nN, u.pm, u.pn);
        u.a = A + (unsigned)u.pm * tA; u.b = B + (unsigned)u.pn * tB; u.grp = 0; u.rows = 256; return true;
    }
};
struct A1Order {
    unsigned XB, WQKG, WVT, t; int G, c;
    __device__ __forceinline__ bool next(int i, Unit& u) const {
        const long L = (long)i * G + c; if (L >= 32 * 48) return false;
        const int w = pg8::xcd_remap((int)L, 32 * 48); pg8::walk2d(w, 32, 48, u.pm, u.pn);
        if (u.pn < 32) { u.a = XB + (unsigned)u.pm * t; u.b = WQKG + (unsigned)u.pn * t; } else { u.a = WVT + (unsigned)(u.pn - 32) * t; u.b = XB + (unsigned)u.pm * t; }
        u.grp = 0; u.rows = 256; return true;
    }
};
struct PoolOrder {
    unsigned MIX, W; int G, c;
    __device__ __forceinline__ bool next(int i, Unit& u) const {
        const long L = (long)i * G + c; if (L >= 256) return false;
        const int rem = (int)L & 7; u.pm = (int)L >> 3; u.grp = rem >> 1; u.pn = rem & 1;
        u.a = MIX + ((unsigned)u.pm * 256 * D + (unsigned)u.grp * 512) * 2; u.b = W + ((unsigned)u.grp * 512 * 512 + (unsigned)u.pn * 256 * 512) * 2; u.rows = 256; return true;
    }
};
struct MoeOrder {
    unsigned A, B; int G, c, nN, total; int cnt[8], pre[9]; unsigned eA, eB, tA, tB;
    __device__ __forceinline__ void init(size_t A_, size_t eA_, int lda, size_t B_, size_t eB_, int ldb, int nN_, const unsigned* counts, int G_, int c_, int es = 2) {
        A = (unsigned)A_; B = (unsigned)B_; eA = (unsigned)eA_; eB = (unsigned)eB_; tA = 256u * lda * es; tB = 256u * ldb * es; nN = nN_; G = G_; c = c_;
        int p = 0;
#pragma unroll
        for (int e = 0; e < 8; ++e) { int n = (int)__builtin_amdgcn_readfirstlane(__hip_atomic_load(counts + 64 * e, __ATOMIC_RELAXED, __HIP_MEMORY_SCOPE_AGENT)); n = n > NT ? NT : n; cnt[e] = n; pre[e] = p; p += (n + 255) >> 8; }
        pre[8] = p; total = p * nN;
    }
    __device__ __forceinline__ bool next(int i, Unit& u) const {
        const long L = (long)i * G + c; if (L >= total) return false;
        const int w = pg8::xcd_remap((int)L, total);
        int e = 0;
#pragma unroll
        for (int j = 1; j < 8; ++j) e += (w >= pre[j] * nN) ? 1 : 0;
        int pe = 0, ce = 0, te = 0;
#pragma unroll
        for (int j = 0; j < 8; ++j) { if (j == e) { pe = pre[j]; ce = cnt[j]; te = pre[j + 1] - pre[j]; } }
        pg8::walk2d(w - pe * nN, te, nN, u.pm, u.pn);
        u.grp = e; u.rows = ce - u.pm * 256;
        u.a = A + (unsigned)e * eA + (unsigned)u.pm * tA; u.b = B + (unsigned)e * eB + (unsigned)u.pn * tB; return true;
    }
};

struct EpiA1 {
    bf16_t* QB; bf16_t* KB; bf16_t* GB; bf16_t* VT; const float* COS; const float* SIN; const float* DQ; const float* DKS; float ascale; int r8; const float* SA; const float* SWQ; const float* SWV;
    __device__ __forceinline__ void operator()(const f32x4 (&acc)[2][2][4][2], const Unit& u, int wr, int wc, int fr, int fq) const {
        if (u.pn < 32) {
            const int kind = u.pn < 8 ? 0 : (u.pn < 16 ? 1 : 2), h = u.pn & 7;
#pragma unroll
            for (int ai = 0; ai < 2; ++ai)
#pragma unroll
                for (int m = 0; m < 4; ++m) {
                    const int row = u.pm * 256 + ai * 128 + wr * 64 + m * 16 + fr, pos = row & (SEQ - 1);
                    float rf = ascale; if (kind < 2) rf = ascale * (kind == 0 ? DQ : DKS)[h * 128 + (pos & 127)];
                    if (SA) rf *= SA[row];
#pragma unroll
                    for (int bj = 0; bj < 2; ++bj) {
                        const int cc = bj * 128 + wc * 32 + fq * 8;
                        f32x4 v0 = acc[ai][bj][m][0], v1 = acc[ai][bj][m][1];
                        if (SA) { v0 = v0 * *(const f32x4*)(SWQ + u.pn * 256 + cc); v1 = v1 * *(const f32x4*)(SWQ + u.pn * 256 + cc + 4); }
                        bf16_t* dst;
                        if (kind < 2) {
                            const f32x4 cs = *(const f32x4*)(COS + pos * 128 + (cc >> 1)), sn = *(const f32x4*)(SIN + pos * 128 + (cc >> 1));
                            f32x4 o0, o1;
                            o0[0] = v0[0] * cs[0] - v0[1] * sn[0]; o0[1] = v0[1] * cs[0] + v0[0] * sn[0];
                            o0[2] = v0[2] * cs[1] - v0[3] * sn[1]; o0[3] = v0[3] * cs[1] + v0[2] * sn[1];
                            o1[0] = v1[0] * cs[2] - v1[1] * sn[2]; o1[1] = v1[1] * cs[2] + v1[0] * sn[2];
                            o1[2] = v1[2] * cs[3] - v1[3] * sn[3]; o1[3] = v1[3] * cs[3] + v1[2] * sn[3];
                            v0 = o0 * rf; v1 = o1 * rf;
                            dst = (kind == 0 ? QB : KB) + (size_t)row * QKW + h * 256 + cc;
                        } else { v0 = v0 * rf; v1 = v1 * rf; dst = GB + (size_t)row * VW + (u.pn - 16) * 256 + cc; }
                        if (r8 && kind < 2) { int w0 = 0, w1 = 0; w0 = __builtin_amdgcn_cvt_pk_fp8_f32(v0[0], v0[1], w0, false); w0 = __builtin_amdgcn_cvt_pk_fp8_f32(v0[2], v0[3], w0, true);
                            w1 = __builtin_amdgcn_cvt_pk_fp8_f32(v1[0], v1[1], w1, false); w1 = __builtin_amdgcn_cvt_pk_fp8_f32(v1[2], v1[3], w1, true); u32x2 w; w.x = (unsigned)w0; w.y = (unsigned)w1;
                            *(u32x2*)((unsigned char*)(kind == 0 ? QB : KB) + (size_t)row * QKW + h * 256 + cc) = w; }
                        else { u32x4 w; w.x = cvt_pk_bf16(v0[0], v0[1]); w.y = cvt_pk_bf16(v0[2], v0[3]); w.z = cvt_pk_bf16(v1[0], v1[1]); w.w = cvt_pk_bf16(v1[2], v1[3]);
                            *(u32x4*)dst = w; }
                    }
                }
        } else {
#pragma unroll
            for (int ai = 0; ai < 2; ++ai)
#pragma unroll
                for (int m = 0; m < 4; ++m) {
                    const int vrow = (u.pn - 32) * 256 + ai * 128 + wr * 64 + m * 16 + fr; const float rsv = SA ? ascale * SWV[vrow] : ascale;
#pragma unroll
                    for (int bj = 0; bj < 2; ++bj) {
                        const int tok = u.pm * 256 + bj * 128 + wc * 32 + fq * 8;
                        f32x4 v0 = acc[ai][bj][m][0] * rsv, v1 = acc[ai][bj][m][1] * rsv;
                        if (SA) { v0 = v0 * *(const f32x4*)(SA + tok); v1 = v1 * *(const f32x4*)(SA + tok + 4); }
                        if (r8) { int w0 = 0, w1 = 0; w0 = __builtin_amdgcn_cvt_pk_fp8_f32(v0[0], v0[1], w0, false); w0 = __builtin_amdgcn_cvt_pk_fp8_f32(v0[2], v0[3], w0, true);
                            w1 = __builtin_amdgcn_cvt_pk_fp8_f32(v1[0], v1[1], w1, false); w1 = __builtin_amdgcn_cvt_pk_fp8_f32(v1[2], v1[3], w1, true); u32x2 w; w.x = (unsigned)w0; w.y = (unsigned)w1;
                            *(u32x2*)((unsigned char*)VT + (size_t)vrow * NT + tok) = w; }
                        else { u32x4 w; w.x = cvt_pk_bf16(v0[0], v0[1]); w.y = cvt_pk_bf16(v0[2], v0[3]); w.z = cvt_pk_bf16(v1[0], v1[1]); w.w = cvt_pk_bf16(v1[2], v1[3]);
                            *(u32x4*)(VT + (size_t)vrow * NT + tok) = w; }
                    }
                }
        }
    }
};
struct EpiRes {
    bf16_t* X; bf16_t* XB; float* ROWSS; const float* colscale; int pool; float ascale; unsigned char* XB8;
    __device__ __forceinline__ void operator()(const f32x4 (&acc)[2][2][4][2], const Unit& u, int wr, int wc, int fr, int fq) const {
        const int colbase = pool ? (u.grp * 512 + u.pn * 256) : u.pn * 256;
        f32x4 cs[2][2];
#pragma unroll
        for (int bj = 0; bj < 2; ++bj)
#pragma unroll
            for (int n = 0; n < 2; ++n) cs[bj][n] = (colscale ? *(const f32x4*)(colscale + colbase + bj * 128 + wc * 32 + fq * 8 + n * 4) : (f32x4){1.f, 1.f, 1.f, 1.f}) * ascale;
#pragma unroll
        for (int ai = 0; ai < 2; ++ai)
#pragma unroll
            for (int m = 0; m < 4; ++m) {
                const int row = u.pm * 256 + ai * 128 + wr * 64 + m * 16 + fr;
                float ss = 0.f;
#pragma unroll
                for (int bj = 0; bj < 2; ++bj) {
                    const size_t off = (size_t)row * D + colbase + bj * 128 + wc * 32 + fq * 8;
                    const u32x4 xw = *(const u32x4*)(X + off); const f32x4 x0 = bf4((u32x2){xw.x, xw.y}), x1 = bf4((u32x2){xw.z, xw.w});
                    const f32x4 v0 = x0 + acc[ai][bj][m][0] * cs[bj][0], v1 = x1 + acc[ai][bj][m][1] * cs[bj][1];
                    { u32x4 w; w.x = cvt_pk_bf16(v0[0], v0[1]); w.y = cvt_pk_bf16(v0[2], v0[3]); w.z = cvt_pk_bf16(v1[0], v1[1]); w.w = cvt_pk_bf16(v1[2], v1[3]); *(u32x4*)(X + off) = w; }
                    if (XB) { u32x4 w; w.x = cvt_pk_bf16(v0[0], v0[1]); w.y = cvt_pk_bf16(v0[2], v0[3]); w.z = cvt_pk_bf16(v1[0], v1[1]); w.w = cvt_pk_bf16(v1[2], v1[3]); *(u32x4*)(XB + off) = w; }
                    if (XB8) { int w0 = 0, w1 = 0; w0 = __builtin_amdgcn_cvt_pk_fp8_f32(v0[0], v0[1], w0, false); w0 = __builtin_amdgcn_cvt_pk_fp8_f32(v0[2], v0[3], w0, true);
                        w1 = __builtin_amdgcn_cvt_pk_fp8_f32(v1[0], v1[1], w1, false); w1 = __builtin_amdgcn_cvt_pk_fp8_f32(v1[2], v1[3], w1, true); u32x2 w; w.x = (unsigned)w0; w.y = (unsigned)w1; *(u32x2*)(XB8 + off) = w; }
                    ss += (v0[0] * v0[0] + v0[1] * v0[1]) + (v0[2] * v0[2] + v0[3] * v0[3]) + (v1[0] * v1[0] + v1[1] * v1[1]) + (v1[2] * v1[2] + v1[3] * v1[3]);
                }
                ss += __shfl_xor(ss, 16); ss += __shfl_xor(ss, 32);
                if (fq == 0) ROWSS[(size_t)row * 32 + (colbase >> 8) * 4 + wc] = ss;
                if (m & 1) asm volatile("" ::: "memory");
            }
    }
};
struct EpiZ {
    bf16_t* Z;
    __device__ __forceinline__ void operator()(const f32x4 (&acc)[2][2][4][2], const Unit& u, int wr, int wc, int fr, int fq) const {
#pragma unroll
        for (int ai = 0; ai < 2; ++ai)
#pragma unroll
            for (int m = 0; m < 4; ++m) { const int row = u.pm * 256 + ai * 128 + wr * 64 + m * 16 + fr;
#pragma unroll
                for (int bj = 0; bj < 2; ++bj) { const f32x4 v0 = acc[ai][bj][m][0], v1 = acc[ai][bj][m][1];
                    u32x4 w; w.x = cvt_pk_bf16(v0[0], v0[1]); w.y = cvt_pk_bf16(v0[2], v0[3]); w.z = cvt_pk_bf16(v1[0], v1[1]); w.w = cvt_pk_bf16(v1[2], v1[3]);
                    *(u32x4*)(Z + (size_t)row * D + u.grp * 512 + u.pn * 256 + bj * 128 + wc * 32 + fq * 8) = w; } }
    }
};
struct EpiGU {
    bf16_t* ACT; int ldact; const float* ROWSS; size_t estride;
    __device__ __forceinline__ void operator()(const f32x4 (&acc)[2][2][4][2], const Unit& u, int wr, int wc, int fr, int fq) const {
        bf16_t* base = ACT + (size_t)u.grp * estride;
#pragma unroll
        for (int ai = 0; ai < 2; ++ai)
#pragma unroll
            for (int m = 0; m < 4; ++m) {
                const int row = u.pm * 256 + ai * 128 + wr * 64 + m * 16 + fr;
                float rs = 1.f;
                if (ROWSS) { const f32x4 p0 = *(const f32x4*)(ROWSS + (size_t)row * 32 + fq * 8), p1 = *(const f32x4*)(ROWSS + (size_t)row * 32 + fq * 8 + 4);
                    float s = (p0[0] + p0[1]) + (p0[2] + p0[3]) + (p1[0] + p1[1]) + (p1[2] + p1[3]); s += __shfl_xor(s, 16); s += __shfl_xor(s, 32); rs = __builtin_amdgcn_rsqf(s * (1.0f / D) + EPS); }
                float o[8];
#pragma unroll
                for (int n = 0; n < 2; ++n)
#pragma unroll
                    for (int j = 0; j < 4; ++j) { const float a = acc[ai][0][m][n][j] * rs, g = acc[ai][1][m][n][j] * rs; o[n * 4 + j] = a * fast_sigmoid(a) * g; }
                u32x4 w; w.x = cvt_pk_bf16(o[0], o[1]); w.y = cvt_pk_bf16(o[2], o[3]); w.z = cvt_pk_bf16(o[4], o[5]); w.w = cvt_pk_bf16(o[6], o[7]);
                *(u32x4*)(base + (size_t)row * ldact + u.pn * 128 + wc * 32 + fq * 8) = w;
            }
    }
};
struct EpiGUi8 {
    bf16_t* ACT; int ldact; const float* SA; const float* SW; int out8; size_t estride; int sastride, swstride;
    __device__ __forceinline__ void operator()(const f32x4 (&acc)[2][2][4][2], const Unit& u, int wr, int wc, int fr, int fq) const {
        f32x4 wa[2], wu[2];
#pragma unroll
        for (int n = 0; n < 2; ++n) { wa[n] = *(const f32x4*)(SW + u.grp * swstride + u.pn * 256 + wc * 32 + fq * 8 + n * 4); wu[n] = *(const f32x4*)(SW + u.grp * swstride + u.pn * 256 + 128 + wc * 32 + fq * 8 + n * 4); }
#pragma unroll
        for (int ai = 0; ai < 2; ++ai)
#pragma unroll
            for (int m = 0; m < 4; ++m) {
                const int row = u.pm * 256 + ai * 128 + wr * 64 + m * 16 + fr; const float sa = SA[u.grp * sastride + row];
                float o[8];
#pragma unroll
                for (int n = 0; n < 2; ++n)
#pragma unroll
                    for (int j = 0; j < 4; ++j) { const float a = acc[ai][0][m][n][j] * sa * wa[n][j], g = acc[ai][1][m][n][j] * sa * wu[n][j]; o[n * 4 + j] = a * fast_sigmoid(a) * g; }
                if (out8) { u32x2 w; w.x = 0u; w.y = 0u;
                    w.x = (unsigned)__builtin_amdgcn_cvt_pk_fp8_f32(o[0], o[1], (int)w.x, false); w.x = (unsigned)__builtin_amdgcn_cvt_pk_fp8_f32(o[2], o[3], (int)w.x, true);
                    w.y = (unsigned)__builtin_amdgcn_cvt_pk_fp8_f32(o[4], o[5], (int)w.y, false); w.y = (unsigned)__builtin_amdgcn_cvt_pk_fp8_f32(o[6], o[7], (int)w.y, true);
                    *(u32x2*)((unsigned char*)ACT + (size_t)u.grp * estride + (size_t)row * ldact + u.pn * 128 + wc * 32 + fq * 8) = w; }
                else { u32x4 w; w.x = cvt_pk_bf16(o[0], o[1]); w.y = cvt_pk_bf16(o[2], o[3]); w.z = cvt_pk_bf16(o[4], o[5]); w.w = cvt_pk_bf16(o[6], o[7]);
                    *(u32x4*)(ACT + (size_t)row * ldact + u.pn * 128 + wc * 32 + fq * 8) = w; }
            }
    }
};
struct EpiGU8 {
    unsigned char* ACT; int ldact; size_t estride; float s; const float* ROWSS;
    __device__ __forceinline__ void operator()(const f32x4 (&acc)[2][2][4][2], const Unit& u, int wr, int wc, int fr, int fq) const {
        unsigned char* base = ACT + (size_t)u.grp * estride;
#pragma unroll
        for (int ai = 0; ai < 2; ++ai)
#pragma unroll
            for (int m = 0; m < 4; ++m) {
                const int row = u.pm * 256 + ai * 128 + wr * 64 + m * 16 + fr;
                float rs = s;
                if (ROWSS) { const f32x4 p0 = *(const f32x4*)(ROWSS + (size_t)row * 32 + fq * 8), p1 = *(const f32x4*)(ROWSS + (size_t)row * 32 + fq * 8 + 4);
                    float q = (p0[0] + p0[1]) + (p0[2] + p0[3]) + (p1[0] + p1[1]) + (p1[2] + p1[3]); q += __shfl_xor(q, 16); q += __shfl_xor(q, 32); rs = s * __builtin_amdgcn_rsqf(q * (1.0f / D) + EPS); }
                float o[8];
#pragma unroll
                for (int n = 0; n < 2; ++n)
#pragma unroll
                    for (int j = 0; j < 4; ++j) { const float a = acc[ai][0][m][n][j] * rs, g = acc[ai][1][m][n][j] * rs; o[n * 4 + j] = a * fast_sigmoid(a) * g; }
                u32x2 w; w.x = 0u; w.y = 0u;
                w.x = (unsigned)__builtin_amdgcn_cvt_pk_fp8_f32(o[0], o[1], (int)w.x, false); w.x = (unsigned)__builtin_amdgcn_cvt_pk_fp8_f32(o[2], o[3], (int)w.x, true);
                w.y = (unsigned)__builtin_amdgcn_cvt_pk_fp8_f32(o[4], o[5], (int)w.y, false); w.y = (unsigned)__builtin_amdgcn_cvt_pk_fp8_f32(o[6], o[7], (int)w.y, true);
                *(u32x2*)(base + (size_t)row * ldact + u.pn * 128 + wc * 32 + fq * 8) = w;
            }
    }
};
struct EpiMoeDown {
    bf16_t* Y; const int* TOK; const float* GATE; float wscale;
    __device__ __forceinline__ void operator()(const f32x4 (&acc)[2][2][4][2], const Unit& u, int wr, int wc, int fr, int fq) const {
#pragma unroll
        for (int ai = 0; ai < 2; ++ai)
#pragma unroll
            for (int m = 0; m < 4; ++m) {
                const int rloc = ai * 128 + wr * 64 + m * 16 + fr;
                if (rloc < u.rows) {
                    const int gi = u.grp * NT + u.pm * 256 + rloc; const int t2 = TOK[gi]; const float gt = GATE[gi] * wscale;
                    bf16_t* dst = Y + ((size_t)(t2 & 1) * NT + (size_t)(t2 >> 1)) * D + u.pn * 256 + wc * 32 + fq * 8;
#pragma unroll
                    for (int bj = 0; bj < 2; ++bj) { const f32x4 v0 = acc[ai][bj][m][0] * gt, v1 = acc[ai][bj][m][1] * gt;
                        u32x4 w; w.x = cvt_pk_bf16(v0[0], v0[1]); w.y = cvt_pk_bf16(v0[2], v0[3]); w.z = cvt_pk_bf16(v1[0], v1[1]); w.w = cvt_pk_bf16(v1[2], v1[3]);
                        *(u32x4*)(dst + bj * 128) = w; }
                }
            }
    }
};

struct Frame {
    LAS unsigned char* lds; int tid, lane, wave, G, bid, wv;
    float* out; unsigned char* ws;
};
struct Params { const float* in[14]; float* out; unsigned char* ws; int ph_lo, ph_hi; };

struct TrItem { const float* src; unsigned char* dst; const float* ks; int srcld, dstpitch, f8; };
__device__ __forceinline__ TrItem tr_make(int r, const float* src, int srcld, int K, int col_begin, int ncols, void* dst, int row_begin, int mode, const float* kscale, int f8 = 0, int pitch8 = 0) {
    const int nb = ncols / 64, g = r >> 2, tq = r & 3, kb = 2 * (g / (nb >> 1)) + (tq >> 1), jb = 2 * (g % (nb >> 1)) + (tq & 1), j0 = jb * 64, k0 = kb * 64;
    const int drow = mode ? (256 * (j0 >> 7) + (j0 & 127) + row_begin) : (row_begin + j0);
    TrItem t; t.src = src + (size_t)k0 * srcld + col_begin + j0; t.ks = kscale ? kscale + k0 : nullptr; t.srcld = srcld;
    if (f8) { t.dst = (unsigned char*)dst + (size_t)drow * pitch8 + k0; t.dstpitch = pitch8; t.f8 = (f8 == 2 && kb == K / 64 - 1) ? 2 : 1; }
    else { t.dst = (unsigned char*)dst + ((size_t)drow * K + k0) * 2; t.dstpitch = K * 2; t.f8 = 0; }
    return t;
}
constexpr int IT_A = 2048 * 4 + 2816 * 3, IT_B = 256 + 5632 * 3;
__device__ __forceinline__ TrItem conv_item_A(const Params& PA, unsigned char* ws, int l, int r) {
    const float* w_in = PA.in[1] + (size_t)l * D * 12288; const float* gm = PA.in[11] + (size_t)(2 * l) * D; const float* gf = PA.in[12] + (size_t)(2 * l) * D;
    bf16_t* WQKG = (bf16_t*)(ws + WS_WQKG + l * SZ_WQKG); bf16_t* WVT = (bf16_t*)(ws + WS_WVT + l * SZ_WVT);
    const int p8 = (PROJ8 >> l) & 1;
    if (r < 2048) return tr_make(r, w_in, 12288, D, 0, 4096, WQKG, 0, 0, gm, p8, D); r -= 2048;
    if (r < 2048) return tr_make(r, w_in, 12288, D, 8192, 4096, WQKG, 4096, 0, gm, p8, D); r -= 2048;
    if (r < 2048) return tr_make(r, w_in, 12288, D, 4096, 4096, WVT, 0, 0, gm, p8, D); r -= 2048;
    if (r < 2048) return tr_make(r, PA.in[3] + (size_t)l * VW * D, D, VW, 0, D, (bf16_t*)(ws + WS_WOUT + l * SZ_WOUT), 0, 0, nullptr, p8, VW); r -= 2048;
    const float* gu = PA.in[6] + (size_t)l * D * 2 * FF; bf16_t* WGU = (bf16_t*)(ws + WS_WGU + l * SZ_WGU); const int d8 = (DENSE8 >> l) & 1;
    if (r < 2816) return tr_make(r, gu, 2 * FF, D, 0, FF, WGU, 0, 1, gf, d8, D); r -= 2816;
    if (r < 2816) return tr_make(r, gu, 2 * FF, D, FF, FF, WGU, 128, 1, gf, d8, D); r -= 2816;
    return tr_make(r, PA.in[7] + (size_t)l * FF * D, D, FF, 0, D, (bf16_t*)(ws + WS_WDN + l * SZ_WDN), 0, 0, nullptr, d8, FF);
}
__device__ __forceinline__ TrItem conv_item_B(const Params& PA, unsigned char* ws, int l, int r) {
    if (r < 256) { const int g = r >> 6; return tr_make(r & 63, PA.in[4] + ((size_t)l * 4 + g) * 512 * 512, 512, 512, 0, 512, (bf16_t*)(ws + WS_WPOOL + l * SZ_WPOOL) + (size_t)g * 512 * 512, 0, 0, PA.in[11] + (size_t)(2 * l + 1) * D + g * 512); } r -= 256;
    const int f8 = (F8MASK >> l) & 1;
    if (r < 5632) { const int e = r / 704; unsigned char* d = ws + WS_WMGU + l * SZ_WMGU + (size_t)e * 2 * FE * D * (f8 ? 1 : 2); return tr_make(r % 704, PA.in[9] + ((size_t)l * NE + e) * D * 2 * FE, 2 * FE, D, 0, FE, d, 0, 1, nullptr, f8, D); } r -= 5632;
    if (r < 5632) { const int e = r / 704; unsigned char* d = ws + WS_WMGU + l * SZ_WMGU + (size_t)e * 2 * FE * D * (f8 ? 1 : 2); return tr_make(r % 704, PA.in[9] + ((size_t)l * NE + e) * D * 2 * FE, 2 * FE, D, FE, FE, d, 128, 1, nullptr, f8, D); } r -= 5632;
    { const int e = r / 704; unsigned char* d = ws + WS_WMDN + l * SZ_WMDN + (size_t)e * D * (f8 ? FE8 : FE * 2); return tr_make(r % 704, PA.in[10] + ((size_t)l * NE + e) * FE * D, D, FE, 0, D, d, 0, 0, nullptr, f8 ? 2 : 0, FE8); }
}
__device__ __forceinline__ int conv_batch_size(int b) { return b == 0 ? (IT_A - ((I8A1 & 1) ? 6144 : 0) - ((I8A4 & 1) ? 5632 : 0)) : b == 1 ? ((I8B4 & 1) ? 256 : 11520) : b == 2 ? (5632 + 8192 - ((I8A1 & 2) ? 6144 : 0)) : b == 3 ? (8448 + 256 + 5632) : ((I8B4 & 2) ? 0 : 11264); }
__device__ __forceinline__ TrItem conv_batch_item(const Params& PA, unsigned char* ws, int b, int r) {
    if (b == 0) { if (I8A1 & 1) r += 6144; if ((I8A4 & 1) && r >= 8192) r += 5632; return conv_item_A(PA, ws, 0, r); }
    if (b == 1) return conv_item_B(PA, ws, 0, r);
    if (b == 2) { if (r < 5632) return conv_item_B(PA, ws, 0, 11520 + r); return conv_item_A(PA, ws, 1, r - 5632 + ((I8A1 & 2) ? 6144 : 0)); }
    if (b == 3) { if (r < 8448) return conv_item_A(PA, ws, 1, 8192 + r); if (r < 8448 + 256) return conv_item_B(PA, ws, 1, r - 8448); return conv_item_B(PA, ws, 1, 11520 + (r - 8448 - 256)); }
    return conv_item_B(PA, ws, 1, 256 + r);
}
__device__ __forceinline__ void tr_load(const TrItem& t, f32x4 (&v)[16], int lane) {
#pragma unroll
    for (int it = 0; it < 16; ++it) { const int kk = it * 4 + (lane >> 4), cc = (lane & 15) * 4; v[it] = *(const f32x4*)(t.src + (size_t)kk * t.srcld + cc); }
}
__device__ __forceinline__ void tr_process(const TrItem& t, const f32x4 (&v)[16], LAS float* scr, int lane) {
    const int c = lane & 7;
    f32x4 k0 = (f32x4){1.f, 1.f, 1.f, 1.f}, k1 = k0; if (t.ks) { k0 = *(const f32x4*)(t.ks + 8 * c); k1 = *(const f32x4*)(t.ks + 8 * c + 4); }
    if (t.f8) { k0 = k0 * 32.0f; k1 = k1 * 32.0f; }
#pragma unroll
    for (int it = 0; it < 16; ++it) { const int kk = it * 4 + (lane >> 4), cc = (lane & 15) * 4;
        LAS float* p = scr + kk * 65 + cc; p[0] = v[it][0]; p[1] = v[it][1]; p[2] = v[it][2]; p[3] = v[it][3]; }
    LDS_WAIT(); asm volatile("" ::: "memory");
    if (t.f8 == 0) {
#pragma unroll
        for (int it = 0; it < 8; ++it) { const int n = it * 8 + (lane >> 3); const LAS float* s = scr + (8 * c) * 65 + n;
            u32x4 o; o.x = cvt_pk_bf16(s[0] * k0[0], s[65] * k0[1]); o.y = cvt_pk_bf16(s[2 * 65] * k0[2], s[3 * 65] * k0[3]); o.z = cvt_pk_bf16(s[4 * 65] * k1[0], s[5 * 65] * k1[1]); o.w = cvt_pk_bf16(s[6 * 65] * k1[2], s[7 * 65] * k1[3]);
            *(u32x4*)(t.dst + (size_t)n * t.dstpitch + 16 * c) = o; }
    } else {
#pragma unroll
        for (int it = 0; it < 8; ++it) { const int n = it * 8 + (lane >> 3); const LAS float* s = scr + (8 * c) * 65 + n;
            int w0 = 0, w1 = 0;
            w0 = __builtin_amdgcn_cvt_pk_fp8_f32(s[0] * k0[0], s[65] * k0[1], w0, false); w0 = __builtin_amdgcn_cvt_pk_fp8_f32(s[2 * 65] * k0[2], s[3 * 65] * k0[3], w0, true);
            w1 = __builtin_amdgcn_cvt_pk_fp8_f32(s[4 * 65] * k1[0], s[5 * 65] * k1[1], w1, false); w1 = __builtin_amdgcn_cvt_pk_fp8_f32(s[6 * 65] * k1[2], s[7 * 65] * k1[3], w1, true);
            u32x2 o; o.x = (unsigned)w0; o.y = (unsigned)w1;
            *(u32x2*)(t.dst + (size_t)n * t.dstpitch + 8 * c) = o;
            if (t.f8 == 2) *(u32x4*)(t.dst + (size_t)n * t.dstpitch + 64 + 16 * c) = (u32x4){0u, 0u, 0u, 0u}; }
    }
    LDS_WAIT(); asm volatile("" ::: "memory");
}
__device__ __forceinline__ void conv_queue(Frame& F_, const Params& PA, int b) {
    Frame F = F_; { int t_ = mk_tid(F_.wv); asm volatile("" : "+v"(t_)); F.tid = t_; F.lane = t_ & 63; F.wave = __builtin_amdgcn_readfirstlane(t_ >> 6); }
    LAS float* scr = (LAS float*)(F.lds + F.wave * 16640);
    unsigned* qb = (unsigned*)(F.ws + WS_CTL) + CW_Q + 512 * b; const int n = conv_batch_size(b), per = n / 8;
    for (int k = 0; k < 8; ++k) {
        const int sq = (F.bid + k) & 7; unsigned* q = qb + 64 * sq;
        for (;;) {
            unsigned r = 0; if (F.lane == 0) r = __hip_atomic_fetch_add(q, 4u, __ATOMIC_RELAXED, __HIP_MEMORY_SCOPE_AGENT);
            r = (unsigned)__builtin_amdgcn_readfirstlane((int)r);
            if (r >= (unsigned)per) break;
            const int base = sq * per + (int)r;
            f32x4 va[16], vb[16];
            TrItem ta = conv_batch_item(PA, F.ws, b, base), tb = conv_batch_item(PA, F.ws, b, base + 1);
            tr_load(ta, va, F.lane); tr_load(tb, vb, F.lane);
            tr_process(ta, va, scr, F.lane); ta = conv_batch_item(PA, F.ws, b, base + 2); tr_load(ta, va, F.lane);
            tr_process(tb, vb, scr, F.lane); tb = conv_batch_item(PA, F.ws, b, base + 3); tr_load(tb, vb, F.lane);
            tr_process(ta, va, scr, F.lane);
            tr_process(tb, vb, scr, F.lane);
        }
    }
}
__device__ __forceinline__ int pack_i8x4(f32x4 v) {
    const int a = (int)rintf(v[0]), b = (int)rintf(v[1]), c = (int)rintf(v[2]), d = (int)rintf(v[3]);
    return (a & 0xff) | ((b & 0xff) << 8) | ((c & 0xff) << 16) | (d << 24);
}
__device__ __forceinline__ float wave_max(float v) {
#pragma unroll
    for (int o = 1; o < 64; o <<= 1) v = fmaxf(v, __shfl_xor(v, o));
    return v;
}
struct StripJob { const float* src; const float* ks; unsigned char* dst; float* sw; int srcld; };
__device__ __forceinline__ StripJob strip_make(const Params& PA, unsigned char* ws, int l, int st) {
    StripJob J;
    if (st < 384) { const int c0 = st * 32; J.srcld = 12288; J.src = PA.in[1] + (size_t)l * D * 12288 + c0; J.ks = PA.in[11] + (size_t)(2 * l) * D;
        J.dst = c0 < 4096 ? ws + WS_WQKG + l * SZ_WQKG + (size_t)c0 * D : (c0 < 8192 ? ws + WS_WVT + l * SZ_WVT + (size_t)(c0 - 4096) * D : ws + WS_WQKG + l * SZ_WQKG + (size_t)(c0 - 4096) * D);
        J.sw = c0 < 4096 ? (float*)(ws + WS_SWQ + l * SZ_SWL) + c0 : (c0 < 8192 ? (float*)(ws + WS_SWV + l * SZ_SWL) + (c0 - 4096) : (float*)(ws + WS_SWQ + l * SZ_SWL) + (c0 - 4096));
    } else if (st < 736) { const int s4 = st - 384, part = s4 / 176, j0 = (s4 % 176) * 32, drow = 256 * (j0 >> 7) + (j0 & 127) + 128 * part; J.srcld = 2 * FF;
        J.src = PA.in[6] + (size_t)l * D * 2 * FF + part * FF + j0; J.ks = PA.in[12] + (size_t)(2 * l) * D; J.dst = ws + WS_WGU + l * SZ_WGU + (size_t)drow * D; J.sw = (float*)(ws + WS_SWGU + l * SZ_SWL) + drow;
    } else { const int sm = st - 736, e = sm / 88, s4 = sm % 88, part = s4 / 44, j0 = (s4 % 44) * 32, drow = 256 * (j0 >> 7) + (j0 & 127) + 128 * part; J.srcld = 2 * FE;
        J.src = PA.in[9] + ((size_t)l * NE + e) * D * 2 * FE + part * FE + j0; J.ks = nullptr; J.dst = ws + WS_WMGU + l * SZ_WMGU + (size_t)e * 2 * FE * D + (size_t)drow * D; J.sw = (float*)(ws + WS_SWM) + (l * NE + e) * 2 * FE + drow; }
    return J;
}
template <bool DYN>
__device__ __forceinline__ void strip_loop(Frame& F_, const Params& PA, int l, int first, int end, int step, int base, int qi) {
    Frame F = F_; { int t_ = mk_tid(F_.wv); asm volatile("" : "+v"(t_)); F.tid = t_; F.lane = t_ & 63; F.wave = __builtin_amdgcn_readfirstlane(t_ >> 6); }
    constexpr int PITCH = 4104;
    LAS unsigned char* T = F.lds;
    LAS float* smax = (LAS float*)(F.lds + MISC_OFF + 1024);
    LAS float* cfin = smax + 256;
    volatile LAS unsigned* slot = (volatile LAS unsigned*)(F.lds + MISC_OFF + 512);
    unsigned* q = (unsigned*)(F.ws + WS_CTL) + CW_Q + 512 * 5 + 64 * qi;
    const int lane = F.lane, cq = lane & 7, r8 = lane >> 3;
    int st = first;
    if (DYN) { if (F.tid == 0) slot[0] = __hip_atomic_fetch_add(q, 1u, __ATOMIC_RELAXED, __HIP_MEMORY_SCOPE_AGENT);
        __syncthreads(); st = (int)slot[0]; __syncthreads(); }
    if (st >= end) return;
    StripJob J = strip_make(PA, F.ws, l, base + st);
    u32x4 va[16], vb[16]; float gq[4];
#define W8_ISSUE(JJ, LIVE) do { const __amdgpu_buffer_rsrc_t rs_ = __builtin_amdgcn_make_buffer_rsrc((void*)(JJ).src, 0, (LIVE) ? (D - 1) * (JJ).srcld * 4 + 128 : 0, 0x00020000);     \
        const int voff_ = (r8 * (JJ).srcld + 4 * cq) * 4, sbase_ = F.wave * 256 * (JJ).srcld * 4, sstep_ = 8 * (JJ).srcld * 4; \
        { const float* ksp_ = (JJ).ks ? (JJ).ks : PA.in[11]; const float one_ = (JJ).ks ? 0.0f : 1.0f, keep_ = (JJ).ks ? 1.0f : 0.0f;     \
          _Pragma("unroll") for (int t = 0; t < 4; ++t) gq[t] = ksp_[F.wave * 256 + t * 64 + lane] * keep_ + one_; } \
        _Pragma("unroll") for (int it = 0; it < 16; ++it) va[it] = __builtin_amdgcn_raw_buffer_load_b128(rs_, voff_, sbase_ + it * sstep_, 0); \
        _Pragma("unroll") for (int it = 0; it < 16; ++it) vb[it] = __builtin_amdgcn_raw_buffer_load_b128(rs_, voff_, sbase_ + (16 + it) * sstep_, 0); } while (0)
    W8_ISSUE(J, true);
    for (;;) {
        f32x4 cm = (f32x4){0.f, 0.f, 0.f, 0.f};
#pragma unroll
        for (int ch = 0; ch < 2; ++ch)
#pragma unroll
            for (int it = 0; it < 16; ++it) { const int j = ch * 16 + it, kk = F.wave * 256 + j * 8 + r8;
                const float g = __shfl(gq[j >> 3], (j & 7) * 8 + r8);
                const f32x4 w = __builtin_bit_cast(f32x4, ch ? vb[it] : va[it]) * g;
                cm[0] = fmaxf(cm[0], fabsf(w[0])); cm[1] = fmaxf(cm[1], fabsf(w[1])); cm[2] = fmaxf(cm[2], fabsf(w[2])); cm[3] = fmaxf(cm[3], fabsf(w[3]));
                const unsigned p01 = cvt_pk_bf16(w[0], w[1]), p23 = cvt_pk_bf16(w[2], w[3]);
                LAS unsigned short* p = (LAS unsigned short*)(T + (4 * cq) * PITCH + kk * 2);
                p[0] = (unsigned short)p01; p[PITCH / 2] = (unsigned short)(p01 >> 16); p[PITCH] = (unsigned short)p23; p[3 * PITCH / 2] = (unsigned short)(p23 >> 16); }
        if (DYN) { if (F.tid == 0) slot[0] = __hip_atomic_fetch_add(q, 1u, __ATOMIC_RELAXED, __HIP_MEMORY_SCOPE_AGENT); }
#pragma unroll
        for (int j = 0; j < 4; ++j) { cm[j] = fmaxf(cm[j], __shfl_xor(cm[j], 8)); cm[j] = fmaxf(cm[j], __shfl_xor(cm[j], 16)); cm[j] = fmaxf(cm[j], __shfl_xor(cm[j], 32)); }
        if (lane < 8) { LAS float* p = smax + F.wave * 32 + lane * 4; p[0] = cm[0]; p[1] = cm[1]; p[2] = cm[2]; p[3] = cm[3]; }
        LDS_WAIT(); __syncthreads();
        const int nx = DYN ? (int)slot[0] : st + step;
        const bool has = nx < end;
        const StripJob Jn = strip_make(PA, F.ws, l, base + (has ? nx : st));
        W8_ISSUE(Jn, has);
        if (F.tid < 32) { float m = 1e-30f;
#pragma unroll
            for (int w = 0; w < 8; ++w) m = fmaxf(m, smax[w * 32 + F.tid]);
            cfin[F.tid] = m; J.sw[F.tid] = m * (1.0f / 127.0f); }
        LDS_WAIT(); __syncthreads();
#pragma unroll
        for (int rr = 0; rr < 4; ++rr) { const int c = F.wave * 4 + rr; const float qs = 127.0f / cfin[c];
#pragma unroll
            for (int i = 0; i < 4; ++i) { const int k0 = (i * 64 + lane) * 8;
                const u32x2 a = *(const LAS u32x2*)(T + c * PITCH + k0 * 2), b = *(const LAS u32x2*)(T + c * PITCH + k0 * 2 + 8);
                u32x2 o; o.x = (unsigned)pack_i8x4(bf4(a) * qs); o.y = (unsigned)pack_i8x4(bf4(b) * qs);
                *(u32x2*)(J.dst + (size_t)c * D + k0) = o; } }
        LDS_WAIT(); __syncthreads();
        if (!has) break;
        J = Jn; st = nx;
    }
#undef W8_ISSUE
}
__device__ __forceinline__ void p0_row(const int lane, const int row, const f32x4 (&v)[8], bf16_t* X, bf16_t* XB, float* SA) {
    float s = 0.f;
#pragma unroll
    for (int j = 0; j < 8; ++j) s += (v[j][0] * v[j][0] + v[j][1] * v[j][1]) + (v[j][2] * v[j][2] + v[j][3] * v[j][3]);
    const float inv = 1.0f / sqrtf(wave_sum(s) * (1.0f / D) + EPS);
    if (I8A1 & 1) {
        float mx = 0.f;
#pragma unroll
        for (int j = 0; j < 8; ++j) mx = fmaxf(mx, fmaxf(fmaxf(fabsf(v[j][0]), fabsf(v[j][1])), fmaxf(fabsf(v[j][2]), fabsf(v[j][3]))));
        mx = fmaxf(wave_max(mx) * inv, 1e-20f); const float q = inv * 127.0f / mx;
#pragma unroll
        for (int j = 0; j < 8; ++j) { { u32x2 w; w.x = cvt_pk_bf16(v[j][0], v[j][1]); w.y = cvt_pk_bf16(v[j][2], v[j][3]); ((u32x2*)(X + (size_t)row * D) + lane)[64 * j] = w; }
            ((int*)((unsigned char*)XB + (size_t)row * D) + lane)[64 * j] = pack_i8x4(v[j] * q); }
        if (lane == 0) SA[row] = mx * (1.0f / 127.0f);
    } else {
#pragma unroll
        for (int j = 0; j < 8; ++j) { { u32x2 w; w.x = cvt_pk_bf16(v[j][0], v[j][1]); w.y = cvt_pk_bf16(v[j][2], v[j][3]); ((u32x2*)(X + (size_t)row * D) + lane)[64 * j] = w; }
            u32x2 w; w.x = cvt_pk_bf16(v[j][0] * inv, v[j][1] * inv); w.y = cvt_pk_bf16(v[j][2] * inv, v[j][3] * inv); ((u32x2*)(XB + (size_t)row * D) + lane)[64 * j] = w; }
    }
}
__device__ __forceinline__ void p0_prologue(Frame& F_, const Params& PA) {
    Frame F = F_; { int t_ = mk_tid(F_.wv); asm volatile("" : "+v"(t_)); F.tid = t_; F.lane = t_ & 63; F.wave = __builtin_amdgcn_readfirstlane(t_ >> 6); }
    unsigned char* ws = F.ws;
    const int gw = F.bid * 8 + F.wave, NGW = F.G * 8;
    {
        const int n1 = (I8A1 & 1) ? 384 : 0, n4 = (I8A4 & 1) ? 352 : 0;
        if (n1 + n4 > 0) strip_loop<false>(F_, PA, 0, F.bid, n1 + n4, F.G, (I8A1 & 1) ? 0 : 384, 0);
    }
    conv_queue(F_, PA, 0);
    bf16_t* X = (bf16_t*)(ws + WS_X); bf16_t* XB = (bf16_t*)(ws + WS_XB);
#define P0_LOAD(V, row_) do { const f32x4* xr_ = (const f32x4*)(PA.in[0] + (size_t)(row_) * D) + F.lane; _Pragma("unroll") for (int j = 0; j < 8; ++j) V[j] = xr_[64 * j]; } while (0)
    {
        int row = gw; f32x4 va[8], vb[8];
        if (row < NT) { P0_LOAD(va, row);
            for (;;) {
                int nrow = row + NGW; bool has = nrow < NT;
                if (has) P0_LOAD(vb, nrow);
                p0_row(F.lane, row, va, X, XB, (float*)(ws + WS_SA));
                if (!has) break;
                row = nrow; nrow = row + NGW; has = nrow < NT;
                if (has) P0_LOAD(va, nrow);
                p0_row(F.lane, row, vb, X, XB, (float*)(ws + WS_SA));
                if (!has) break;
                row = nrow;
            } }
    }
#undef P0_LOAD
    float* COS = (float*)(ws + WS_COS); float* SIN = (float*)(ws + WS_SIN);
    for (int i = F.bid * 512 + F.tid; i < SEQ * 128; i += F.G * 512) { const int pos = i >> 7, p = i & 127;
        const float t = (float)p / 127.0f; const float fr = 1.0f / powf(10000.0f, t); const float ang = (float)pos * fr;
        COS[i] = (float)cos((double)ang); SIN[i] = (float)sin((double)ang); }
    if (F.bid == 0) { float* DQ = (float*)(ws + WS_DQ); float* DKS = (float*)(ws + WS_DKS);
        for (int i = F.tid; i < NH * 128; i += 512) { const int h = i >> 7, j = i & 127; const double lg = log1p(-exp2(-5.0 - (double)h));
            DQ[i] = (float)exp((double)j * lg); DKS[i] = (float)(exp(-(double)j * lg) * 0.0625);
            ((float*)(ws + WS_DQ8))[i] = (float)exp((double)(j - 64) * lg); ((float*)(ws + WS_DKS8))[i] = (float)(exp((double)(64 - j) * lg) * 0.0625); if (j == 0) ((float*)(ws + WS_LG2))[h] = (float)(lg * 1.4426950408889634); } }
}

__device__ __forceinline__ void retention_phase(Frame& F, const bf16_t* QB, const bf16_t* KB, const bf16_t* VT, const bf16_t* GB, const float* normg, bf16_t* OG, const int og8) {
    using namespace pg8;
    LAS unsigned char* lds = F.lds;
    int tid = mk_tid(F.wv); asm volatile("" : "+v"(tid));
    const int wid = __builtin_amdgcn_readfirstlane(tid >> 6), lane = tid & 63, wr = wid >> 2, wc = wid & 3;
    unsigned voffQ[2], voffV[2];
#pragma unroll
    for (int i = 0; i < 2; ++i) { int R, C; stage_rc(tid * 16 + i * 8192, R, C); const int Rb = (R & ~31) + perm32(R & 31);
        voffQ[i] = (unsigned)(R * QKW + C) * 2u; voffV[i] = (unsigned)(Rb * NT + C) * 2u; }
    const unsigned ldsw = (unsigned)wid * 1024u;
    const int aoff = lds_byte(wr * 64 + (lane & 15), (lane >> 4) * 8), boff = lds_byte(wc * 32 + (lane & 15), (lane >> 4) * 8);
    constexpr int PIMG = 6 * HTB;
    LAS float* red = (LAS float*)(lds + MISC_OFF + 256);
    const __amdgpu_buffer_rsrc_t rsQ = __builtin_amdgcn_make_buffer_rsrc((void*)QB, 0, NT * QKW * 2, 0x00020000);
    const __amdgpu_buffer_rsrc_t rsK = __builtin_amdgcn_make_buffer_rsrc((void*)KB, 0, NT * QKW * 2, 0x00020000);
    const __amdgpu_buffer_rsrc_t rsV = __builtin_amdgcn_make_buffer_rsrc((void*)VT, 0, VW * NT * 2, 0x00020000);
#define RT_STAGE(bufoff, rsrc, soff, voff) do { _Pragma("unroll") for (int _i = 0; _i < 2; ++_i) \
        __builtin_amdgcn_raw_ptr_buffer_load_lds((rsrc), (LAS unsigned*)(lds + (bufoff) + ldsw + _i * 8192), 16, (voff)[_i], (soff), 0, 0); } while (0)
#define RT_BAR __builtin_amdgcn_s_barrier()
    for (int it = F.bid; it < 256; it += F.G) {
        const int item = (it & 7) * 32 + (it >> 3);
        const int b = item >> 6, h = (item >> 3) & 7, x = item & 7;
        const float lg2 = ((const float*)(F.ws + WS_LG2))[h];
        const int koff = (b * SEQ * QKW + h * DK) * 2, voff0 = (h * DV * NT + b * SEQ) * 2;
        for (int qs = 0; qs < 2; ++qs) {
            const int qc = qs == 0 ? 15 - x : x, nkv = qc + 1, total = 8 * nkv;
            const int qoff = ((b * SEQ + qc * 128) * QKW + h * DK) * 2;
            f32x4 O[4][4][2], P[4][2];
#pragma unroll
            for (int c = 0; c < 4; ++c)
#pragma unroll
                for (int m = 0; m < 4; ++m)
#pragma unroll
                    for (int n = 0; n < 2; ++n) O[c][m][n] = (f32x4){0.f, 0.f, 0.f, 0.f};
#define RT_STAGE_STEP(sv) do { const int _s = (sv); const int _kt = _s >> 3, _sub = _s & 7, _bo = (_s % 3) * 2 * HTB; \
                if (_sub < 4) { RT_STAGE(_bo, rsQ, qoff + _sub * 128, voffQ); RT_STAGE(_bo + HTB, rsK, koff + _kt * (128 * QKW * 2) + _sub * 128, voffQ); } \
                else { const int _vo = voff0 + (_sub - 4) * (128 * NT * 2) + _kt * 256; RT_STAGE(_bo, rsV, _vo, voffV); RT_STAGE(_bo + HTB, rsV, _vo + 128, voffV); } } while (0)
            RT_STAGE_STEP(0); RT_STAGE_STEP(1);
            asm volatile("s_waitcnt vmcnt(4)" ::: "memory"); RT_BAR;
            int s = 0;
            for (int kt = 0; kt < nkv; ++kt) {
                const float tscale = __builtin_amdgcn_exp2f((float)(128 * (qc - kt)) * lg2);
                const bool diag = (kt == qc);
#pragma unroll
                for (int sub = 0; sub < 8; ++sub, ++s) {
                    __builtin_amdgcn_sched_barrier(0);
                    if (s + 2 < total) RT_STAGE_STEP(s + 2);
                    const int bo = (s % 3) * 2 * HTB;
                    if (sub < 4) {
                        if (sub == 0) {
#pragma unroll
                            for (int m = 0; m < 4; ++m)
#pragma unroll
                                for (int n = 0; n < 2; ++n) P[m][n] = (f32x4){0.f, 0.f, 0.f, 0.f};
                        }
                        bf16x8 Bt[2][2];
#pragma unroll
                        for (int n = 0; n < 2; ++n)
#pragma unroll
                            for (int k = 0; k < 2; ++k) Bt[n][k] = *(const LAS bf16x8*)(lds + bo + HTB + boff + n * 2048 + k * 1024);
#pragma unroll
                        for (int mh = 0; mh < 2; ++mh) {
                            bf16x8 At[2][2];
#pragma unroll
                            for (int m = 0; m < 2; ++m)
#pragma unroll
                                for (int k = 0; k < 2; ++k) At[m][k] = *(const LAS bf16x8*)(lds + bo + aoff + (mh * 2 + m) * 2048 + k * 1024);
#pragma unroll
                            for (int m = 0; m < 2; ++m)
#pragma unroll
                                for (int n = 0; n < 2; ++n)
#pragma unroll
                                    for (int k = 0; k < 2; ++k) P[mh * 2 + m][n] = __builtin_amdgcn_mfma_f32_16x16x32_bf16(Bt[n][k], At[m][k], P[mh * 2 + m][n], 0, 0, 0);
                            __builtin_amdgcn_sched_barrier(0);
                        }
                        if (sub == 3) {
                            int ln = lane; asm volatile("" : "+v"(ln)); const int fr = ln & 15, fq = ln >> 4;
#pragma unroll
                            for (int m = 0; m < 4; ++m) { const int i = wr * 64 + m * 16 + fr;
#pragma unroll
                                for (int n = 0; n < 2; ++n) { const int j0 = wc * 32 + n * 16 + fq * 4; f32x4 v = P[m][n] * tscale;
                                    if (diag) { int dd = i - j0; asm volatile("" : "+v"(dd));
#pragma unroll
                                        for (int e = 0; e < 4; ++e) v[e] = (e > dd) ? 0.f : v[e]; }
                                    u32x2 w; w.x = cvt_pk_bf16(v[0], v[1]); w.y = cvt_pk_bf16(v[2], v[3]);
                                    *(LAS u32x2*)(lds + PIMG + (wc >> 1) * HTB + lds_byte(i, (wc & 1) * 32 + n * 16 + fq * 4)) = w; } }
                        }
                    } else {
#pragma unroll
                        for (int k2 = 0; k2 < 2; ++k2) {
                            bf16x8 Bt[2][2];
#pragma unroll
                            for (int n = 0; n < 2; ++n)
#pragma unroll
                                for (int k = 0; k < 2; ++k) Bt[n][k] = *(const LAS bf16x8*)(lds + bo + k2 * HTB + boff + n * 2048 + k * 1024);
#pragma unroll
                            for (int mh = 0; mh < 2; ++mh) {
                                bf16x8 At[2][2];
#pragma unroll
                                for (int m = 0; m < 2; ++m)
#pragma unroll
                                    for (int k = 0; k < 2; ++k) At[m][k] = *(const LAS bf16x8*)(lds + PIMG + k2 * HTB + aoff + (mh * 2 + m) * 2048 + k * 1024);
#pragma unroll
                                for (int m = 0; m < 2; ++m)
#pragma unroll
                                    for (int n = 0; n < 2; ++n)
#pragma unroll
                                        for (int k = 0; k < 2; ++k) O[sub - 4][mh * 2 + m][n] = __builtin_amdgcn_mfma_f32_16x16x32_bf16(Bt[n][k], At[m][k], O[sub - 4][mh * 2 + m][n], 0, 0, 0);
                                __builtin_amdgcn_sched_barrier(0);
                            }
                        }
                    }
                    if (s + 2 < total) asm volatile("s_waitcnt vmcnt(4) lgkmcnt(0)" ::: "memory"); else asm volatile("s_waitcnt vmcnt(0) lgkmcnt(0)" ::: "memory");
                    RT_BAR;
                }
            }
            int ln = lane; asm volatile("" : "+v"(ln)); const int fr = ln & 15, fq = ln >> 4;
#pragma unroll
            for (int m = 0; m < 4; ++m) { float ss = 0.f;
#pragma unroll
                for (int c = 0; c < 4; ++c)
#pragma unroll
                    for (int n = 0; n < 2; ++n) { const f32x4 o = O[c][m][n]; ss += (o[0] * o[0] + o[1] * o[1]) + (o[2] * o[2] + o[3] * o[3]); }
                ss += __shfl_xor(ss, 16); ss += __shfl_xor(ss, 32);
                if (fq == 0) red[(wr * 64 + m * 16 + fr) * 4 + wc] = ss; }
            LDS_WAIT(); RT_BAR;
#pragma unroll
            for (int m = 0; m < 4; ++m) { const int i = wr * 64 + m * 16 + fr; const f32x4 pr = *(const LAS f32x4*)(red + i * 4);
                const float inv = __builtin_amdgcn_rsqf(((pr[0] + pr[1]) + (pr[2] + pr[3])) * (1.0f / DV) + EPS);
                const size_t tok = (size_t)b * SEQ + (size_t)qc * 128 + i;
#pragma unroll
                for (int c = 0; c < 4; ++c) { const int col = h * DV + c * 128 + wc * 32 + fq * 8;
                    const u32x4 gw = *(const u32x4*)(GB + tok * VW + col); const f32x4 n0 = *(const f32x4*)(normg + col), n1 = *(const f32x4*)(normg + col + 4);
                    const f32x4 o0 = O[c][m][0] * inv * n0, o1 = O[c][m][1] * inv * n1;
                    float gv[8] = {bf_lo(gw.x), bf_hi(gw.x), bf_lo(gw.y), bf_hi(gw.y), bf_lo(gw.z), bf_hi(gw.z), bf_lo(gw.w), bf_hi(gw.w)};
                    float r[8];
#pragma unroll
                    for (int e = 0; e < 4; ++e) { r[e] = o0[e] * gv[e] * fast_sigmoid(gv[e]); r[4 + e] = o1[e] * gv[4 + e] * fast_sigmoid(gv[4 + e]); }
                    if (og8) { int w0 = 0, w1 = 0; w0 = __builtin_amdgcn_cvt_pk_fp8_f32(r[0], r[1], w0, false); w0 = __builtin_amdgcn_cvt_pk_fp8_f32(r[2], r[3], w0, true);
                        w1 = __builtin_amdgcn_cvt_pk_fp8_f32(r[4], r[5], w1, false); w1 = __builtin_amdgcn_cvt_pk_fp8_f32(r[6], r[7], w1, true); u32x2 w; w.x = (unsigned)w0; w.y = (unsigned)w1;
                        *(u32x2*)((unsigned char*)OG + tok * VW + col) = w; }
                    else { u32x4 w; w.x = cvt_pk_bf16(r[0], r[1]); w.y = cvt_pk_bf16(r[2], r[3]); w.z = cvt_pk_bf16(r[4], r[5]); w.w = cvt_pk_bf16(r[6], r[7]);
                        *(u32x4*)(OG + tok * VW + col) = w; } } }
            VM_WAIT(); RT_BAR;
        }
    }
#undef RT_STAGE
#undef RT_STAGE_STEP
#undef RT_BAR
}

__device__ __forceinline__ void mfma8(f32x4& c, const i32x8& a, const i32x8& b, int sc) { asm volatile("v_mfma_scale_f32_16x16x128_f8f6f4 %0, %1, %2, %0, %3, %3 op_sel_hi:[0,0,0]" : "+v"(c) : "v"(a), "v"(b), "v"(sc)); }
__device__ __forceinline__ void retention8_phase(Frame& F, const unsigned char* Q8, const unsigned char* K8, const unsigned char* VT8, const bf16_t* GB, const float* normg, bf16_t* OG, const int og8) {
    using namespace pg8;
    LAS unsigned char* lds = F.lds;
    int tid = mk_tid(F.wv); asm volatile("" : "+v"(tid));
    const int wid = __builtin_amdgcn_readfirstlane(tid >> 6), lane = tid & 63, wr = wid >> 2, wc = wid & 3;
    unsigned voffQ[2], voffV[2];
#pragma unroll
    for (int i = 0; i < 2; ++i) { int R, C; stage_rc(tid * 16 + i * 8192, R, C); const int Rb = (R & ~31) + perm32(R & 31);
        voffQ[i] = (unsigned)(R * QKW + C * 2); voffV[i] = (unsigned)(Rb * NT + C * 2); }
    const unsigned ldsw = (unsigned)wid * 1024u;
    const int aoff = lds_byte(wr * 64 + (lane & 15), (lane >> 4) * 8), boff = lds_byte(wc * 32 + (lane & 15), (lane >> 4) * 8);
    constexpr int PIMG = 6 * HTB;
    LAS float* red = (LAS float*)(lds + MISC_OFF + 256);
    int f8scale = 0x7f7f7f7f; asm volatile("" : "+v"(f8scale));
    const __amdgpu_buffer_rsrc_t rsQ = __builtin_amdgcn_make_buffer_rsrc((void*)Q8, 0, NT * QKW, 0x00020000);
    const __amdgpu_buffer_rsrc_t rsK = __builtin_amdgcn_make_buffer_rsrc((void*)K8, 0, NT * QKW, 0x00020000);
    const __amdgpu_buffer_rsrc_t rsV = __builtin_amdgcn_make_buffer_rsrc((void*)VT8, 0, VW * NT, 0x00020000);
#define RT_STAGE(bufoff, rsrc, soff, voff) do { _Pragma("unroll") for (int _i = 0; _i < 2; ++_i) \
        __builtin_amdgcn_raw_ptr_buffer_load_lds((rsrc), (LAS unsigned*)(lds + (bufoff) + ldsw + _i * 8192), 16, (voff)[_i], (soff), 0, 0); } while (0)
#define RT_BAR __builtin_amdgcn_s_barrier()
#define RT_LD16(off) (*(const LAS i32x4*)(lds + (off)))
    for (int it = F.bid; it < 256; it += F.G) {
        const int item = (it & 7) * 32 + (it >> 3);
        const int b = item >> 6, h = (item >> 3) & 7, x = item & 7;
        const float lg2 = ((const float*)(F.ws + WS_LG2))[h];
        const int koff = b * SEQ * QKW + h * DK, voff0 = h * DV * NT + b * SEQ;
        for (int qs = 0; qs < 2; ++qs) {
            const int qc = qs == 0 ? 15 - x : x, nkv = qc + 1, total = 4 * nkv;
            const int qoff = (b * SEQ + qc * 128) * QKW + h * DK;
            f32x4 O[4][4][2], P[4][2]; i32x8 Apf[4];
#pragma unroll
            for (int c = 0; c < 4; ++c)
#pragma unroll
                for (int m = 0; m < 4; ++m)
#pragma unroll
                    for (int n = 0; n < 2; ++n) O[c][m][n] = (f32x4){0.f, 0.f, 0.f, 0.f};
#define RT_STAGE_STEP(sv) do { const int _s = (sv); const int _kt = _s >> 2, _sub = _s & 3, _bo = (_s % 3) * 2 * HTB; \
                if (_sub < 2) { RT_STAGE(_bo, rsQ, qoff + _sub * 128, voffQ); RT_STAGE(_bo + HTB, rsK, koff + _kt * (128 * QKW) + _sub * 128, voffQ); } \
                else { const int _vo = voff0 + (_sub - 2) * (256 * NT) + _kt * 128; RT_STAGE(_bo, rsV, _vo, voffV); RT_STAGE(_bo + HTB, rsV, _vo + 128 * NT, voffV); } } while (0)
            RT_STAGE_STEP(0); RT_STAGE_STEP(1);
            asm volatile("s_waitcnt vmcnt(4)" ::: "memory"); RT_BAR;
            int s = 0;
            for (int kt = 0; kt < nkv; ++kt) {
                const float tscale = __builtin_amdgcn_exp2f((float)(128 * (qc - kt)) * lg2);
                const bool diag = (kt == qc);
#pragma unroll
                for (int sub = 0; sub < 4; ++sub, ++s) {
                    __builtin_amdgcn_sched_barrier(0);
                    if (s + 2 < total) RT_STAGE_STEP(s + 2);
                    const int bo = (s % 3) * 2 * HTB;
                    if (sub < 2) {
                        if (sub == 0) {
#pragma unroll
                            for (int m = 0; m < 4; ++m)
#pragma unroll
                                for (int n = 0; n < 2; ++n) P[m][n] = (f32x4){0.f, 0.f, 0.f, 0.f};
                        }
                        i32x8 Bt[2], At[4];
#pragma unroll
                        for (int n = 0; n < 2; ++n) { Bt[n].lo = RT_LD16(bo + HTB + boff + n * 2048); Bt[n].hi = RT_LD16(bo + HTB + boff + n * 2048 + 1024); }
#pragma unroll
                        for (int m = 0; m < 4; ++m) { At[m].lo = RT_LD16(bo + aoff + m * 2048); At[m].hi = RT_LD16(bo + aoff + m * 2048 + 1024); }
#pragma unroll
                        for (int m = 0; m < 4; ++m)
#pragma unroll
                            for (int n = 0; n < 2; ++n) mfma8(P[m][n], Bt[n], At[m], f8scale);
                        __builtin_amdgcn_sched_barrier(0);
                        if (sub == 1) {
                            asm volatile("s_nop 15\n\ts_nop 7" ::: "memory"); __builtin_amdgcn_sched_barrier(0);
                            int ln = lane; asm volatile("" : "+v"(ln)); const int fr = ln & 15, fq = ln >> 4;
#pragma unroll
                            for (int m = 0; m < 4; ++m) { const int i = wr * 64 + m * 16 + fr;
#pragma unroll
                                for (int n = 0; n < 2; ++n) { const int j0 = wc * 32 + n * 16 + fq * 4; f32x4 v = P[m][n] * tscale;
                                    if (diag) { int dd = i - j0; asm volatile("" : "+v"(dd));
#pragma unroll
                                        for (int e = 0; e < 4; ++e) v[e] = (e > dd) ? 0.f : v[e]; }
                                    int w = 0; w = __builtin_amdgcn_cvt_pk_fp8_f32(v[0], v[1], w, false); w = __builtin_amdgcn_cvt_pk_fp8_f32(v[2], v[3], w, true);
                                    *(LAS int*)(lds + PIMG + lds_byte(i, j0 >> 1)) = w; } }
                        }
                    } else {
                        if (sub == 2) {
#pragma unroll
                            for (int m = 0; m < 4; ++m) { Apf[m].lo = RT_LD16(PIMG + aoff + m * 2048); Apf[m].hi = RT_LD16(PIMG + aoff + m * 2048 + 1024); }
                        }
#pragma unroll
                        for (int ch = 0; ch < 2; ++ch) {
                            i32x8 Bv[2];
#pragma unroll
                            for (int n = 0; n < 2; ++n) { Bv[n].lo = RT_LD16(bo + ch * HTB + boff + n * 2048); Bv[n].hi = RT_LD16(bo + ch * HTB + boff + n * 2048 + 1024); }
#pragma unroll
                            for (int m = 0; m < 4; ++m)
#pragma unroll
                                for (int n = 0; n < 2; ++n) mfma8(O[(sub - 2) * 2 + ch][m][n], Bv[n], Apf[m], f8scale);
                            __builtin_amdgcn_sched_barrier(0);
                        }
                    }
                    if (s + 2 < total) asm volatile("s_waitcnt vmcnt(4) lgkmcnt(0)" ::: "memory"); else asm volatile("s_waitcnt vmcnt(0) lgkmcnt(0)" ::: "memory");
                    RT_BAR;
                }
            }
            asm volatile("s_nop 15\n\ts_nop 7" ::: "memory"); __builtin_amdgcn_sched_barrier(0);
            int ln = lane; asm volatile("" : "+v"(ln)); const int fr = ln & 15, fq = ln >> 4;
#pragma unroll
            for (int m = 0; m < 4; ++m) { float ss = 0.f;
#pragma unroll
                for (int c = 0; c < 4; ++c)
#pragma unroll
                    for (int n = 0; n < 2; ++n) { const f32x4 o = O[c][m][n]; ss += (o[0] * o[0] + o[1] * o[1]) + (o[2] * o[2] + o[3] * o[3]); }
                ss += __shfl_xor(ss, 16); ss += __shfl_xor(ss, 32);
                if (fq == 0) red[(wr * 64 + m * 16 + fr) * 4 + wc] = ss; }
            LDS_WAIT(); RT_BAR;
#pragma unroll
            for (int m = 0; m < 4; ++m) { const int i = wr * 64 + m * 16 + fr; const f32x4 pr = *(const LAS f32x4*)(red + i * 4);
                const float inv = __builtin_amdgcn_rsqf(((pr[0] + pr[1]) + (pr[2] + pr[3])) * (1.0f / DV) + EPS);
                const size_t tok = (size_t)b * SEQ + (size_t)qc * 128 + i;
#pragma unroll
                for (int c = 0; c < 4; ++c) { const int col = h * DV + c * 128 + wc * 32 + fq * 8;
                    const u32x4 gw = *(const u32x4*)(GB + tok * VW + col); const f32x4 n0 = *(const f32x4*)(normg + col), n1 = *(const f32x4*)(normg + col + 4);
                    const f32x4 o0 = O[c][m][0] * inv * n0, o1 = O[c][m][1] * inv * n1;
                    float gv[8] = {bf_lo(gw.x), bf_hi(gw.x), bf_lo(gw.y), bf_hi(gw.y), bf_lo(gw.z), bf_hi(gw.z), bf_lo(gw.w), bf_hi(gw.w)};
                    float r[8];
#pragma unroll
                    for (int e = 0; e < 4; ++e) { r[e] = o0[e] * gv[e] * fast_sigmoid(gv[e]); r[4 + e] = o1[e] * gv[4 + e] * fast_sigmoid(gv[4 + e]); }
                    if (og8) { int w0 = 0, w1 = 0; w0 = __builtin_amdgcn_cvt_pk_fp8_f32(r[0], r[1], w0, false); w0 = __builtin_amdgcn_cvt_pk_fp8_f32(r[2], r[3], w0, true);
                        w1 = __builtin_amdgcn_cvt_pk_fp8_f32(r[4], r[5], w1, false); w1 = __builtin_amdgcn_cvt_pk_fp8_f32(r[6], r[7], w1, true); u32x2 w; w.x = (unsigned)w0; w.y = (unsigned)w1;
                        *(u32x2*)((unsigned char*)OG + tok * VW + col) = w; }
                    else { u32x4 w; w.x = cvt_pk_bf16(r[0], r[1]); w.y = cvt_pk_bf16(r[2], r[3]); w.z = cvt_pk_bf16(r[4], r[5]); w.w = cvt_pk_bf16(r[6], r[7]);
                        *(u32x4*)(OG + tok * VW + col) = w; } } }
            VM_WAIT(); RT_BAR;
        }
    }
#undef RT_STAGE
#undef RT_STAGE_STEP
#undef RT_BAR
#undef RT_LD16
}

template <int W>
__device__ __forceinline__ void pool_rows(const bf16_t* X, const LAS float* rs, bf16_t* MIX, int r0, int s0, int q, int col) {
    f32x4 v[23];
#pragma unroll
    for (int t = 0; t < 23; ++t) { if (t >= 16 - W) { int row = r0 - 15 + 8 * q + t; row = row < 0 ? 0 : row; v[t] = bf4(*(const u32x2*)(X + (size_t)row * D + col)) * rs[8 * q + t]; } }
#pragma unroll
    for (int o = 0; o < 8; ++o) { const int t = 15 + o, s = s0 + 8 * q + o; f32x4 sum = v[t];
#pragma unroll
        for (int d = 1; d < W; ++d) sum = sum + v[t - d];
        const int cnt = (s + 1) < W ? (s + 1) : W; const float ic = 1.0f / (float)cnt;
        const f32x4 mx = sum * ic - v[t];
        u32x2 w; w.x = cvt_pk_bf16(mx[0], mx[1]); w.y = cvt_pk_bf16(mx[2], mx[3]);
        *(u32x2*)(MIX + (size_t)(r0 + 8 * q + o) * D + col) = w; }
}
__device__ __forceinline__ void pool_phase(Frame& F_, const bf16_t* X, const float* ROWSS, bf16_t* MIX) {
    Frame F = F_; { int t_ = mk_tid(F_.wv); asm volatile("" : "+v"(t_)); F.tid = t_; F.lane = t_ & 63; F.wave = __builtin_amdgcn_readfirstlane(t_ >> 6); }
    LAS float* rs = (LAS float*)(F.lds);
    for (int u = F.bid; u < 1024; u += F.G) {
        const int rt = u >> 2, g = u & 3, r0 = rt * 32, s0 = r0 & (SEQ - 1);
        for (int li = F.wave; li < 47; li += 8) { const int s = s0 - 15 + li; int row = r0 - 15 + li; row = row < 0 ? 0 : row;
            float p = (F.lane < 32) ? ROWSS[(size_t)row * 32 + F.lane] : 0.f; p = wave_sum(p);
            if (F.lane == 0) rs[li] = (s >= 0) ? (1.0f / sqrtf(p * (1.0f / D) + EPS)) : 0.f; }
        LDS_WAIT(); __syncthreads();
        const int q = F.tid >> 7, col = g * 512 + (F.tid & 127) * 4;
        if (g == 0) pool_rows<2>(X, rs, MIX, r0, s0, q, col); else if (g == 1) pool_rows<4>(X, rs, MIX, r0, s0, q, col); else if (g == 2) pool_rows<8>(X, rs, MIX, r0, s0, q, col); else pool_rows<16>(X, rs, MIX, r0, s0, q, col);
        __syncthreads();
    }
}

template <int W>
__device__ __forceinline__ void pool_pair(const bf16_t* Z, const LAS float* invt, int li0  , int ra, int sa, int col, f32x4& pa, f32x4& pb) {
    f32x4 S = (f32x4){0.f, 0.f, 0.f, 0.f}, first = S, za = S, zb = S;
#pragma unroll
    for (int k = 0; k <= W; ++k) { int row = ra - W + 1 + k; row = row < 0 ? 0 : row;
        const f32x4 z = bf4(*(const u32x2*)(Z + (size_t)row * D + col)) * invt[li0 - W + 1 + k];
        if (k == 0) first = z; if (k < W) S = S + z; if (k == W - 1) za = z; if (k == W) zb = z; }
    const int ca = (sa + 1) < W ? (sa + 1) : W, cb = (sa + 2) < W ? (sa + 2) : W;
    pa = S * (1.0f / (float)ca) - za; pb = (S - first + zb) * (1.0f / (float)cb) - zb;
}
template <int fp8>
__device__ __forceinline__ void router_phase(Frame& F_, bf16_t* X, const bf16_t* Z, const float* ROWSS, const float* pscale  , const float* router  , const float* gain  , unsigned* counts  , unsigned char* XG, int* TOK, float* GATE, unsigned char* ACTM8, float* SAM) {
    Frame F = F_; { int t_ = mk_tid(F_.wv); asm volatile("" : "+v"(t_)); F.tid = t_; F.lane = t_ & 63; F.wave = __builtin_amdgcn_readfirstlane(t_ >> 6); }
    LAS float* RTt = (LAS float*)(F.lds);
    LAS float* GN = (LAS float*)(F.lds + 65536);
    LAS float* PS = (LAS float*)(F.lds + 73728);
    LAS float* invt = (LAS float*)(F.lds + 81920);
    LAS int* lcnt = (LAS int*)(F.lds + MISC_OFF + 256);
    for (int i = F.tid; i < D * 8; i += 512) { const int c = i >> 3, e = i & 7; RTt[e * D + c] = router[i] * gain[c]; }
    for (int i = F.tid; i < D; i += 512) { GN[i] = gain[i]; PS[i] = pscale[i]; }
    if (fp8 != 0) { for (int i = F.bid * 512 + F.tid; i < NE * NT * 8; i += F.G * 512) *(u32x4*)(ACTM8 + (size_t)(i >> 3) * FE8 + FE + (i & 7) * 16) = (u32x4){0u, 0u, 0u, 0u}; }
    __syncthreads();
    for (int t = F.bid; t < 256; t += F.G) {
        const int r0 = t * 32, s0 = r0 & (SEQ - 1);
        if (F.tid < 16) lcnt[F.tid] = 0;
        for (int li = F.wave; li < 47; li += 8) { const int sp = s0 - 15 + li; int row = r0 - 15 + li; row = row < 0 ? 0 : row;
            float p = (F.lane < 32) ? ROWSS[(size_t)row * 32 + F.lane] : 0.f; p = wave_sum(p);
            if (F.lane == 0) invt[li] = (sp >= 0) ? (1.0f / sqrtf(p * (1.0f / D) + EPS)) : 0.f; }
        LDS_WAIT(); __syncthreads();
        const int rbase = r0 + F.wave * 4;
        int e0[4], e1[4], p0[4], p1[4]; float g0[4], inr[4], mq[4];
#pragma unroll
        for (int pr = 0; pr < 2; ++pr) {
            const int ra = rbase + 2 * pr, sa = ra & (SEQ - 1), li0 = ra - r0 + 15;
            f32x4 xa[8], xb[8];
#pragma unroll
            for (int j = 0; j < 8; ++j) { int ln = F.lane; asm volatile("" : "+v"(ln));
                const int col = 4 * ln + 256 * j; f32x4 pa, pb;
                if (j < 2) pool_pair<2>(Z, invt, li0, ra, sa, col, pa, pb); else if (j < 4) pool_pair<4>(Z, invt, li0, ra, sa, col, pa, pb); else if (j < 6) pool_pair<8>(Z, invt, li0, ra, sa, col, pa, pb); else pool_pair<16>(Z, invt, li0, ra, sa, col, pa, pb);
                const f32x4 ps = *(const LAS f32x4*)(PS + col);
                xa[j] = bf4(*(const u32x2*)(X + (size_t)ra * D + col)) + ps * pa; xb[j] = bf4(*(const u32x2*)(X + (size_t)(ra + 1) * D + col)) + ps * pb;
                u32x2 wa, wb; wa.x = cvt_pk_bf16(xa[j][0], xa[j][1]); wa.y = cvt_pk_bf16(xa[j][2], xa[j][3]); wb.x = cvt_pk_bf16(xb[j][0], xb[j][1]); wb.y = cvt_pk_bf16(xb[j][2], xb[j][3]);
                *(u32x2*)(X + (size_t)ra * D + col) = wa; *(u32x2*)(X + (size_t)(ra + 1) * D + col) = wb;
                if (j == 3 || j == 7) __builtin_amdgcn_sched_barrier(0); }
            float sqa = 0.f, sqb = 0.f;
            if constexpr (fp8 == 2) { float ma = 0.f, mb = 0.f;
#pragma unroll
                for (int j = 0; j < 8; ++j) { const f32x4 gn = *(const LAS f32x4*)(GN + 4 * F.lane + 256 * j); const f32x4 ta = xa[j] * gn, tb = xb[j] * gn;
                    ma = fmaxf(ma, fmaxf(fmaxf(fabsf(ta[0]), fabsf(ta[1])), fmaxf(fabsf(ta[2]), fabsf(ta[3])))); mb = fmaxf(mb, fmaxf(fmaxf(fabsf(tb[0]), fabsf(tb[1])), fmaxf(fabsf(tb[2]), fabsf(tb[3])))); }
                mq[2 * pr] = fmaxf(wave_max(ma), 1e-20f); mq[2 * pr + 1] = fmaxf(wave_max(mb), 1e-20f); }
#pragma unroll
            for (int j = 0; j < 8; ++j) { sqa += (xa[j][0] * xa[j][0] + xa[j][1] * xa[j][1]) + (xa[j][2] * xa[j][2] + xa[j][3] * xa[j][3]); sqb += (xb[j][0] * xb[j][0] + xb[j][1] * xb[j][1]) + (xb[j][2] * xb[j][2] + xb[j][3] * xb[j][3]); }
            const float inva = 1.0f / sqrtf(wave_sum(sqa) * (1.0f / D) + EPS), invb = 1.0f / sqrtf(wave_sum(sqb) * (1.0f / D) + EPS);
            inr[2 * pr] = inva; inr[2 * pr + 1] = invb;
            float lg[2][8];
#pragma unroll
            for (int e = 0; e < 8; ++e) { float a0 = 0.f, a1 = 0.f;
#pragma unroll
                for (int j = 0; j < 8; ++j) { const f32x4 w = *(const LAS f32x4*)(RTt + e * D + 4 * F.lane + 256 * j);
                    a0 += (xa[j][0] * w[0] + xa[j][1] * w[1]) + (xa[j][2] * w[2] + xa[j][3] * w[3]);
                    a1 += (xb[j][0] * w[0] + xb[j][1] * w[1]) + (xb[j][2] * w[2] + xb[j][3] * w[3]); }
                lg[0][e] = wave_sum(a0) * inva; lg[1][e] = wave_sum(a1) * invb; }
#pragma unroll
            for (int q = 0; q < 2; ++q) { const int rr = 2 * pr + q;
                float v0 = lg[q][0]; int i0 = 0;
#pragma unroll
                for (int e = 1; e < 8; ++e) if (lg[q][e] > v0) { v0 = lg[q][e]; i0 = e; }
                float v1 = -3.0e38f; int i1 = 0;
#pragma unroll
                for (int e = 0; e < 8; ++e) if (e != i0 && lg[q][e] > v1) { v1 = lg[q][e]; i1 = e; }
                e0[rr] = i0; e1[rr] = i1; g0[rr] = 1.0f / (1.0f + expf(v1 - v0));
                int a = 0, bq = 0;
                if (F.lane == 0) { a = atomicAdd((int*)(lcnt + i0), 1); bq = atomicAdd((int*)(lcnt + i1), 1); }
                p0[rr] = __builtin_amdgcn_readfirstlane(a); p1[rr] = __builtin_amdgcn_readfirstlane(bq); }
            __builtin_amdgcn_sched_barrier(0);
        }
        VM_WAIT();
        __syncthreads();
        if (F.tid < 8) lcnt[8 + F.tid] = (int)__hip_atomic_fetch_add(counts + 64 * F.tid, (unsigned)lcnt[F.tid], __ATOMIC_RELAXED, __HIP_MEMORY_SCOPE_AGENT);
        __syncthreads();
#pragma unroll
        for (int rr = 0; rr < 4; ++rr) { const int row = rbase + rr;
            const int q0 = lcnt[8 + e0[rr]] + p0[rr], q1 = lcnt[8 + e1[rr]] + p1[rr];
            const size_t pitch = fp8 ? D : 2 * D;
            float q8 = 0.f; if constexpr (fp8 == 2) q8 = 127.0f / mq[rr];
            unsigned char* d0 = XG + ((size_t)e0[rr] * NT + q0) * pitch; unsigned char* d1 = XG + ((size_t)e1[rr] * NT + q1) * pitch;
            int ln = F.lane; asm volatile("" : "+v"(ln));
#pragma unroll
            for (int j = 0; j < 8; ++j) { const f32x4 gn = *(const LAS f32x4*)(GN + 4 * ln + 256 * j);
                const unsigned long long xw = __hip_atomic_load((const unsigned long long*)(X + (size_t)row * D) + ln + 64 * j, __ATOMIC_RELAXED, __HIP_MEMORY_SCOPE_AGENT);
                u32x2 xx; xx.x = (unsigned)xw; xx.y = (unsigned)(xw >> 32); const f32x4 hv = bf4(xx) * inr[rr] * gn;
                if constexpr (fp8 == 2) { const int w = pack_i8x4(bf4(xx) * gn * q8); ((unsigned*)d0 + ln)[64 * j] = (unsigned)w; ((unsigned*)d1 + ln)[64 * j] = (unsigned)w; }
                else if constexpr (fp8 != 0) { int w = 0; w = __builtin_amdgcn_cvt_pk_fp8_f32(hv[0], hv[1], w, false); w = __builtin_amdgcn_cvt_pk_fp8_f32(hv[2], hv[3], w, true);
                    ((unsigned*)d0 + ln)[64 * j] = (unsigned)w; ((unsigned*)d1 + ln)[64 * j] = (unsigned)w; }
                else { u32x2 w; w.x = cvt_pk_bf16(hv[0], hv[1]); w.y = cvt_pk_bf16(hv[2], hv[3]); ((u32x2*)d0 + ln)[64 * j] = w; ((u32x2*)d1 + ln)[64 * j] = w; } }
            if constexpr (fp8 == 2) { if (F.lane == 0) { const float sc = mq[rr] * inr[rr] * (1.0f / 127.0f); SAM[e0[rr] * NT + q0] = sc; SAM[e1[rr] * NT + q1] = sc; } }
            if (F.lane == 0) { TOK[e0[rr] * NT + q0] = row * 2; GATE[e0[rr] * NT + q0] = g0[rr]; TOK[e1[rr] * NT + q1] = row * 2 + 1; GATE[e1[rr] * NT + q1] = 1.0f - g0[rr]; }
        }
        __syncthreads();
    }
}

__device__ __forceinline__ void cb_row(const int lane, const int row, const u32x2 (&rx)[8], const u32x2 (&ry0)[8], const u32x2 (&ry1)[8], bf16_t* X, bf16_t* XB, const float* gfinal, float* out, const bool last, const int xb8, const float ys, float* SA) {
    f32x4 v[8]; float s = 0.f;
#pragma unroll
    for (int j = 0; j < 8; ++j) { const u32x2 y0 = ry0[j], y1 = ry1[j];
        v[j] = bf4(rx[j]) + ((f32x4){bf_lo(y0.x), bf_hi(y0.x), bf_lo(y0.y), bf_hi(y0.y)} + (f32x4){bf_lo(y1.x), bf_hi(y1.x), bf_lo(y1.y), bf_hi(y1.y)}) * ys;
        s += (v[j][0] * v[j][0] + v[j][1] * v[j][1]) + (v[j][2] * v[j][2] + v[j][3] * v[j][3]); }
    const float inv = 1.0f / sqrtf(wave_sum(s) * (1.0f / D) + EPS);
    if (last) {
#pragma unroll
        for (int j = 0; j < 8; ++j) { const f32x4 g = ((const f32x4*)gfinal)[lane + 64 * j]; ((f32x4*)(out + (size_t)row * D))[lane + 64 * j] = v[j] * inv * g; }
    } else {
        float q8 = 0.f;
        if (xb8 == 2) { float mx = 0.f;
#pragma unroll
            for (int j = 0; j < 8; ++j) mx = fmaxf(mx, fmaxf(fmaxf(fabsf(v[j][0]), fabsf(v[j][1])), fmaxf(fabsf(v[j][2]), fabsf(v[j][3]))));
            mx = fmaxf(wave_max(mx) * inv, 1e-20f); q8 = inv * 127.0f / mx; if (lane == 0) SA[row] = mx * (1.0f / 127.0f); }
#pragma unroll
        for (int j = 0; j < 8; ++j) { { u32x2 w; w.x = cvt_pk_bf16(v[j][0], v[j][1]); w.y = cvt_pk_bf16(v[j][2], v[j][3]); ((u32x2*)(X + (size_t)row * D))[lane + 64 * j] = w; }
            if (xb8 == 2) ((int*)((unsigned char*)XB + (size_t)row * D) + lane)[64 * j] = pack_i8x4(v[j] * q8);
            else if (xb8) { int w = 0; w = __builtin_amdgcn_cvt_pk_fp8_f32(v[j][0] * inv, v[j][1] * inv, w, false); w = __builtin_amdgcn_cvt_pk_fp8_f32(v[j][2] * inv, v[j][3] * inv, w, true); ((unsigned*)((unsigned char*)XB + (size_t)row * D) + lane)[64 * j] = (unsigned)w; }
            else { u32x2 w; w.x = cvt_pk_bf16(v[j][0] * inv, v[j][1] * inv); w.y = cvt_pk_bf16(v[j][2] * inv, v[j][3] * inv); ((u32x2*)(XB + (size_t)row * D) + lane)[64 * j] = w; } }
    }
}
__device__ __forceinline__ void combine_phase(Frame& F_, bf16_t* X, const bf16_t* Y, bf16_t* XB, const float* gfinal, float* out, bool last, const int xb8  , const float ys, float* SA) {
    Frame F = F_; { int t_ = mk_tid(F_.wv); asm volatile("" : "+v"(t_)); F.tid = t_; F.lane = t_ & 63; F.wave = __builtin_amdgcn_readfirstlane(t_ >> 6); }
    const int gw = F.bid * 8 + F.wave, NGW = F.G * 8;
#define CB_LOAD(RX, RY0, RY1, row_) do { _Pragma("unroll") for (int j = 0; j < 8; ++j) { const size_t o = (size_t)(row_) * D / 4 + F.lane + 64 * j; \
        RX[j] = ((const u32x2*)X)[o]; RY0[j] = ((const u32x2*)Y)[o]; RY1[j] = ((const u32x2*)(Y + (size_t)NT * D))[o]; } } while (0)
    int row = gw; if (row >= NT) return;
    u32x2 ax[8], ay0[8], ay1[8], bx[8], by0[8], by1[8];
    CB_LOAD(ax, ay0, ay1, row);
    for (;;) {
        int nrow = row + NGW; bool has = nrow < NT;
        if (has) CB_LOAD(bx, by0, by1, nrow);
        cb_row(F.lane, row, ax, ay0, ay1, X, XB, gfinal, out, last, xb8, ys, SA);
        if (!has) break;
        row = nrow; nrow = row + NGW; has = nrow < NT;
        if (has) CB_LOAD(ax, ay0, ay1, nrow);
        cb_row(F.lane, row, bx, by0, by1, X, XB, gfinal, out, last, xb8, ys, SA);
        if (!has) break;
        row = nrow;
    }
#undef CB_LOAD
}

__device__ __forceinline__ int compute_cus(int T, int G) { if (T <= 0) return G; const int R = (T + G - 1) / G; int g = (T + R - 1) / R; g = (g + 7) & ~7; return g > G ? G : g; }
__device__ __forceinline__ void q4_row(const int lane, const int row, const float pss, const u32x2 (&rx)[8], unsigned char* XQ, float* SA) {
    const float p = wave_sum(pss); const float inv = 1.0f / sqrtf(p * (1.0f / D) + EPS);
    f32x4 v[8]; float mx = 0.f;
#pragma unroll
    for (int j = 0; j < 8; ++j) { v[j] = bf4(rx[j]) * inv; mx = fmaxf(mx, fmaxf(fmaxf(fabsf(v[j][0]), fabsf(v[j][1])), fmaxf(fabsf(v[j][2]), fabsf(v[j][3])))); }
    mx = fmaxf(wave_max(mx), 1e-20f); const float q = 127.0f / mx;
#pragma unroll
    for (int j = 0; j < 8; ++j) ((int*)(XQ + (size_t)row * D) + lane)[64 * j] = pack_i8x4(v[j] * q);
    if (lane == 0) SA[row] = mx * (1.0f / 127.0f);
}
__device__ __forceinline__ void quant_rows_phase(Frame& F_, const bf16_t* X, const float* ROWSS, unsigned char* XQ, float* SA) {
    Frame F = F_; { int t_ = mk_tid(F_.wv); asm volatile("" : "+v"(t_)); F.tid = t_; F.lane = t_ & 63; F.wave = __builtin_amdgcn_readfirstlane(t_ >> 6); }
    const int gw = F.bid * 8 + F.wave, NGW = F.G * 8;
#define Q4_LOAD(P, RX, row_) do { P = (F.lane < 32) ? ROWSS[(size_t)(row_) * 32 + F.lane] : 0.f; _Pragma("unroll") for (int j = 0; j < 8; ++j) RX[j] = ((const u32x2*)(X + (size_t)(row_) * D) + F.lane)[64 * j]; } while (0)
    int row = gw; if (row >= NT) return;
    u32x2 ax[8], bx[8]; float pa, pb = 0.f;
    Q4_LOAD(pa, ax, row);
    for (;;) {
        int nrow = row + NGW; bool has = nrow < NT;
        if (has) Q4_LOAD(pb, bx, nrow);
        q4_row(F.lane, row, pa, ax, XQ, SA);
        if (!has) break;
        row = nrow; nrow = row + NGW; has = nrow < NT;
        if (has) Q4_LOAD(pa, ax, nrow);
        q4_row(F.lane, row, pb, bx, XQ, SA);
        if (!has) break;
        row = nrow;
    }
#undef Q4_LOAD
}
__global__ void __launch_bounds__(512, 2) trunk_fwd(Params args) {
    extern __shared__ __attribute__((aligned(16))) unsigned char lds_raw[];
    Frame F;
    F.lds = (LAS unsigned char*)lds_raw;
    F.tid = 0; F.lane = 0; F.wave = 0; F.G = gridDim.x; F.bid = blockIdx.x; F.wv = __builtin_amdgcn_readfirstlane((int)(threadIdx.x >> 6));
    F.out = args.out; F.ws = args.ws;
    unsigned char* ws = args.ws;
    unsigned* ctl = (unsigned*)(ws + WS_CTL);
    volatile LAS unsigned* MISC = (volatile LAS unsigned*)(F.lds + MISC_OFF);
    if (threadIdx.x < 64) MISC[threadIdx.x] = 0u;
    __syncthreads();
    const int lo = args.ph_lo, hi = args.ph_hi;
    const bool use_bar = (hi - lo) > 1;
    XcdBarrier bar; bar.bar = ctl + CW_BAR; bar.x = 0; bar.st = MISC + 8;
    if (use_bar) bar = xcd_barrier_post(ctl + CW_BAR, MISC + 8);
    bar.wv = F.wv;
#ifndef PHMASK
#define PHMASK 0x1FFF
#endif
#ifndef REPSLOT
#define REPSLOT -1
#endif
#ifndef REPCNT
#define REPCNT 2
#endif
#define NREP(j) (((j) == (REPSLOT)) ? (REPCNT) : 1)
#define EN(j) (((PHMASK) >> (j)) & 1)
#define IN(k) (lo <= (k) && (k) < hi)
#define WS_FRESH do { } while (0)
#define SEAM(k) do { if (IN(k) && IN((k) + 1)) xcd_barrier(bar); } while (0)
    bf16_t* X = (bf16_t*)(ws + WS_X); bf16_t* XB = (bf16_t*)(ws + WS_XB); float* ROWSS = (float*)(ws + WS_ROWSS);
    LAS unsigned char* ring = F.lds;

    if (EN(0) && IN(0)) { _Pragma("unroll 1") for (int rep = 0; rep < NREP(0); ++rep) { p0_prologue(F, args); __syncthreads(); } }
    SEAM(0);

#pragma unroll 1
    for (int l = 0; l < 2; ++l) {
        const int pb = 1 + 11 * l;
        asm volatile("" : "+s"(ws));
        WS_FRESH;
        if (EN(1) && IN(pb + 0)) _Pragma("unroll 1") for (int rep = 0; rep < NREP(1); ++rep) {
            const bool p8 = (PROJ8 >> l) & 1; const int r8 = (RET8 >> l) & 1;
            A1Order S; S.XB = (unsigned)WS_XB; S.WQKG = (unsigned)(WS_WQKG + l * SZ_WQKG); S.WVT = (unsigned)(WS_WVT + l * SZ_WVT); S.G = F.G; S.c = F.bid; S.t = p8 ? 256u * D : 256u * D * 2;
            const bool i8 = (I8A1 >> l) & 1; if (i8) S.t = 256u * D;
            EpiA1 E{(bf16_t*)(ws + WS_QB), (bf16_t*)(ws + WS_KB), (bf16_t*)(ws + WS_GB), (bf16_t*)(ws + WS_VT), (const float*)(ws + WS_COS), (const float*)(ws + WS_SIN), (const float*)(ws + (r8 ? WS_DQ8 : WS_DQ)), (const float*)(ws + (r8 ? WS_DKS8 : WS_DKS)), (p8 && !i8) ? 1.0f / 32.0f : 1.0f, r8,
                    i8 ? (const float*)(ws + WS_SA) : nullptr, (const float*)(ws + WS_SWQ + l * SZ_SWL), (const float*)(ws + WS_SWV + l * SZ_SWL)};
            if (i8) pg8::gemm_phase<EpiA1, A1Order, 2>(ring, ws, D, D, D, S, E, F.wv);
            else if (!p8) pg8::gemm_phase<EpiA1, A1Order>(ring, ws, D, D, D, S, E, F.wv);
            else pg8::gemm_phase<EpiA1, A1Order, true>(ring, ws, D, D, D, S, E, F.wv);
        }
        SEAM(pb + 0);
        WS_FRESH;
        if (EN(2) && IN(pb + 1)) _Pragma("unroll 1") for (int rep = 0; rep < NREP(2); ++rep) { if (!((RET8 >> l) & 1)) retention_phase(F, (const bf16_t*)(ws + WS_QB), (const bf16_t*)(ws + WS_KB), (const bf16_t*)(ws + WS_VT), (const bf16_t*)(ws + WS_GB), args.in[2] + (size_t)l * VW, (bf16_t*)(ws + WS_OG), (PROJ8 >> l) & 1);
            else retention8_phase(F, ws + WS_QB, ws + WS_KB, ws + WS_VT, (const bf16_t*)(ws + WS_GB), args.in[2] + (size_t)l * VW, (bf16_t*)(ws + WS_OG), (PROJ8 >> l) & 1); }
        SEAM(pb + 1);
        WS_FRESH;
        if (EN(3) && IN(pb + 2)) _Pragma("unroll 1") for (int rep = 0; rep < NREP(3); ++rep) {
            const bool d8 = ((DENSE8 >> l) & 1) && !((I8A4 >> l) & 1);
            const bool p8 = (PROJ8 >> l) & 1;
            DenseOrder S; S.init(WS_OG, p8 ? VW / 2 : VW, WS_WOUT + l * SZ_WOUT, p8 ? VW / 2 : VW, NT, D, F.G, F.bid);
            EpiRes E{X, nullptr, ROWSS, nullptr, 0, rep ? 0.f : (p8 ? 1.0f / 32.0f : 1.0f), d8 ? (unsigned char*)XB : nullptr};
            if (!p8) pg8::gemm_phase<EpiRes, DenseOrder>(ring, ws, VW, VW, VW, S, E, F.wv);
            else pg8::gemm_phase<EpiRes, DenseOrder, true>(ring, ws, VW, VW, VW, S, E, F.wv);
        }
        SEAM(pb + 2);
        if ((I8A4 >> l) & 1) {
            WS_FRESH;
        if (EN(12) && IN(pb + 3)) _Pragma("unroll 1") for (int rep = 0; rep < NREP(12); ++rep) quant_rows_phase(F, X, ROWSS, ws + WS_XB, (float*)(ws + WS_SA));
            SEAM(pb + 3);
        }
        WS_FRESH;
        if (EN(4) && IN(pb + 4)) _Pragma("unroll 1") for (int rep = 0; rep < NREP(4); ++rep) {
            const int Gc = compute_cus(32 * 44, F.G);
            if (F.bid < Gc) {
                if ((I8A4 >> l) & 1) {
                    DenseOrder S; S.init(WS_XB, D / 2, WS_WGU + l * SZ_WGU, D / 2, NT, 2 * FF, Gc, F.bid);
                    EpiGUi8 E{(bf16_t*)(ws + WS_ACT), FF, (const float*)(ws + WS_SA), (const float*)(ws + WS_SWGU + l * SZ_SWL), (DENSE8 >> l) & 1, 0, 0, 0};
                    pg8::gemm_phase<EpiGUi8, DenseOrder, 2>(ring, ws, D, D, D, S, E, F.wv);
                } else if (!((DENSE8 >> l) & 1)) {
                    DenseOrder S; S.init(WS_X, D, WS_WGU + l * SZ_WGU, D, NT, 2 * FF, Gc, F.bid);
                    EpiGU E{(bf16_t*)(ws + WS_ACT), FF, ROWSS, 0};
                    pg8::gemm_phase<EpiGU, DenseOrder>(ring, ws, D, D, D, S, E, F.wv);
                } else {
                    DenseOrder S; S.init(WS_XB, D / 2, WS_WGU + l * SZ_WGU, D / 2, NT, 2 * FF, Gc, F.bid);
                    EpiGU8 E{ws + WS_ACT, FF, 0, 1.0f / 32.0f, ROWSS};
                    pg8::gemm_phase<EpiGU8, DenseOrder, true>(ring, ws, D, D, D, S, E, F.wv);
                }
            }
            if ((I8B4 >> l) & 1) strip_loop<true>(F, args, l, 0, 704, 0, 736, 1 + l);
            conv_queue(F, args, l == 0 ? 1 : 4); __syncthreads();
        }
        SEAM(pb + 4);
        WS_FRESH;
        if (EN(5) && IN(pb + 5)) _Pragma("unroll 1") for (int rep = 0; rep < NREP(5); ++rep) {
            const bool d8 = (DENSE8 >> l) & 1;
            DenseOrder S; S.init(WS_ACT, d8 ? FF / 2 : FF, WS_WDN + l * SZ_WDN, d8 ? FF / 2 : FF, NT, D, F.G, F.bid);
            EpiRes E{X, nullptr, ROWSS, nullptr, 0, rep ? 0.f : (d8 ? 1.0f / 32.0f : 1.0f), nullptr};
            if (!d8) pg8::gemm_phase<EpiRes, DenseOrder>(ring, ws, FF, FF, FF, S, E, F.wv);
            else pg8::gemm_phase<EpiRes, DenseOrder, true>(ring, ws, FF, FF, FF, S, E, F.wv);
        }
        SEAM(pb + 5);
        WS_FRESH;
        if (EN(6) && IN(pb + 6)) _Pragma("unroll 1") for (int rep = 0; rep < NREP(6); ++rep) {
            PoolOrder S; S.MIX = (unsigned)WS_X; S.W = (unsigned)(WS_WPOOL + l * SZ_WPOOL); S.G = F.G; S.c = F.bid;
            EpiZ E{(bf16_t*)(ws + WS_MIX)};
            pg8::gemm_phase<EpiZ, PoolOrder>(ring, ws, 512, D, 512, S, E, F.wv);
        }
        SEAM(pb + 6);
        unsigned* counts = ctl + CW_CNT + l * 512;
        WS_FRESH;
        if (EN(8) && IN(pb + 7)) _Pragma("unroll 1") for (int rep = 0; rep < NREP(8); ++rep) {
            const float* a_ps = args.in[5] + (size_t)l * D; const float* a_rt = args.in[8] + (size_t)l * D * NE; const float* a_gn = args.in[12] + (size_t)(2 * l + 1) * D;
            constexpr bool all_i8 = (I8B4 & 3) == 3, all_f8 = (F8MASK & 3) == 3;
            if (all_i8 || ((I8B4 >> l) & 1)) router_phase<2>(F, X, (const bf16_t*)(ws + WS_MIX), ROWSS, a_ps, a_rt, a_gn, counts, ws + WS_XG, (int*)(ws + WS_TOK), (float*)(ws + WS_GATE), ws + WS_ACTM, (float*)(ws + WS_SAM));
            else if (all_f8 || ((F8MASK >> l) & 1)) router_phase<1>(F, X, (const bf16_t*)(ws + WS_MIX), ROWSS, a_ps, a_rt, a_gn, counts, ws + WS_XG, (int*)(ws + WS_TOK), (float*)(ws + WS_GATE), ws + WS_ACTM, nullptr);
            else router_phase<0>(F, X, (const bf16_t*)(ws + WS_MIX), ROWSS, a_ps, a_rt, a_gn, counts, ws + WS_XG, (int*)(ws + WS_TOK), (float*)(ws + WS_GATE), ws + WS_ACTM, nullptr);
        }
        SEAM(pb + 7);
        WS_FRESH;
        if (EN(9) && IN(pb + 8)) _Pragma("unroll 1") for (int rep = 0; rep < NREP(9); ++rep) {
            const bool f8 = (F8MASK >> l) & 1;
            MoeOrder S;
            if (!f8) S.init(WS_XG, (size_t)NT * D * 2, D, WS_WMGU + l * SZ_WMGU, (size_t)2 * FE * D * 2, D, 2 * FE / 256, counts, F.G, F.bid);
            else S.init(WS_XG, (size_t)NT * D, D, WS_WMGU + l * SZ_WMGU, (size_t)2 * FE * D, D, 2 * FE / 256, counts, F.G, F.bid, 1);
#ifndef B4GC
#define B4GC 0
#endif
            const int Gc = (l == 0) ? (B4GC ? B4GC : compute_cus(S.total, F.G)) : F.G; S.G = Gc;
            if (F.bid < Gc) {
                if (!f8) { EpiGU E{(bf16_t*)(ws + WS_ACTM), FE, nullptr, (size_t)NT * FE}; pg8::gemm_phase<EpiGU, MoeOrder>(ring, ws, D, D, D, S, E, F.wv); }
                else if ((I8B4 >> l) & 1) { EpiGUi8 E{(bf16_t*)(ws + WS_ACTM), FE8, (const float*)(ws + WS_SAM), (const float*)(ws + WS_SWM) + l * NE * 2 * FE, 1, (size_t)NT * FE8, NT, 2 * FE};
                    pg8::gemm_phase<EpiGUi8, MoeOrder, 2>(ring, ws, D, D, D, S, E, F.wv); }
                else { EpiGU8 E{ws + WS_ACTM, FE8, (size_t)NT * FE8, 1.0f / 32.0f, nullptr}; pg8::gemm_phase<EpiGU8, MoeOrder, true>(ring, ws, D, D, D, S, E, F.wv); }
            }
            if (l == 0) { if (I8A1 & 2) strip_loop<true>(F, args, 1, 0, 384, 0, 0, 0); conv_queue(F, args, 2); }
            __syncthreads();
        }
        SEAM(pb + 8);
        WS_FRESH;
        if (EN(10) && IN(pb + 9)) _Pragma("unroll 1") for (int rep = 0; rep < NREP(10); ++rep) {
            const bool f8 = (F8MASK >> l) & 1;
            MoeOrder S;
            if (!f8) S.init(WS_ACTM, (size_t)NT * FE * 2, FE, WS_WMDN + l * SZ_WMDN, (size_t)D * FE * 2, FE, D / 256, counts, F.G, F.bid);
            else S.init(WS_ACTM, (size_t)NT * FE8, FE8, WS_WMDN + l * SZ_WMDN, (size_t)D * FE8, FE8, D / 256, counts, F.G, F.bid, 1);
            const int Gc = (l == 0) ? compute_cus(S.total, F.G) : F.G; S.G = Gc;
            if (F.bid < Gc) {
                EpiMoeDown E{(bf16_t*)(ws + WS_Y), (const int*)(ws + WS_TOK), (const float*)(ws + WS_GATE), f8 ? 1.0f / 32.0f : 1.0f};
                if (!f8) pg8::gemm_phase<EpiMoeDown, MoeOrder>(ring, ws, FE, FE, FE, S, E, F.wv);
                else pg8::gemm_phase<EpiMoeDown, MoeOrder, true>(ring, ws, FE8, FE8, FE8, S, E, F.wv);
            }
            if (l == 0) conv_queue(F, args, 3);
            __syncthreads();
        }
        SEAM(pb + 9);
        WS_FRESH;
        if (EN(11) && IN(pb + 10)) _Pragma("unroll 1") for (int rep = 0; rep < NREP(11); ++rep) combine_phase(F, X, (const bf16_t*)(ws + WS_Y), XB, args.in[13], F.out, l == 1, ((I8A1 >> (l + 1)) & 1) ? 2 : ((PROJ8 >> (l + 1)) & 1), rep ? 0.f : 1.0f, (float*)(ws + WS_SA));
        if (l == 0) SEAM(pb + 10);
    }
#undef IN
#undef SEAM
}

extern "C" void kernel_launch(void* const* d_in, const int* in_sizes, int n_in, void* d_out, int out_size, void* d_ws, size_t ws_size, hipStream_t stream) {
    static int grid = 0;
    if (grid == 0) {
        if (n_in != 14 || in_sizes[0] != NT * D || out_size != NT * D || ws_size < WS_END) { fprintf(stderr, "kernel_launch: unexpected shapes (n_in %d, in0 %d, out %d, ws %zu < %zu)\n", n_in, n_in > 0 ? in_sizes[0] : -1, out_size, ws_size, (size_t)WS_END); grid = -1; return; }
        int dev = 0, cus = 0, per_cu = 0;
        if (hipGetDevice(&dev) != hipSuccess || hipDeviceGetAttribute(&cus, hipDeviceAttributeMultiprocessorCount, dev) != hipSuccess) { grid = -1; return; }
        if (hipFuncSetAttribute((const void*)trunk_fwd, hipFuncAttributeMaxDynamicSharedMemorySize, LDS_BYTES) != hipSuccess) { fprintf(stderr, "kernel_launch: hipFuncSetAttribute failed\n"); grid = -1; return; }
        if (hipOccupancyMaxActiveBlocksPerMultiprocessor(&per_cu, (const void*)trunk_fwd, 512, LDS_BYTES) != hipSuccess || per_cu < 1) fprintf(stderr, "kernel_launch: occupancy query reports %d\n", per_cu);
        (void)hipGetLastError();
        grid = cus;
    }
    if (grid < 0) return;
    if (hipMemsetAsync((char*)d_ws + WS_CTL, 0, CTL_BYTES, stream) != hipSuccess) return;
    Params p{};
    for (int i = 0; i < 14; ++i) p.in[i] = (const float*)d_in[i];
    p.out = (float*)d_out; p.ws = (unsigned char*)d_ws;
#if MK_N_LAUNCHES == 1
    p.ph_lo = 0; p.ph_hi = NPHASE;
    hipLaunchKernelGGL(trunk_fwd, dim3(grid), dim3(512), LDS_BYTES, stream, p);
#else
    for (int k = 0; k < NPHASE; ++k) { p.ph_lo = k; p.ph_hi = k + 1; hipLaunchKernelGGL(trunk_fwd, dim3(grid), dim3(512), LDS_BYTES, stream, p); }
#endif
}
```

```cpp
#include <hip/hip_runtime.h>
#include <cstdio>

#define LAS __attribute__((address_space(3)))
#define GAS __attribute__((address_space(1)))
typedef unsigned short bf16_t;
typedef short bf16x8 __attribute__((ext_vector_type(8)));
typedef float f32x4 __attribute__((ext_vector_type(4)));
typedef float f32x2 __attribute__((ext_vector_type(2)));
typedef unsigned u32x4 __attribute__((ext_vector_type(4)));
typedef unsigned u32x2 __attribute__((ext_vector_type(2)));
typedef int i32x4 __attribute__((ext_vector_type(4)));
typedef int i32x8 __attribute__((ext_vector_type(8)));

#ifndef MK_N_LAUNCHES
#define MK_N_LAUNCHES 1
#endif

constexpr int NT = 8192, SEQ = 2048, D = 2048, NH = 8, DK = 256, DV = 512, QKW = 2048, VW = 4096, FF = 5632, NE = 8, FE = 1408;
constexpr float EPS = 1e-6f;
constexpr int NPHASE = 23;
#ifndef DENSE8
#define DENSE8 3
#endif
#ifndef PROJ8
#define PROJ8 2
#endif
#ifndef I8A1
#define I8A1 3
#endif
#ifndef I8A4
#define I8A4 1
#endif
#ifndef I8B4
#define I8B4 0
#endif
#ifndef RET8
#define RET8 2
#endif
#ifndef F8MASK
#define F8MASK 3
#endif
constexpr int FE8 = 1536;

constexpr size_t MiB = 1u << 20;
constexpr size_t WS_CTL = 0, CTL_BYTES = 1 * MiB;
constexpr size_t WS_COS = 1 * MiB, WS_SIN = 2 * MiB, WS_DQ = 3 * MiB, WS_DKS = 3 * MiB + 4096, WS_LG2 = 3 * MiB + 8192, WS_DQ8 = 3 * MiB + 12288, WS_DKS8 = 3 * MiB + 16384;
constexpr size_t WS_ROWSS = 4 * MiB, WS_TOK = 5 * MiB, WS_GATE = 5 * MiB + 512 * 1024;
constexpr size_t WS_SA = 6 * MiB, WS_SWGU = 6 * MiB + 64 * 1024;
constexpr size_t WS_SWQ = WS_SA + 128 * 1024, WS_SWV = WS_SA + 160 * 1024, SZ_SWL = 256 * 1024;
constexpr size_t WS_SAM = WS_SA + 1024 * 1024, WS_SWM = WS_SA + 1536 * 1024;
constexpr size_t WS_WQKG = 8 * MiB, SZ_WQKG = 32 * MiB;
constexpr size_t WS_WVT = 72 * MiB, SZ_WVT = 16 * MiB;
constexpr size_t WS_WOUT = 104 * MiB, SZ_WOUT = 16 * MiB;
constexpr size_t WS_WGU = 136 * MiB, SZ_WGU = 44 * MiB;
constexpr size_t WS_WDN = 224 * MiB, SZ_WDN = 22 * MiB;
constexpr size_t WS_WPOOL = 268 * MiB, SZ_WPOOL = 2 * MiB;
constexpr size_t WS_WMGU = 272 * MiB, SZ_WMGU = 88 * MiB;
constexpr size_t WS_WMDN = 448 * MiB, SZ_WMDN = 44 * MiB;
constexpr size_t WS_X = 536 * MiB, WS_XB = 600 * MiB, WS_S = 632 * MiB;
constexpr size_t WS_QB = WS_S, WS_KB = WS_S + 32 * MiB, WS_VT = WS_S + 64 * MiB, WS_GB = WS_S + 128 * MiB, WS_OG = WS_S + 192 * MiB, WS_ACT = WS_S;
constexpr size_t WS_MIX = WS_S, WS_XG = WS_S + 32 * MiB, WS_ACTM = WS_S + 288 * MiB, WS_Y = WS_S + 464 * MiB;
constexpr size_t WS_END = WS_S + 592 * MiB;
constexpr unsigned WS_END_32 = (unsigned)WS_END;
constexpr int CW_BAR = 4096;
constexpr int CW_Q = 8192;
constexpr int CW_CNT = 1024;

constexpr int RING_BYTES = 131072, MISC_OFF = 139264, LDS_BYTES = 143360;

__device__ __forceinline__ unsigned cvt_pk_bf16(float lo, float hi) { unsigned r; asm volatile("v_cvt_pk_bf16_f32 %0, %1, %2" : "=v"(r) : "v"(lo), "v"(hi)); return r; }
__device__ __forceinline__ float bf_lo(unsigned w) { return __uint_as_float(w << 16); }
__device__ __forceinline__ float bf_hi(unsigned w) { return __uint_as_float(w & 0xffff0000u); }
__device__ __forceinline__ f32x4 bf4(u32x2 w) { return (f32x4){bf_lo(w.x), bf_hi(w.x), bf_lo(w.y), bf_hi(w.y)}; }
__device__ __forceinline__ float fast_sigmoid(float a) { return __builtin_amdgcn_rcpf(1.0f + __builtin_amdgcn_exp2f(-1.4426950408889634f * a)); }
__device__ __forceinline__ float wave_sum(float v) {
#pragma unroll
    for (int o = 1; o < 64; o <<= 1) v += __shfl_xor(v, o);
    return v;
}
#define LDS_WAIT() asm volatile("s_waitcnt lgkmcnt(0)" ::: "memory")
__device__ __forceinline__ int mk_tid(int wv) { unsigned z = 0u; asm volatile("" : "+s"(z)); return wv * 64 + (int)__builtin_amdgcn_mbcnt_hi(~0u, __builtin_amdgcn_mbcnt_lo(~0u, z)); }
#define VM_WAIT() asm volatile("s_waitcnt vmcnt(0)" ::: "memory")

namespace pg8 {
constexpr int BM = 256, BK = 64, HALF = 128, HTB = HALF * BK * 2, STAGE_BYTES = 8 * HTB;
__host__ __device__ __forceinline__ int lds_byte(int r, int c) { const int st = (r >> 4) * 2 + (c >> 5), rr = r & 15, cc = c & 31, ob = rr * 64 + cc * 2; return st * 1024 + (ob ^ (((ob >> 9) & 1) << 5)); }
__host__ __device__ __forceinline__ void stage_rc(int b, int& R, int& C) { const int st = b / 1024, sb = b % 1024, swz = sb ^ (((sb >> 9) & 1) << 5); R = (st >> 1) * 16 + swz / 64; C = (st & 1) * 32 + (swz % 64) / 2; }
__host__ __device__ __forceinline__ int perm32(int rho) { const int n = rho >> 4, i = rho & 15; return 8 * (i >> 2) + 4 * n + (i & 3); }

struct Unit { unsigned a, b; int pm, pn, grp, rows; };

__device__ __forceinline__ int xcd_remap(int L, int nwg) { const int q = nwg / 8, r = nwg % 8, xcd = L % 8, off = L / 8; return (xcd < r ? xcd * (q + 1) : r * (q + 1) + (xcd - r) * q) + off; }
__device__ __forceinline__ void walk2d(int w, int nM, int nN, int& pm, int& pn) { const int nig = 8 * nN, gid = w / nig, fm = gid * 8, gsz = (nM - fm) < 8 ? (nM - fm) : 8; pm = fm + ((w % nig) % gsz); pn = (w % nig) / gsz; }

template <class Epi, class Sched, int FP8 = 0>
__device__ __forceinline__ void gemm_phase(LAS unsigned char* lds, const unsigned char* wsbase, const int K, const int lda, const int ldb, const Sched& S, const Epi& E, const int wv) {
    int tid = mk_tid(wv); asm volatile("" : "+v"(tid));
    const int wid = __builtin_amdgcn_readfirstlane(tid >> 6), lane = tid & 63, wr = wid >> 2, wc = wid & 3, fr = lane & 15, fq = lane >> 4;
    constexpr int ES = FP8 ? 1 : 2;
    const int nt = K * ES / 128;
    unsigned voffA[2], voffB[2];
#pragma unroll
    for (int i = 0; i < 2; ++i) { int R, C; stage_rc(tid * 16 + i * 8192, R, C); const int Rb = (R & ~31) + perm32(R & 31);
        voffA[i] = (unsigned)(R * lda * ES + C * 2); voffB[i] = (unsigned)(Rb * ldb * ES + C * 2); }
    const unsigned kstep = (unsigned)(BK * 2);
    const unsigned hstepA = (unsigned)HALF * lda * ES, hstepB = (unsigned)HALF * ldb * ES;
    const unsigned ldsw = (unsigned)wid * 1024u;
    const __amdgpu_buffer_rsrc_t rsrc = __builtin_amdgcn_make_buffer_rsrc((void*)wsbase, 0, (int)WS_END_32, 0x00020000);
    const int aoff = lds_byte(wr * 64 + fr, fq * 8); int boff = lds_byte(wc * 32 + fr, fq * 8) + 4 * HTB;
    asm volatile("" : "+v"(boff));
#define PG8_SBR(b, h) (((b) * 2 + (h)) * HTB)
#define PG8_SA(b, h) (((b) * 2 + (h)) * HTB)
#define PG8_SB(b, h) ((4 + (b) * 2 + (h)) * HTB)
#define PG8_STAGE(bufoff, soff, voff) do { _Pragma("unroll") for (int _i = 0; _i < 2; ++_i) \
        __builtin_amdgcn_raw_ptr_buffer_load_lds(rsrc, (LAS unsigned*)(lds + (bufoff) + ldsw + _i * 8192), 16, (voff)[_i], (int)(soff), 0, 0); } while (0)
#define PG8_LD16(off) (*(const LAS i32x4*)(lds + (off)))
#define PG8_LDA(dst, b, h) do { _Pragma("unroll") for (int m = 0; m < 4; ++m) { \
        if constexpr (FP8 == 1) { dst##8[m].lo = PG8_LD16(PG8_SA(b, h) + aoff + m * 2048); dst##8[m].hi = PG8_LD16(PG8_SA(b, h) + aoff + m * 2048 + 1024); } \
        else { _Pragma("unroll") for (int k = 0; k < 2; ++k) dst[m][k] = *(const LAS bf16x8*)(lds + PG8_SA(b, h) + aoff + m * 2048 + k * 1024); } } } while (0)
#define PG8_LDB(dst, b, h) do { _Pragma("unroll") for (int n = 0; n < 2; ++n) { \
        if constexpr (FP8 == 1) { dst##8[n].lo = PG8_LD16(PG8_SBR(b, h) + boff + n * 2048); dst##8[n].hi = PG8_LD16(PG8_SBR(b, h) + boff + n * 2048 + 1024); } \
        else { _Pragma("unroll") for (int k = 0; k < 2; ++k) dst[n][k] = *(const LAS bf16x8*)(lds + PG8_SBR(b, h) + boff + n * 2048 + k * 1024); } } } while (0)
#define PG8_MMA(ai, bj, At, Bt) do { __builtin_amdgcn_s_setprio(1); _Pragma("unroll") for (int m = 0; m < 4; ++m) _Pragma("unroll") for (int n = 0; n < 2; ++n) { \
        if constexpr (FP8 == 1) asm volatile("v_mfma_scale_f32_16x16x128_f8f6f4 %0, %1, %2, %0, %3, %3 op_sel_hi:[0,0,0]" : "+v"(acc[ai][bj][m][n]) : "v"(Bt##8[n]), "v"(At##8[m]), "v"(f8scale)); \
        else if constexpr (FP8 == 2) { _Pragma("unroll") for (int k = 0; k < 2; ++k) acc[ai][bj][m][n] = __builtin_bit_cast(f32x4, __builtin_amdgcn_mfma_i32_16x16x64_i8(__builtin_bit_cast(i32x4, Bt[n][k]), __builtin_bit_cast(i32x4, At[m][k]), __builtin_bit_cast(i32x4, acc[ai][bj][m][n]), 0, 0, 0)); } \
        else { _Pragma("unroll") for (int k = 0; k < 2; ++k) acc[ai][bj][m][n] = __builtin_amdgcn_mfma_f32_16x16x32_bf16(Bt[n][k], At[m][k], acc[ai][bj][m][n], 0, 0, 0); } } \
        __builtin_amdgcn_s_setprio(0); } while (0)
#define PG8_WAIT_V(n) asm volatile("s_waitcnt vmcnt(" #n ")" ::: "memory")
#define PG8_WAIT_L(n) asm volatile("s_waitcnt lgkmcnt(" #n ")" ::: "memory")
#define PG8_BAR __builtin_amdgcn_s_barrier()
#define PG8_SCHED __builtin_amdgcn_sched_barrier(0)
    Unit cur, nxt; int ui = 0;
    if (!S.next(0, cur)) return;
    f32x4 acc[2][2][4][2];
#pragma unroll
    for (int a = 0; a < 2; ++a)
#pragma unroll
        for (int b = 0; b < 2; ++b)
#pragma unroll
            for (int m = 0; m < 4; ++m)
#pragma unroll
                for (int n = 0; n < 2; ++n) acc[a][b][m][n] = (f32x4){0.f, 0.f, 0.f, 0.f};
    bf16x8 At[4][2], B0[2][2], B1[2][2]; i32x8 At8[4], B08[2], B18[2];
    int f8scale = 0x7f7f7f7f; asm volatile("" : "+v"(f8scale));
    unsigned cA = cur.a, cB = cur.b;
    PG8_STAGE(PG8_SB(0, 0), cB, voffB); PG8_STAGE(PG8_SB(0, 1), cB + hstepB, voffB); PG8_STAGE(PG8_SA(0, 0), cA, voffA); PG8_STAGE(PG8_SA(0, 1), cA + hstepA, voffA);
    if (wr == 1) PG8_BAR;
    PG8_WAIT_V(2); PG8_BAR;
    PG8_STAGE(PG8_SB(1, 0), cB + kstep, voffB); PG8_STAGE(PG8_SA(1, 0), cA + kstep, voffA); PG8_STAGE(PG8_SB(1, 1), cB + hstepB + kstep, voffB);
    PG8_WAIT_V(6); PG8_BAR;
    for (;;) {
        const bool has_next = S.next(ui + 1, nxt);
        const unsigned nA = has_next ? nxt.a : cA, nB = has_next ? nxt.b : cB;
        for (int t = 0; t < nt; t += 2) {
            const bool last = (t == nt - 2);
            const unsigned a1 = cA + (unsigned)(t + 1) * kstep;
            const unsigned a2 = last ? nA : cA + (unsigned)(t + 2) * kstep, b2 = last ? nB : cB + (unsigned)(t + 2) * kstep;
            const unsigned a3 = a2 + kstep, b3 = b2 + kstep;
            PG8_LDB(B0, 0, 0); PG8_LDB(B1, 0, 1); PG8_SCHED; PG8_LDA(At, 0, 0); PG8_STAGE(PG8_SA(1, 1), a1 + hstepA, voffA);
            PG8_WAIT_V(8); PG8_WAIT_L(0); PG8_BAR; PG8_MMA(0, 0, At, B0); PG8_MMA(0, 1, At, B1); PG8_BAR; PG8_SCHED;
            PG8_LDA(At, 0, 1); PG8_STAGE(PG8_SB(0, 0), b2, voffB); PG8_STAGE(PG8_SB(0, 1), b2 + hstepB, voffB); PG8_STAGE(PG8_SA(0, 0), a2, voffA);
            PG8_WAIT_V(8); PG8_WAIT_L(0); PG8_BAR; PG8_MMA(1, 0, At, B0); PG8_MMA(1, 1, At, B1); PG8_BAR; PG8_SCHED;
            PG8_LDB(B0, 1, 0); PG8_LDB(B1, 1, 1); PG8_SCHED; PG8_LDA(At, 1, 0); PG8_STAGE(PG8_SA(0, 1), a2 + hstepA, voffA);
            PG8_WAIT_V(8); PG8_WAIT_L(0); PG8_BAR; PG8_MMA(0, 0, At, B0); PG8_MMA(0, 1, At, B1); PG8_BAR; PG8_SCHED;
            PG8_LDA(At, 1, 1); PG8_STAGE(PG8_SB(1, 0), b3, voffB); PG8_STAGE(PG8_SB(1, 1), b3 + hstepB, voffB); PG8_STAGE(PG8_SA(1, 0), a3, voffA);
            PG8_WAIT_V(8); PG8_WAIT_L(0); PG8_BAR; PG8_MMA(1, 0, At, B0); PG8_MMA(1, 1, At, B1); PG8_BAR; PG8_SCHED;
        }
        if (wr == 0) PG8_BAR;
        if constexpr (FP8 == 1) { asm volatile("s_nop 15\n\ts_nop 7" ::: "memory"); PG8_SCHED; }
        if constexpr (FP8 == 2) {
            _Pragma("unroll") for (int a = 0; a < 2; ++a) _Pragma("unroll") for (int b = 0; b < 2; ++b) _Pragma("unroll") for (int m = 0; m < 4; ++m) _Pragma("unroll") for (int n = 0; n < 2; ++n)
                acc[a][b][m][n] = __builtin_convertvector(__builtin_bit_cast(i32x4, acc[a][b][m][n]), f32x4); }
        E(acc, cur, wr, wc, fr, fq);
        if (!has_next) break;
#pragma unroll
        for (int a = 0; a < 2; ++a)
#pragma unroll
            for (int b = 0; b < 2; ++b)
#pragma unroll
                for (int m = 0; m < 4; ++m)
#pragma unroll
                    for (int n = 0; n < 2; ++n) acc[a][b][m][n] = (f32x4){0.f, 0.f, 0.f, 0.f};
        cur = nxt; cA = nA; cB = nB; ++ui;
        if (wr == 1) PG8_BAR;
    }
    PG8_WAIT_V(0);
    PG8_BAR;
#undef PG8_SA
#undef PG8_SB
#undef PG8_SBR
#undef PG8_STAGE
#undef PG8_LDA
#undef PG8_LD16
#undef PG8_LDB
#undef PG8_MMA
#undef PG8_WAIT_V
#undef PG8_WAIT_L
#undef PG8_BAR
#undef PG8_SCHED
}
}

#define XB_TMO      128
#define XB_XCNT(j)  (256  + 64 * (j))
#define XB_XSUB(j)  (1280 + 64 * (j))
#define XB_XGEN(j)  (2304 + 64 * (j))
#define XB_TOP      3328
#define XB_TOPGEN   3392
#define XCD_BAR_WORDS 3456
#define XB_SPIN_CAP (1u << 18)

__device__ __forceinline__ unsigned xb_ld(unsigned* p)              { return __hip_atomic_load(p, __ATOMIC_RELAXED, __HIP_MEMORY_SCOPE_AGENT); }
__device__ __forceinline__ unsigned xb_add(unsigned* p, unsigned v) { return __hip_atomic_fetch_add(p, v, __ATOMIC_RELAXED, __HIP_MEMORY_SCOPE_AGENT); }
__device__ __forceinline__ unsigned xb_xcc_id() { return (unsigned)__builtin_amdgcn_s_getreg((3 << 11) | 20) & 0xFu; }
#define XB_SPIN(cond, bar) do { unsigned _sp = 0; while (cond) { __builtin_amdgcn_s_sleep(1); \
    if ((++_sp & 255u) == 0u) { if (xb_ld(&(bar)[XB_TMO])) break; if (_sp > XB_SPIN_CAP) { atomicAdd(&(bar)[XB_TMO], 1u); break; } } } } while (0)

struct XcdBarrier { unsigned* bar; unsigned x; volatile LAS unsigned* st; int wv; };

__device__ __forceinline__ XcdBarrier xcd_barrier_post(unsigned* bar, volatile LAS unsigned* st) {
    XcdBarrier b; b.bar = bar; b.x = xb_xcc_id(); b.st = st;
    if (threadIdx.x == 0) (void)xb_add(&bar[XB_XCNT(b.x)], 1u);
    return b;
}
__device__ __forceinline__ void xcd_barrier_complete(unsigned* bar, unsigned x, unsigned& nloc, unsigned& nx) {
    const unsigned G = gridDim.x * gridDim.y * gridDim.z;
    unsigned sum, cnt, mine, sp = 0u;
    for (;;) {
        sum = 0u; cnt = 0u; mine = 0u;
#pragma unroll
        for (unsigned j = 0; j < 16; ++j) { const unsigned c = xb_ld(&bar[XB_XCNT(j)]); sum += c; cnt += (c > 0u) ? 1u : 0u; mine = (j == x) ? c : mine; }
        if (sum == G) break;
        __builtin_amdgcn_s_sleep(1);
        if ((++sp & 255u) == 0u) { if (xb_ld(&bar[XB_TMO])) break; if (sp > XB_SPIN_CAP) { atomicAdd(&bar[XB_TMO], 1u); break; } }
    }
    nloc = mine > 0u ? mine : 1u; nx = cnt > 0u ? cnt : 1u;
}
__device__ __forceinline__ void xcd_barrier(const XcdBarrier& b) {
    asm volatile("s_waitcnt vmcnt(0)" ::: "memory");
    __syncthreads();
    if (mk_tid(b.wv) == 0) {
        unsigned* bar = b.bar;
        __builtin_amdgcn_s_waitcnt(0);
        unsigned nloc = b.st[0], nx = b.st[1];
        if (nloc == 0u) { xcd_barrier_complete(bar, b.x, nloc, nx); b.st[0] = nloc; b.st[1] = nx; }
        const unsigned old = xb_add(&bar[XB_XSUB(b.x)], 1u);
        const unsigned gen = old / nloc;
        if (old + 1u == (gen + 1u) * nloc) {
            __builtin_amdgcn_fence(__ATOMIC_RELEASE, "agent");
            asm volatile("s_waitcnt vmcnt(0)" ::: "memory");
            const unsigned og = xb_add(&bar[XB_TOP], 1u);
            const unsigned tg = og / nx;
            if (og + 1u == (tg + 1u) * nx) xb_add(&bar[XB_TOPGEN], 1u);
            else XB_SPIN(xb_ld(&bar[XB_TOPGEN]) == tg, bar);
            __builtin_amdgcn_fence(__ATOMIC_ACQUIRE, "agent");
            xb_add(&bar[XB_XGEN(b.x)], 1u);
            asm volatile("s_waitcnt vmcnt(0)" ::: "memory");
        } else {
            XB_SPIN(xb_ld(&bar[XB_XGEN(b.x)]) == gen, bar);
            __builtin_amdgcn_fence(__ATOMIC_ACQUIRE, "agent");
            asm volatile("s_waitcnt vmcnt(0)" ::: "memory");
        }
    }
    __syncthreads();
}

using pg8::Unit;
struct DenseOrder {
    unsigned A, B; int nM, nN, nwg, G, c; unsigned tA, tB;
    __device__ __forceinline__ void init(size_t A_, int lda, size_t B_, int ldb, int M, int N, int G_, int c_) { A = (unsigned)A_; B = (unsigned)B_; nM = M / 256; nN = N / 256; nwg = nM * nN; G = G_; c = c_; tA = 256u * lda * 2; tB = 256u * ldb * 2; }
    __device__ __forceinline__ bool next(int i, Unit& u) const {
        const long L = (long)i * G + c; if (L >= nwg) return false;
        const int w = pg8::xcd_remap((int)L, nwg); pg8::walk2d(w, nM, nN, u.pm, u.pn);
        u.a = A + (unsigned)u.pm * tA; u.b = B + (unsigned)u.pn * tB; u.grp = 0; u.rows = 256; return true;
    }
};
struct A1Order {
    unsigned XB, WQKG, WVT, t; int G, c;
    __device__ __forceinline__ bool next(int i, Unit& u) const {
        const long L = (long)i * G + c; if (L >= 32 * 48) return false;
        const int w = pg8::xcd_remap((int)L, 32 * 48); pg8::walk2d(w, 32, 48, u.pm, u.pn);
        if (u.pn < 32) { u.a = XB + (unsigned)u.pm * t; u.b = WQKG + (unsigned)u.pn * t; } else { u.a = WVT + (unsigned)(u.pn - 32) * t; u.b = XB + (unsigned)u.pm * t; }
        u.grp = 0; u.rows = 256; return true;
    }
};
struct PoolOrder {
    unsigned MIX, W; int G, c;
    __device__ __forceinline__ bool next(int i, Unit& u) const {
        const long L = (long)i * G + c; if (L >= 256) return false;
        const int rem = (int)L & 7; u.pm = (int)L >> 3; u.grp = rem >> 1; u.pn = rem & 1;
        u.a = MIX + ((unsigned)u.pm * 256 * D + (unsigned)u.grp * 512) * 2; u.b = W + ((unsigned)u.grp * 512 * 512 + (unsigned)u.pn * 256 * 512) * 2; u.rows = 256; return true;
    }
};
struct MoeOrder {
    unsigned A, B; int G, c, nN, total; int cnt[8], pre[9]; unsigned eA, eB, tA, tB;
    __device__ __forceinline__ void init(size_t A_, size_t eA_, int lda, size_t B_, size_t eB_, int ldb, int nN_, const unsigned* counts, int G_, int c_, int es = 2) {
        A = (unsigned)A_; B = (unsigned)B_; eA = (unsigned)eA_; eB = (unsigned)eB_; tA = 256u * lda * es; tB = 256u * ldb * es; nN = nN_; G = G_; c = c_;
        int p = 0;
#pragma unroll
        for (int e = 0; e < 8; ++e) { int n = (int)__builtin_amdgcn_readfirstlane(__hip_atomic_load(counts + 64 * e, __ATOMIC_RELAXED, __HIP_MEMORY_SCOPE_AGENT)); n = n > NT ? NT : n; cnt[e] = n; pre[e] = p; p += (n + 255) >> 8; }
        pre[8] = p; total = p * nN;
    }
    __device__ __forceinline__ bool next(int i, Unit& u) const {
        const long L = (long)i * G + c; if (L >= total) return false;
        const int w = pg8::xcd_remap((int)L, total);
        int e = 0;
#pragma unroll
        for (int j = 1; j < 8; ++j) e += (w >= pre[j] * nN) ? 1 : 0;
        int pe = 0, ce = 0, te = 0;
#pragma unroll
        for (int j = 0; j < 8; ++j) { if (j == e) { pe = pre[j]; ce = cnt[j]; te = pre[j + 1] - pre[j]; } }
        pg8::walk2d(w - pe * nN, te, nN, u.pm, u.pn);
        u.grp = e; u.rows = ce - u.pm * 256;
        u.a = A + (unsigned)e * eA + (unsigned)u.pm * tA; u.b = B + (unsigned)e * eB + (unsigned)u.pn * tB; return true;
    }
};

struct EpiA1 {
    bf16_t* QB; bf16_t* KB; bf16_t* GB; bf16_t* VT; const float* COS; const float* SIN; const float* DQ; const float* DKS; float ascale; int r8; const float* SA; const float* SWQ; const float* SWV;
    __device__ __forceinline__ void operator()(const f32x4 (&acc)[2][2][4][2], const Unit& u, int wr, int wc, int fr, int fq) const {
        if (u.pn < 32) {
            const int kind = u.pn < 8 ? 0 : (u.pn < 16 ? 1 : 2), h = u.pn & 7;
#pragma unroll
            for (int ai = 0; ai < 2; ++ai)
#pragma unroll
                for (int m = 0; m < 4; ++m) {
                    const int row = u.pm * 256 + ai * 128 + wr * 64 + m * 16 + fr, pos = row & (SEQ - 1);
                    float rf = ascale; if (kind < 2) rf = ascale * (kind == 0 ? DQ : DKS)[h * 128 + (pos & 127)];
                    if (SA) rf *= SA[row];
#pragma unroll
                    for (int bj = 0; bj < 2; ++bj) {
                        const int cc = bj * 128 + wc * 32 + fq * 8;
                        f32x4 v0 = acc[ai][bj][m][0], v1 = acc[ai][bj][m][1];
                        if (SA) { v0 = v0 * *(const f32x4*)(SWQ + u.pn * 256 + cc); v1 = v1 * *(const f32x4*)(SWQ + u.pn * 256 + cc + 4); }
                        bf16_t* dst;
                        if (kind < 2) {
                            const f32x4 cs = *(const f32x4*)(COS + pos * 128 + (cc >> 1)), sn = *(const f32x4*)(SIN + pos * 128 + (cc >> 1));
                            f32x4 o0, o1;
                            o0[0] = v0[0] * cs[0] - v0[1] * sn[0]; o0[1] = v0[1] * cs[0] + v0[0] * sn[0];
                            o0[2] = v0[2] * cs[1] - v0[3] * sn[1]; o0[3] = v0[3] * cs[1] + v0[2] * sn[1];
                            o1[0] = v1[0] * cs[2] - v1[1] * sn[2]; o1[1] = v1[1] * cs[2] + v1[0] * sn[2];
                            o1[2] = v1[2] * cs[3] - v1[3] * sn[3]; o1[3] = v1[3] * cs[3] + v1[2] * sn[3];
                            v0 = o0 * rf; v1 = o1 * rf;
                            dst = (kind == 0 ? QB : KB) + (size_t)row * QKW + h * 256 + cc;
                        } else { v0 = v0 * rf; v1 = v1 * rf; dst = GB + (size_t)row * VW + (u.pn - 16) * 256 + cc; }
                        if (r8 && kind < 2) { int w0 = 0, w1 = 0; w0 = __builtin_amdgcn_cvt_pk_fp8_f32(v0[0], v0[1], w0, false); w0 = __builtin_amdgcn_cvt_pk_fp8_f32(v0[2], v0[3], w0, true);
                            w1 = __builtin_amdgcn_cvt_pk_fp8_f32(v1[0], v1[1], w1, false); w1 = __builtin_amdgcn_cvt_pk_fp8_f32(v1[2], v1[3], w1, true); u32x2 w; w.x = (unsigned)w0; w.y = (unsigned)w1;
                            *(u32x2*)((unsigned char*)(kind == 0 ? QB : KB) + (size_t)row * QKW + h * 256 + cc) = w; }
                        else { u32x4 w; w.x = cvt_pk_bf16(v0[0], v0[1]); w.y = cvt_pk_bf16(v0[2], v0[3]); w.z = cvt_pk_bf16(v1[0], v1[1]); w.w = cvt_pk_bf16(v1[2], v1[3]);
                            *(u32x4*)dst = w; }
                    }
                }
        } else {
#pragma unroll
            for (int ai = 0; ai < 2; ++ai)
#pragma unroll
                for (int m = 0; m < 4; ++m) {
                    const int vrow = (u.pn - 32) * 256 + ai * 128 + wr * 64 + m * 16 + fr; const float rsv = SA ? ascale * SWV[vrow] : ascale;
#pragma unroll
                    for (int bj = 0; bj < 2; ++bj) {
                        const int tok = u.pm * 256 + bj * 128 + wc * 32 + fq * 8;
                        f32x4 v0 = acc[ai][bj][m][0] * rsv, v1 = acc[ai][bj][m][1] * rsv;
                        if (SA) { v0 = v0 * *(const f32x4*)(SA + tok); v1 = v1 * *(const f32x4*)(SA + tok + 4); }
                        if (r8) { int w0 = 0, w1 = 0; w0 = __builtin_amdgcn_cvt_pk_fp8_f32(v0[0], v0[1], w0, false); w0 = __builtin_amdgcn_cvt_pk_fp8_f32(v0[2], v0[3], w0, true);
                            w1 = __builtin_amdgcn_cvt_pk_fp8_f32(v1[0], v1[1], w1, false); w1 = __builtin_amdgcn_cvt_pk_fp8_f32(v1[2], v1[3], w1, true); u32x2 w; w.x = (unsigned)w0; w.y = (unsigned)w1;
                            *(u32x2*)((unsigned char*)VT + (size_t)vrow * NT + tok) = w; }
                        else { u32x4 w; w.x = cvt_pk_bf16(v0[0], v0[1]); w.y = cvt_pk_bf16(v0[2], v0[3]); w.z = cvt_pk_bf16(v1[0], v1[1]); w.w = cvt_pk_bf16(v1[2], v1[3]);
                            *(u32x4*)(VT + (size_t)vrow * NT + tok) = w; }
                    }
                }
        }
    }
};
struct EpiRes {
    bf16_t* X; bf16_t* XB; float* ROWSS; const float* colscale; int pool; float ascale; unsigned char* XB8;
    __device__ __forceinline__ void operator()(const f32x4 (&acc)[2][2][4][2], const Unit& u, int wr, int wc, int fr, int fq) const {
        const int colbase = pool ? (u.grp * 512 + u.pn * 256) : u.pn * 256;
        f32x4 cs[2][2];
#pragma unroll
        for (int bj = 0; bj < 2; ++bj)
#pragma unroll
            for (int n = 0; n < 2; ++n) cs[bj][n] = (colscale ? *(const f32x4*)(colscale + colbase + bj * 128 + wc * 32 + fq * 8 + n * 4) : (f32x4){1.f, 1.f, 1.f, 1.f}) * ascale;
#pragma unroll
        for (int ai = 0; ai < 2; ++ai)
#pragma unroll
            for (int m = 0; m < 4; ++m) {
                const int row = u.pm * 256 + ai * 128 + wr * 64 + m * 16 + fr;
                float ss = 0.f;
#pragma unroll
                for (int bj = 0; bj < 2; ++bj) {
                    const size_t off = (size_t)row * D + colbase + bj * 128 + wc * 32 + fq * 8;
                    const u32x4 xw = *(const u32x4*)(X + off); const f32x4 x0 = bf4((u32x2){xw.x, xw.y}), x1 = bf4((u32x2){xw.z, xw.w});
                    const f32x4 v0 = x0 + acc[ai][bj][m][0] * cs[bj][0], v1 = x1 + acc[ai][bj][m][1] * cs[bj][1];
                    { u32x4 w; w.x = cvt_pk_bf16(v0[0], v0[1]); w.y = cvt_pk_bf16(v0[2], v0[3]); w.z = cvt_pk_bf16(v1[0], v1[1]); w.w = cvt_pk_bf16(v1[2], v1[3]); *(u32x4*)(X + off) = w; }
                    if (XB) { u32x4 w; w.x = cvt_pk_bf16(v0[0], v0[1]); w.y = cvt_pk_bf16(v0[2], v0[3]); w.z = cvt_pk_bf16(v1[0], v1[1]); w.w = cvt_pk_bf16(v1[2], v1[3]); *(u32x4*)(XB + off) = w; }
                    if (XB8) { int w0 = 0, w1 = 0; w0 = __builtin_amdgcn_cvt_pk_fp8_f32(v0[0], v0[1], w0, false); w0 = __builtin_amdgcn_cvt_pk_fp8_f32(v0[2], v0[3], w0, true);
                        w1 = __builtin_amdgcn_cvt_pk_fp8_f32(v1[0], v1[1], w1, false); w1 = __builtin_amdgcn_cvt_pk_fp8_f32(v1[2], v1[3], w1, true); u32x2 w; w.x = (unsigned)w0; w.y = (unsigned)w1; *(u32x2*)(XB8 + off) = w; }
                    ss += (v0[0] * v0[0] + v0[1] * v0[1]) + (v0[2] * v0[2] + v0[3] * v0[3]) + (v1[0] * v1[0] + v1[1] * v1[1]) + (v1[2] * v1[2] + v1[3] * v1[3]);
                }
                ss += __shfl_xor(ss, 16); ss += __shfl_xor(ss, 32);
                if (fq == 0) ROWSS[(size_t)row * 32 + (colbase >> 8) * 4 + wc] = ss;
                if (m & 1) asm volatile("" ::: "memory");
            }
    }
};
struct EpiZ {
    bf16_t* Z;
    __device__ __forceinline__ void operator()(const f32x4 (&acc)[2][2][4][2], const Unit& u, int wr, int wc, int fr, int fq) const {
#pragma unroll
        for (int ai = 0; ai < 2; ++ai)
#pragma unroll
            for (int m = 0; m < 4; ++m) { const int row = u.pm * 256 + ai * 128 + wr * 64 + m * 16 + fr;
#pragma unroll
                for (int bj = 0; bj < 2; ++bj) { const f32x4 v0 = acc[ai][bj][m][0], v1 = acc[ai][bj][m][1];
                    u32x4 w; w.x = cvt_pk_bf16(v0[0], v0[1]); w.y = cvt_pk_bf16(v0[2], v0[3]); w.z = cvt_pk_bf16(v1[0], v1[1]); w.w = cvt_pk_bf16(v1[2], v1[3]);
                    *(u32x4*)(Z + (size_t)row * D + u.grp * 512 + u.pn * 256 + bj * 128 + wc * 32 + fq * 8) = w; } }
    }
};
struct EpiGU {
    bf16_t* ACT; int ldact; const float* ROWSS; size_t estride;
    __device__ __forceinline__ void operator()(const f32x4 (&acc)[2][2][4][2], const Unit& u, int wr, int wc, int fr, int fq) const {
        bf16_t* base = ACT + (size_t)u.grp * estride;
#pragma unroll
        for (int ai = 0; ai < 2; ++ai)
#pragma unroll
            for (int m = 0; m < 4; ++m) {
                const int row = u.pm * 256 + ai * 128 + wr * 64 + m * 16 + fr;
                float rs = 1.f;
                if (ROWSS) { const f32x4 p0 = *(const f32x4*)(ROWSS + (size_t)row * 32 + fq * 8), p1 = *(const f32x4*)(ROWSS + (size_t)row * 32 + fq * 8 + 4);
                    float s = (p0[0] + p0[1]) + (p0[2] + p0[3]) + (p1[0] + p1[1]) + (p1[2] + p1[3]); s += __shfl_xor(s, 16); s += __shfl_xor(s, 32); rs = __builtin_amdgcn_rsqf(s * (1.0f / D) + EPS); }
                float o[8];
#pragma unroll
                for (int n = 0; n < 2; ++n)
#pragma unroll
                    for (int j = 0; j < 4; ++j) { const float a = acc[ai][0][m][n][j] * rs, g = acc[ai][1][m][n][j] * rs; o[n * 4 + j] = a * fast_sigmoid(a) * g; }
                u32x4 w; w.x = cvt_pk_bf16(o[0], o[1]); w.y = cvt_pk_bf16(o[2], o[3]); w.z = cvt_pk_bf16(o[4], o[5]); w.w = cvt_pk_bf16(o[6], o[7]);
                *(u32x4*)(base + (size_t)row * ldact + u.pn * 128 + wc * 32 + fq * 8) = w;
            }
    }
};
struct EpiGUi8 {
    bf16_t* ACT; int ldact; const float* SA; const float* SW; int out8; size_t estride; int sastride, swstride;
    __device__ __forceinline__ void operator()(const f32x4 (&acc)[2][2][4][2], const Unit& u, int wr, int wc, int fr, int fq) const {
        f32x4 wa[2], wu[2];
#pragma unroll
        for (int n = 0; n < 2; ++n) { wa[n] = *(const f32x4*)(SW + u.grp * swstride + u.pn * 256 + wc * 32 + fq * 8 + n * 4); wu[n] = *(const f32x4*)(SW + u.grp * swstride + u.pn * 256 + 128 + wc * 32 + fq * 8 + n * 4); }
#pragma unroll
        for (int ai = 0; ai < 2; ++ai)
#pragma unroll
            for (int m = 0; m < 4; ++m) {
                const int row = u.pm * 256 + ai * 128 + wr * 64 + m * 16 + fr; const float sa = SA[u.grp * sastride + row];
                float o[8];
#pragma unroll
                for (int n = 0; n < 2; ++n)
#pragma unroll
                    for (int j = 0; j < 4; ++j) { const float a = acc[ai][0][m][n][j] * sa * wa[n][j], g = acc[ai][1][m][n][j] * sa * wu[n][j]; o[n * 4 + j] = a * fast_sigmoid(a) * g; }
                if (out8) { u32x2 w; w.x = 0u; w.y = 0u;
                    w.x = (unsigned)__builtin_amdgcn_cvt_pk_fp8_f32(o[0], o[1], (int)w.x, false); w.x = (unsigned)__builtin_amdgcn_cvt_pk_fp8_f32(o[2], o[3], (int)w.x, true);
                    w.y = (unsigned)__builtin_amdgcn_cvt_pk_fp8_f32(o[4], o[5], (int)w.y, false); w.y = (unsigned)__builtin_amdgcn_cvt_pk_fp8_f32(o[6], o[7], (int)w.y, true);
                    *(u32x2*)((unsigned char*)ACT + (size_t)u.grp * estride + (size_t)row * ldact + u.pn * 128 + wc * 32 + fq * 8) = w; }
                else { u32x4 w; w.x = cvt_pk_bf16(o[0], o[1]); w.y = cvt_pk_bf16(o[2], o[3]); w.z = cvt_pk_bf16(o[4], o[5]); w.w = cvt_pk_bf16(o[6], o[7]);
                    *(u32x4*)(ACT + (size_t)row * ldact + u.pn * 128 + wc * 32 + fq * 8) = w; }
            }
    }
};
struct EpiGU8 {
    unsigned char* ACT; int ldact; size_t estride; float s; const float* ROWSS;
    __device__ __forceinline__ void operator()(const f32x4 (&acc)[2][2][4][2], const Unit& u, int wr, int wc, int fr, int fq) const {
        unsigned char* base = ACT + (size_t)u.grp * estride;
#pragma unroll
        for (int ai = 0; ai < 2; ++ai)
#pragma unroll
            for (int m = 0; m < 4; ++m) {
                const int row = u.pm * 256 + ai * 128 + wr * 64 + m * 16 + fr;
                float rs = s;
                if (ROWSS) { const f32x4 p0 = *(const f32x4*)(ROWSS + (size_t)row * 32 + fq * 8), p1 = *(const f32x4*)(ROWSS + (size_t)row * 32 + fq * 8 + 4);
                    float q = (p0[0] + p0[1]) + (p0[2] + p0[3]) + (p1[0] + p1[1]) + (p1[2] + p1[3]); q += __shfl_xor(q, 16); q += __shfl_xor(q, 32); rs = s * __builtin_amdgcn_rsqf(q * (1.0f / D) + EPS); }
                float o[8];
#pragma unroll
                for (int n = 0; n < 2; ++n)
#pragma unroll
                    for (int j = 0; j < 4; ++j) { const float a = acc[ai][0][m][n][j] * rs, g = acc[ai][1][m][n][j] * rs; o[n * 4 + j] = a * fast_sigmoid(a) * g; }
                u32x2 w; w.x = 0u; w.y = 0u;
                w.x = (unsigned)__builtin_amdgcn_cvt_pk_fp8_f32(o[0], o[1], (int)w.x, false); w.x = (unsigned)__builtin_amdgcn_cvt_pk_fp8_f32(o[2], o[3], (int)w.x, true);
                w.y = (unsigned)__builtin_amdgcn_cvt_pk_fp8_f32(o[4], o[5], (int)w.y, false); w.y = (unsigned)__builtin_amdgcn_cvt_pk_fp8_f32(o[6], o[7], (int)w.y, true);
                *(u32x2*)(base + (size_t)row * ldact + u.pn * 128 + wc * 32 + fq * 8) = w;
            }
    }
};
struct EpiMoeDown {
    bf16_t* Y; const int* TOK; const float* GATE; float wscale;
    __device__ __forceinline__ void operator()(const f32x4 (&acc)[2][2][4][2], const Unit& u, int wr, int wc, int fr, int fq) const {
#pragma unroll
        for (int ai = 0; ai < 2; ++ai)
#pragma unroll
            for (int m = 0; m < 4; ++m) {
                const int rloc = ai * 128 + wr * 64 + m * 16 + fr;
                if (rloc < u.rows) {
                    const int gi = u.grp * NT + u.pm * 256 + rloc; const int t2 = TOK[gi]; const float gt = GATE[gi] * wscale;
                    bf16_t* dst = Y + ((size_t)(t2 & 1) * NT + (size_t)(t2 >> 1)) * D + u.pn * 256 + wc * 32 + fq * 8;
#pragma unroll
                    for (int bj = 0; bj < 2; ++bj) { const f32x4 v0 = acc[ai][bj][m][0] * gt, v1 = acc[ai][bj][m][1] * gt;
                        u32x4 w; w.x = cvt_pk_bf16(v0[0], v0[1]); w.y = cvt_pk_bf16(v0[2], v0[3]); w.z = cvt_pk_bf16(v1[0], v1[1]); w.w = cvt_pk_bf16(v1[2], v1[3]);
                        *(u32x4*)(dst + bj * 128) = w; }
                }
            }
    }
};

struct Frame {
    LAS unsigned char* lds; int tid, lane, wave, G, bid, wv;
    float* out; unsigned char* ws;
};
struct Params { const float* in[14]; float* out; unsigned char* ws; int ph_lo, ph_hi; };

struct RJob { const float* src; unsigned char* dst; const float* ks; int srcld, pitch, fmt, F, n0, kbyte; };
__device__ __forceinline__ RJob rj_make(int r, const float* src, int srcld, int K, int col_begin, int ncols, void* dst, int F, const float* kscale, int f8 = 0, int pitch8 = 0) {
    const int nn = ncols / 256, kb = r / nn, nb = r - kb * nn, k0 = kb * 128;
    RJob t; t.src = src + (size_t)k0 * srcld + col_begin + nb * 256; t.ks = kscale ? kscale + k0 : nullptr; t.srcld = srcld; t.dst = (unsigned char*)dst; t.F = F; t.n0 = nb * 256;
    if (f8) { t.pitch = pitch8; t.fmt = (f8 == 2 && kb == K / 128 - 1) ? 2 : 1; t.kbyte = k0; } else { t.pitch = K * 2; t.fmt = 0; t.kbyte = k0 * 2; }
    return t;
}
constexpr int IT_A = 256 * 4 + 704 + 352, IT_B = 32 + 1408 + 704;
__device__ __forceinline__ RJob conv_item_A(const Params& PA, unsigned char* ws, int l, int r) {
    const float* w_in = PA.in[1] + (size_t)l * D * 12288; const float* gm = PA.in[11] + (size_t)(2 * l) * D; const float* gf = PA.in[12] + (size_t)(2 * l) * D;
    bf16_t* WQKG = (bf16_t*)(ws + WS_WQKG + l * SZ_WQKG); bf16_t* WVT = (bf16_t*)(ws + WS_WVT + l * SZ_WVT);
    const int p8 = (PROJ8 >> l) & 1;
    if (r < 256) return rj_make(r, w_in, 12288, D, 0, 4096, WQKG, 0, gm, p8, D); r -= 256;
    if (r < 256) return rj_make(r, w_in, 12288, D, 8192, 4096, (unsigned char*)WQKG + (size_t)4096 * D * (p8 ? 1 : 2), 0, gm, p8, D); r -= 256;
    if (r < 256) return rj_make(r, w_in, 12288, D, 4096, 4096, WVT, 0, gm, p8, D); r -= 256;
    if (r < 256) return rj_make(r, PA.in[3] + (size_t)l * VW * D, D, VW, 0, D, (bf16_t*)(ws + WS_WOUT + l * SZ_WOUT), 0, nullptr, p8, VW); r -= 256;
    const float* gu = PA.in[6] + (size_t)l * D * 2 * FF; bf16_t* WGU = (bf16_t*)(ws + WS_WGU + l * SZ_WGU); const int d8 = (DENSE8 >> l) & 1;
    if (r < 704) return rj_make(r, gu, 2 * FF, D, 0, 2 * FF, WGU, FF, gf, d8, D); r -= 704;
    return rj_make(r, PA.in[7] + (size_t)l * FF * D, D, FF, 0, D, (bf16_t*)(ws + WS_WDN + l * SZ_WDN), 0, nullptr, d8, FF);
}
__device__ __forceinline__ RJob conv_item_B(const Params& PA, unsigned char* ws, int l, int r) {
    if (r < 32) { const int g = r >> 3; return rj_make(r & 7, PA.in[4] + ((size_t)l * 4 + g) * 512 * 512, 512, 512, 0, 512, (bf16_t*)(ws + WS_WPOOL + l * SZ_WPOOL) + (size_t)g * 512 * 512, 0, PA.in[11] + (size_t)(2 * l + 1) * D + g * 512); } r -= 32;
    const int f8 = (F8MASK >> l) & 1;
    if (r < 1408) { const int e = r / 176; unsigned char* d = ws + WS_WMGU + l * SZ_WMGU + (size_t)e * 2 * FE * D * (f8 ? 1 : 2); return rj_make(r % 176, PA.in[9] + ((size_t)l * NE + e) * D * 2 * FE, 2 * FE, D, 0, 2 * FE, d, FE, nullptr, f8, D); } r -= 1408;
    { const int e = r / 88; unsigned char* d = ws + WS_WMDN + l * SZ_WMDN + (size_t)e * D * (f8 ? FE8 : FE * 2); return rj_make(r % 88, PA.in[10] + ((size_t)l * NE + e) * FE * D, D, FE, 0, D, d, 0, nullptr, f8 ? 2 : 0, FE8); }
}
__device__ __forceinline__ int conv_batch_size(int b) { return b == 0 ? (IT_A - ((I8A1 & 1) ? 768 : 0) - ((I8A4 & 1) ? 704 : 0)) : b == 1 ? ((I8B4 & 1) ? 32 : 1440) : b == 2 ? (704 + 1024 - ((I8A1 & 2) ? 768 : 0)) : b == 3 ? (1056 + 32 + 704) : ((I8B4 & 2) ? 0 : 1408); }
__device__ __forceinline__ RJob conv_batch_item(const Params& PA, unsigned char* ws, int b, int r) {
    if (b == 0) { if (I8A1 & 1) r += 768; if ((I8A4 & 1) && r >= 1024) r += 704; return conv_item_A(PA, ws, 0, r); }
    if (b == 1) return conv_item_B(PA, ws, 0, r);
    if (b == 2) { if (r < 704) return conv_item_B(PA, ws, 0, 1440 + r); return conv_item_A(PA, ws, 1, r - 704 + ((I8A1 & 2) ? 768 : 0)); }
    if (b == 3) { if (r < 1056) return conv_item_A(PA, ws, 1, 1024 + r); if (r < 1056 + 32) return conv_item_B(PA, ws, 1, r - 1056); return conv_item_B(PA, ws, 1, 1440 + (r - 1056 - 32)); }
    return conv_item_B(PA, ws, 1, 32 + r);
}
template <bool DYN>
__device__ __forceinline__ void tile_loop(Frame& F_, const Params& PA, int b, int first, int step) {
    Frame F = F_; { int t_ = mk_tid(F_.wv); asm volatile("" : "+v"(t_)); F.tid = t_; F.lane = t_ & 63; F.wave = __builtin_amdgcn_readfirstlane(t_ >> 6); }
    LAS unsigned char* IMG = F.lds;
    volatile LAS unsigned* slot = (volatile LAS unsigned*)(F.lds + MISC_OFF + 512);
    unsigned* q = (unsigned*)(F.ws + WS_CTL) + CW_Q + 512 * b;
    const int n = conv_batch_size(b), lane = F.lane, w = F.wave;
    int jb = first;
    if (DYN) { if (F.tid == 0) slot[0] = __hip_atomic_fetch_add(q, 1u, __ATOMIC_RELAXED, __HIP_MEMORY_SCOPE_AGENT);
        __syncthreads(); jb = (int)slot[0]; __syncthreads(); }
    if (jb >= n) return;
    RJob J = conv_batch_item(PA, F.ws, b, jb);
    u32x4 v[16];
#define TJ_ISSUE(JJ, LIVE) do { const __amdgpu_buffer_rsrc_t rs_ = __builtin_amdgcn_make_buffer_rsrc((void*)(JJ).src, 0, (LIVE) ? (127 * (JJ).srcld + 256) * 4 : 0, 0x00020000);     \
        _Pragma("unroll") for (int it = 0; it < 16; ++it) v[it] = __builtin_amdgcn_raw_buffer_load_b128(rs_, lane * 16, (16 * w + it) * (JJ).srcld * 4, 0); } while (0)
    TJ_ISSUE(J, true);
    for (;;) {
        const int es = J.fmt ? 1 : 2, PITCH = 128 * es + 16;
        {
            float g[16];
#pragma unroll
            for (int it = 0; it < 16; ++it) g[it] = (J.fmt ? 32.0f : 1.0f) * (J.ks ? J.ks[16 * w + it] : 1.0f);
#pragma unroll
            for (int c = 0; c < 4; ++c) { LAS unsigned char* p = IMG + (64 * c + lane) * PITCH + 16 * w * es;
                if (J.fmt == 0) { u32x4 o0, o1;
#define TJ_F(i) (__builtin_bit_cast(f32x4, v[i])[c] * g[i])
                    o0.x = cvt_pk_bf16(TJ_F(0), TJ_F(1)); o0.y = cvt_pk_bf16(TJ_F(2), TJ_F(3)); o0.z = cvt_pk_bf16(TJ_F(4), TJ_F(5)); o0.w = cvt_pk_bf16(TJ_F(6), TJ_F(7));
                    o1.x = cvt_pk_bf16(TJ_F(8), TJ_F(9)); o1.y = cvt_pk_bf16(TJ_F(10), TJ_F(11)); o1.z = cvt_pk_bf16(TJ_F(12), TJ_F(13)); o1.w = cvt_pk_bf16(TJ_F(14), TJ_F(15));
                    *(LAS u32x4*)p = o0; *(LAS u32x4*)(p + 16) = o1;
                } else { int x[4];
#pragma unroll
                    for (int qd = 0; qd < 4; ++qd) { int y = 0; y = __builtin_amdgcn_cvt_pk_fp8_f32(TJ_F(4 * qd), TJ_F(4 * qd + 1), y, false); y = __builtin_amdgcn_cvt_pk_fp8_f32(TJ_F(4 * qd + 2), TJ_F(4 * qd + 3), y, true); x[qd] = y; }
                    *(LAS u32x4*)p = (u32x4){(unsigned)x[0], (unsigned)x[1], (unsigned)x[2], (unsigned)x[3]}; }
#undef TJ_F
            }
        }
        if (DYN) { if (F.tid == 0) slot[0] = __hip_atomic_fetch_add(q, 1u, __ATOMIC_RELAXED, __HIP_MEMORY_SCOPE_AGENT); }
        LDS_WAIT(); __syncthreads();
        const int nx = DYN ? (int)slot[0] : jb + step;
        const bool has = nx < n;
        const RJob Jn = conv_batch_item(PA, F.ws, b, has ? nx : jb);
        TJ_ISSUE(Jn, has);
        {
            const int lpr = 8 * es, rpi = 64 / lpr, pc = lane & (lpr - 1), rr = lane / lpr;
            for (int i = 0; i < 32 / rpi; ++i) { const int sl = w * 32 + i * rpi + rr, nn = J.n0 + (sl & 63) * 4 + (sl >> 6);
                int row = nn; if (J.F) { const int part = nn >= J.F ? 1 : 0, j = nn - part * J.F; row = 256 * (j >> 7) + (j & 127) + 128 * part; }
                const u32x4 d = *(const LAS u32x4*)(IMG + sl * PITCH + 16 * pc);
                unsigned char* o = J.dst + (size_t)row * J.pitch + J.kbyte + 16 * pc;
                *(u32x4*)o = d; if (J.fmt == 2) *(u32x4*)(o + 128) = (u32x4){0u, 0u, 0u, 0u}; }
        }
        LDS_WAIT(); __syncthreads();
        if (!has) break;
        J = Jn; jb = nx;
    }
#undef TJ_ISSUE
}
__device__ __forceinline__ int pack_i8x4(f32x4 v) {
    const int a = (int)rintf(v[0]), b = (int)rintf(v[1]), c = (int)rintf(v[2]), d = (int)rintf(v[3]);
    return (a & 0xff) | ((b & 0xff) << 8) | ((c & 0xff) << 16) | (d << 24);
}
__device__ __forceinline__ float wave_max(float v) {
#pragma unroll
    for (int o = 1; o < 64; o <<= 1) v = fmaxf(v, __shfl_xor(v, o));
    return v;
}
struct StripJob { const float* src; const float* ks; unsigned char* dst; float* sw; int srcld; };
__device__ __forceinline__ StripJob strip_make(const Params& PA, unsigned char* ws, int l, int st) {
    StripJob J;
    if (st < 384) { const int c0 = st * 32; J.srcld = 12288; J.src = PA.in[1] + (size_t)l * D * 12288 + c0; J.ks = PA.in[11] + (size_t)(2 * l) * D;
        J.dst = c0 < 4096 ? ws + WS_WQKG + l * SZ_WQKG + (size_t)c0 * D : (c0 < 8192 ? ws + WS_WVT + l * SZ_WVT + (size_t)(c0 - 4096) * D : ws + WS_WQKG + l * SZ_WQKG + (size_t)(c0 - 4096) * D);
        J.sw = c0 < 4096 ? (float*)(ws + WS_SWQ + l * SZ_SWL) + c0 : (c0 < 8192 ? (float*)(ws + WS_SWV + l * SZ_SWL) + (c0 - 4096) : (float*)(ws + WS_SWQ + l * SZ_SWL) + (c0 - 4096));
    } else if (st < 736) { const int s4 = st - 384, part = s4 / 176, j0 = (s4 % 176) * 32, drow = 256 * (j0 >> 7) + (j0 & 127) + 128 * part; J.srcld = 2 * FF;
        J.src = PA.in[6] + (size_t)l * D * 2 * FF + part * FF + j0; J.ks = PA.in[12] + (size_t)(2 * l) * D; J.dst = ws + WS_WGU + l * SZ_WGU + (size_t)drow * D; J.sw = (float*)(ws + WS_SWGU + l * SZ_SWL) + drow;
    } else { const int sm = st - 736, e = sm / 88, s4 = sm % 88, part = s4 / 44, j0 = (s4 % 44) * 32, drow = 256 * (j0 >> 7) + (j0 & 127) + 128 * part; J.srcld = 2 * FE;
        J.src = PA.in[9] + ((size_t)l * NE + e) * D * 2 * FE + part * FE + j0; J.ks = nullptr; J.dst = ws + WS_WMGU + l * SZ_WMGU + (size_t)e * 2 * FE * D + (size_t)drow * D; J.sw = (float*)(ws + WS_SWM) + (l * NE + e) * 2 * FE + drow; }
    return J;
}
template <bool DYN>
__device__ __forceinline__ void strip_loop(Frame& F_, const Params& PA, int l, int first, int end, int step, int base, int qi) {
    Frame F = F_; { int t_ = mk_tid(F_.wv); asm volatile("" : "+v"(t_)); F.tid = t_; F.lane = t_ & 63; F.wave = __builtin_amdgcn_readfirstlane(t_ >> 6); }
    constexpr int PITCH = 4104;
    LAS unsigned char* T = F.lds;
    LAS float* smax = (LAS float*)(F.lds + MISC_OFF + 1024);
    LAS float* cfin = smax + 256;
    volatile LAS unsigned* slot = (volatile LAS unsigned*)(F.lds + MISC_OFF + 512);
    unsigned* q = (unsigned*)(F.ws + WS_CTL) + CW_Q + 512 * 5 + 64 * qi;
    const int lane = F.lane, cq = lane & 7, r8 = lane >> 3;
    int st = first;
    if (DYN) { if (F.tid == 0) slot[0] = __hip_atomic_fetch_add(q, 1u, __ATOMIC_RELAXED, __HIP_MEMORY_SCOPE_AGENT);
        __syncthreads(); st = (int)slot[0]; __syncthreads(); }
    if (st >= end) return;
    StripJob J = strip_make(PA, F.ws, l, base + st);
    u32x4 va[16], vb[16]; float gq[4];
#define W8_ISSUE(JJ, LIVE) do { const __amdgpu_buffer_rsrc_t rs_ = __builtin_amdgcn_make_buffer_rsrc((void*)(JJ).src, 0, (LIVE) ? (D - 1) * (JJ).srcld * 4 + 128 : 0, 0x00020000);     \
        const int voff_ = (r8 * (JJ).srcld + 4 * cq) * 4, sbase_ = F.wave * 256 * (JJ).srcld * 4, sstep_ = 8 * (JJ).srcld * 4; \
        { const float* ksp_ = (JJ).ks ? (JJ).ks : PA.in[11]; const float one_ = (JJ).ks ? 0.0f : 1.0f, keep_ = (JJ).ks ? 1.0f : 0.0f;     \
          _Pragma("unroll") for (int t = 0; t < 4; ++t) gq[t] = ksp_[F.wave * 256 + t * 64 + lane] * keep_ + one_; } \
        _Pragma("unroll") for (int it = 0; it < 16; ++it) va[it] = __builtin_amdgcn_raw_buffer_load_b128(rs_, voff_, sbase_ + it * sstep_, 0); \
        _Pragma("unroll") for (int it = 0; it < 16; ++it) vb[it] = __builtin_amdgcn_raw_buffer_load_b128(rs_, voff_, sbase_ + (16 + it) * sstep_, 0); } while (0)
    W8_ISSUE(J, true);
    for (;;) {
        f32x4 cm = (f32x4){0.f, 0.f, 0.f, 0.f};
#pragma unroll
        for (int ch = 0; ch < 2; ++ch)
#pragma unroll
            for (int it = 0; it < 16; ++it) { const int j = ch * 16 + it, kk = F.wave * 256 + j * 8 + r8;
                const float g = __shfl(gq[j >> 3], (j & 7) * 8 + r8);
                const f32x4 w = __builtin_bit_cast(f32x4, ch ? vb[it] : va[it]) * g;
                cm[0] = fmaxf(cm[0], fabsf(w[0])); cm[1] = fmaxf(cm[1], fabsf(w[1])); cm[2] = fmaxf(cm[2], fabsf(w[2])); cm[3] = fmaxf(cm[3], fabsf(w[3]));
                const unsigned p01 = cvt_pk_bf16(w[0], w[1]), p23 = cvt_pk_bf16(w[2], w[3]);
                LAS unsigned short* p = (LAS unsigned short*)(T + (4 * cq) * PITCH + kk * 2);
                p[0] = (unsigned short)p01; p[PITCH / 2] = (unsigned short)(p01 >> 16); p[PITCH] = (unsigned short)p23; p[3 * PITCH / 2] = (unsigned short)(p23 >> 16); }
        if (DYN) { if (F.tid == 0) slot[0] = __hip_atomic_fetch_add(q, 1u, __ATOMIC_RELAXED, __HIP_MEMORY_SCOPE_AGENT); }
#pragma unroll
        for (int j = 0; j < 4; ++j) { cm[j] = fmaxf(cm[j], __shfl_xor(cm[j], 8)); cm[j] = fmaxf(cm[j], __shfl_xor(cm[j], 16)); cm[j] = fmaxf(cm[j], __shfl_xor(cm[j], 32)); }
        if (lane < 8) { LAS float* p = smax + F.wave * 32 + lane * 4; p[0] = cm[0]; p[1] = cm[1]; p[2] = cm[2]; p[3] = cm[3]; }
        LDS_WAIT(); __syncthreads();
        const int nx = DYN ? (int)slot[0] : st + step;
        const bool has = nx < end;
        const StripJob Jn = strip_make(PA, F.ws, l, base + (has ? nx : st));
        W8_ISSUE(Jn, has);
        if (F.tid < 32) { float m = 1e-30f;
#pragma unroll
            for (int w = 0; w < 8; ++w) m = fmaxf(m, smax[w * 32 + F.tid]);
            cfin[F.tid] = m; J.sw[F.tid] = m * (1.0f / 127.0f); }
        LDS_WAIT(); __syncthreads();
#pragma unroll
        for (int rr = 0; rr < 4; ++rr) { const int c = F.wave * 4 + rr; const float qs = 127.0f / cfin[c];
#pragma unroll
            for (int i = 0; i < 4; ++i) { const int k0 = (i * 64 + lane) * 8;
                const u32x2 a = *(const LAS u32x2*)(T + c * PITCH + k0 * 2), b = *(const LAS u32x2*)(T + c * PITCH + k0 * 2 + 8);
                u32x2 o; o.x = (unsigned)pack_i8x4(bf4(a) * qs); o.y = (unsigned)pack_i8x4(bf4(b) * qs);
                *(u32x2*)(J.dst + (size_t)c * D + k0) = o; } }
        LDS_WAIT(); __syncthreads();
        if (!has) break;
        J = Jn; st = nx;
    }
#undef W8_ISSUE
}
__device__ __forceinline__ void p0_row(const int lane, const int row, const f32x4 (&v)[8], bf16_t* X, bf16_t* XB, float* SA) {
    float s = 0.f;
#pragma unroll
    for (int j = 0; j < 8; ++j) s += (v[j][0] * v[j][0] + v[j][1] * v[j][1]) + (v[j][2] * v[j][2] + v[j][3] * v[j][3]);
    const float inv = 1.0f / sqrtf(wave_sum(s) * (1.0f / D) + EPS);
    if (I8A1 & 1) {
        float mx = 0.f;
#pragma unroll
        for (int j = 0; j < 8; ++j) mx = fmaxf(mx, fmaxf(fmaxf(fabsf(v[j][0]), fabsf(v[j][1])), fmaxf(fabsf(v[j][2]), fabsf(v[j][3]))));
        mx = fmaxf(wave_max(mx) * inv, 1e-20f); const float q = inv * 127.0f / mx;
#pragma unroll
        for (int j = 0; j < 8; ++j) { { u32x2 w; w.x = cvt_pk_bf16(v[j][0], v[j][1]); w.y = cvt_pk_bf16(v[j][2], v[j][3]); ((u32x2*)(X + (size_t)row * D) + lane)[64 * j] = w; }
            ((int*)((unsigned char*)XB + (size_t)row * D) + lane)[64 * j] = pack_i8x4(v[j] * q); }
        if (lane == 0) SA[row] = mx * (1.0f / 127.0f);
    } else {
#pragma unroll
        for (int j = 0; j < 8; ++j) { { u32x2 w; w.x = cvt_pk_bf16(v[j][0], v[j][1]); w.y = cvt_pk_bf16(v[j][2], v[j][3]); ((u32x2*)(X + (size_t)row * D) + lane)[64 * j] = w; }
            u32x2 w; w.x = cvt_pk_bf16(v[j][0] * inv, v[j][1] * inv); w.y = cvt_pk_bf16(v[j][2] * inv, v[j][3] * inv); ((u32x2*)(XB + (size_t)row * D) + lane)[64 * j] = w; }
    }
}
__device__ __forceinline__ void p0_prologue(Frame& F_, const Params& PA) {
    Frame F = F_; { int t_ = mk_tid(F_.wv); asm volatile("" : "+v"(t_)); F.tid = t_; F.lane = t_ & 63; F.wave = __builtin_amdgcn_readfirstlane(t_ >> 6); }
    unsigned char* ws = F.ws;
    const int gw = F.bid * 8 + F.wave, NGW = F.G * 8;
    {
        const int n1 = (I8A1 & 1) ? 384 : 0, n4 = (I8A4 & 1) ? 352 : 0;
        if (n1 + n4 > 0) strip_loop<false>(F_, PA, 0, F.bid, n1 + n4, F.G, (I8A1 & 1) ? 0 : 384, 0);
    }
    tile_loop<false>(F_, PA, 0, F.bid, F.G);
    bf16_t* X = (bf16_t*)(ws + WS_X); bf16_t* XB = (bf16_t*)(ws + WS_XB);
#define P0_LOAD(V, row_) do { const f32x4* xr_ = (const f32x4*)(PA.in[0] + (size_t)(row_) * D) + F.lane; _Pragma("unroll") for (int j = 0; j < 8; ++j) V[j] = xr_[64 * j]; } while (0)
    {
        int row = gw; f32x4 va[8], vb[8];
        if (row < NT) { P0_LOAD(va, row);
            for (;;) {
                int nrow = row + NGW; bool has = nrow < NT;
                if (has) P0_LOAD(vb, nrow);
                p0_row(F.lane, row, va, X, XB, (float*)(ws + WS_SA));
                if (!has) break;
                row = nrow; nrow = row + NGW; has = nrow < NT;
                if (has) P0_LOAD(va, nrow);
                p0_row(F.lane, row, vb, X, XB, (float*)(ws + WS_SA));
                if (!has) break;
                row = nrow;
            } }
    }
#undef P0_LOAD
    float* COS = (float*)(ws + WS_COS); float* SIN = (float*)(ws + WS_SIN);
    for (int i = F.bid * 512 + F.tid; i < SEQ * 128; i += F.G * 512) { const int pos = i >> 7, p = i & 127;
        const float t = (float)p / 127.0f; const float fr = 1.0f / powf(10000.0f, t); const float ang = (float)pos * fr;
        COS[i] = (float)cos((double)ang); SIN[i] = (float)sin((double)ang); }
    if (F.bid == 0) { float* DQ = (float*)(ws + WS_DQ); float* DKS = (float*)(ws + WS_DKS);
        for (int i = F.tid; i < NH * 128; i += 512) { const int h = i >> 7, j = i & 127; const double lg = log1p(-exp2(-5.0 - (double)h));
            DQ[i] = (float)exp((double)j * lg); DKS[i] = (float)(exp(-(double)j * lg) * 0.0625);
            ((float*)(ws + WS_DQ8))[i] = (float)exp((double)(j - 64) * lg); ((float*)(ws + WS_DKS8))[i] = (float)(exp((double)(64 - j) * lg) * 0.0625); if (j == 0) ((float*)(ws + WS_LG2))[h] = (float)(lg * 1.4426950408889634); } }
}

__device__ __forceinline__ void retention_phase(Frame& F, const bf16_t* QB, const bf16_t* KB, const bf16_t* VT, const bf16_t* GB, const float* normg, bf16_t* OG, const int og8) {
    using namespace pg8;
    LAS unsigned char* lds = F.lds;
    int tid = mk_tid(F.wv); asm volatile("" : "+v"(tid));
    const int wid = __builtin_amdgcn_readfirstlane(tid >> 6), lane = tid & 63, wr = wid >> 2, wc = wid & 3;
    unsigned voffQ[2], voffV[2];
#pragma unroll
    for (int i = 0; i < 2; ++i) { int R, C; stage_rc(tid * 16 + i * 8192, R, C); const int Rb = (R & ~31) + perm32(R & 31);
        voffQ[i] = (unsigned)(R * QKW + C) * 2u; voffV[i] = (unsigned)(Rb * NT + C) * 2u; }
    const unsigned ldsw = (unsigned)wid * 1024u;
    const int aoff = lds_byte(wr * 64 + (lane & 15), (lane >> 4) * 8), boff = lds_byte(wc * 32 + (lane & 15), (lane >> 4) * 8);
    constexpr int PIMG = 6 * HTB;
    LAS float* red = (LAS float*)(lds + MISC_OFF + 256);
    const __amdgpu_buffer_rsrc_t rsQ = __builtin_amdgcn_make_buffer_rsrc((void*)QB, 0, NT * QKW * 2, 0x00020000);
    const __amdgpu_buffer_rsrc_t rsK = __builtin_amdgcn_make_buffer_rsrc((void*)KB, 0, NT * QKW * 2, 0x00020000);
    const __amdgpu_buffer_rsrc_t rsV = __builtin_amdgcn_make_buffer_rsrc((void*)VT, 0, VW * NT * 2, 0x00020000);
#define RT_STAGE(bufoff, rsrc, soff, voff) do { _Pragma("unroll") for (int _i = 0; _i < 2; ++_i) \
        __builtin_amdgcn_raw_ptr_buffer_load_lds((rsrc), (LAS unsigned*)(lds + (bufoff) + ldsw + _i * 8192), 16, (voff)[_i], (soff), 0, 0); } while (0)
#define RT_BAR __builtin_amdgcn_s_barrier()
    for (int it = F.bid; it < 256; it += F.G) {
        const int item = (it & 7) * 32 + (it >> 3);
        const int b = item >> 6, h = (item >> 3) & 7, x = item & 7;
        const float lg2 = ((const float*)(F.ws + WS_LG2))[h];
        const int koff = (b * SEQ * QKW + h * DK) * 2, voff0 = (h * DV * NT + b * SEQ) * 2;
        for (int qs = 0; qs < 2; ++qs) {
            const int qc = qs == 0 ? 15 - x : x, nkv = qc + 1, total = 8 * nkv;
            const int qoff = ((b * SEQ + qc * 128) * QKW + h * DK) * 2;
            f32x4 O[4][4][2], P[4][2];
#pragma unroll
            for (int c = 0; c < 4; ++c)
#pragma unroll
                for (int m = 0; m < 4; ++m)
#pragma unroll
                    for (int n = 0; n < 2; ++n) O[c][m][n] = (f32x4){0.f, 0.f, 0.f, 0.f};
#define RT_STAGE_STEP(sv) do { const int _s = (sv); const int _kt = _s >> 3, _sub = _s & 7, _bo = (_s % 3) * 2 * HTB; \
                if (_sub < 4) { RT_STAGE(_bo, rsQ, qoff + _sub * 128, voffQ); RT_STAGE(_bo + HTB, rsK, koff + _kt * (128 * QKW * 2) + _sub * 128, voffQ); } \
                else { const int _vo = voff0 + (_sub - 4) * (128 * NT * 2) + _kt * 256; RT_STAGE(_bo, rsV, _vo, voffV); RT_STAGE(_bo + HTB, rsV, _vo + 128, voffV); } } while (0)
            RT_STAGE_STEP(0); RT_STAGE_STEP(1);
            asm volatile("s_waitcnt vmcnt(4)" ::: "memory"); RT_BAR;
            int s = 0;
            for (int kt = 0; kt < nkv; ++kt) {
                const float tscale = __builtin_amdgcn_exp2f((float)(128 * (qc - kt)) * lg2);
                const bool diag = (kt == qc);
#pragma unroll
                for (int sub = 0; sub < 8; ++sub, ++s) {
                    __builtin_amdgcn_sched_barrier(0);
                    if (s + 2 < total) RT_STAGE_STEP(s + 2);
                    const int bo = (s % 3) * 2 * HTB;
                    if (sub < 4) {
                        if (sub == 0) {
#pragma unroll
                            for (int m = 0; m < 4; ++m)
#pragma unroll
                                for (int n = 0; n < 2; ++n) P[m][n] = (f32x4){0.f, 0.f, 0.f, 0.f};
                        }
                        bf16x8 Bt[2][2];
#pragma unroll
                        for (int n = 0; n < 2; ++n)
#pragma unroll
                            for (int k = 0; k < 2; ++k) Bt[n][k] = *(const LAS bf16x8*)(lds + bo + HTB + boff + n * 2048 + k * 1024);
#pragma unroll
                        for (int mh = 0; mh < 2; ++mh) {
                            bf16x8 At[2][2];
#pragma unroll
                            for (int m = 0; m < 2; ++m)
#pragma unroll
                                for (int k = 0; k < 2; ++k) At[m][k] = *(const LAS bf16x8*)(lds + bo + aoff + (mh * 2 + m) * 2048 + k * 1024);
#pragma unroll
                            for (int m = 0; m < 2; ++m)
#pragma unroll
                                for (int n = 0; n < 2; ++n)
#pragma unroll
                                    for (int k = 0; k < 2; ++k) P[mh * 2 + m][n] = __builtin_amdgcn_mfma_f32_16x16x32_bf16(Bt[n][k], At[m][k], P[mh * 2 + m][n], 0, 0, 0);
                            __builtin_amdgcn_sched_barrier(0);
                        }
                        if (sub == 3) {
                            int ln = lane; asm volatile("" : "+v"(ln)); const int fr = ln & 15, fq = ln >> 4;
#pragma unroll
                            for (int m = 0; m < 4; ++m) { const int i = wr * 64 + m * 16 + fr;
#pragma unroll
                                for (int n = 0; n < 2; ++n) { const int j0 = wc * 32 + n * 16 + fq * 4; f32x4 v = P[m][n] * tscale;
                                    if (diag) { int dd = i - j0; asm volatile("" : "+v"(dd));
#pragma unroll
                                        for (int e = 0; e < 4; ++e) v[e] = (e > dd) ? 0.f : v[e]; }
                                    u32x2 w; w.x = cvt_pk_bf16(v[0], v[1]); w.y = cvt_pk_bf16(v[2], v[3]);
                                    *(LAS u32x2*)(lds + PIMG + (wc >> 1) * HTB + lds_byte(i, (wc & 1) * 32 + n * 16 + fq * 4)) = w; } }
                        }
                    } else {
#pragma unroll
                        for (int k2 = 0; k2 < 2; ++k2) {
                            bf16x8 Bt[2][2];
#pragma unroll
                            for (int n = 0; n < 2; ++n)
#pragma unroll
                                for (int k = 0; k < 2; ++k) Bt[n][k] = *(const LAS bf16x8*)(lds + bo + k2 * HTB + boff + n * 2048 + k * 1024);
#pragma unroll
                            for (int mh = 0; mh < 2; ++mh) {
                                bf16x8 At[2][2];
#pragma unroll
                                for (int m = 0; m < 2; ++m)
#pragma unroll
                                    for (int k = 0; k < 2; ++k) At[m][k] = *(const LAS bf16x8*)(lds + PIMG + k2 * HTB + aoff + (mh * 2 + m) * 2048 + k * 1024);
#pragma unroll
                                for (int m = 0; m < 2; ++m)
#pragma unroll
                                    for (int n = 0; n < 2; ++n)
#pragma unroll
                                        for (int k = 0; k < 2; ++k) O[sub - 4][mh * 2 + m][n] = __builtin_amdgcn_mfma_f32_16x16x32_bf16(Bt[n][k], At[m][k], O[sub - 4][mh * 2 + m][n], 0, 0, 0);
                                __builtin_amdgcn_sched_barrier(0);
                            }
                        }
                    }
                    if (s + 2 < total) asm volatile("s_waitcnt vmcnt(4) lgkmcnt(0)" ::: "memory"); else asm volatile("s_waitcnt vmcnt(0) lgkmcnt(0)" ::: "memory");
                    RT_BAR;
                }
            }
            int ln = lane; asm volatile("" : "+v"(ln)); const int fr = ln & 15, fq = ln >> 4;
#pragma unroll
            for (int m = 0; m < 4; ++m) { float ss = 0.f;
#pragma unroll
                for (int c = 0; c < 4; ++c)
#pragma unroll
                    for (int n = 0; n < 2; ++n) { const f32x4 o = O[c][m][n]; ss += (o[0] * o[0] + o[1] * o[1]) + (o[2] * o[2] + o[3] * o[3]); }
                ss += __shfl_xor(ss, 16); ss += __shfl_xor(ss, 32);
                if (fq == 0) red[(wr * 64 + m * 16 + fr) * 4 + wc] = ss; }
            LDS_WAIT(); RT_BAR;
#pragma unroll
            for (int m = 0; m < 4; ++m) { const int i = wr * 64 + m * 16 + fr; const f32x4 pr = *(const LAS f32x4*)(red + i * 4);
                const float inv = __builtin_amdgcn_rsqf(((pr[0] + pr[1]) + (pr[2] + pr[3])) * (1.0f / DV) + EPS);
                const size_t tok = (size_t)b * SEQ + (size_t)qc * 128 + i;
#pragma unroll
                for (int c = 0; c < 4; ++c) { const int col = h * DV + c * 128 + wc * 32 + fq * 8;
                    const u32x4 gw = *(const u32x4*)(GB + tok * VW + col); const f32x4 n0 = *(const f32x4*)(normg + col), n1 = *(const f32x4*)(normg + col + 4);
                    const f32x4 o0 = O[c][m][0] * inv * n0, o1 = O[c][m][1] * inv * n1;
                    float gv[8] = {bf_lo(gw.x), bf_hi(gw.x), bf_lo(gw.y), bf_hi(gw.y), bf_lo(gw.z), bf_hi(gw.z), bf_lo(gw.w), bf_hi(gw.w)};
                    float r[8];
#pragma unroll
                    for (int e = 0; e < 4; ++e) { r[e] = o0[e] * gv[e] * fast_sigmoid(gv[e]); r[4 + e] = o1[e] * gv[4 + e] * fast_sigmoid(gv[4 + e]); }
                    if (og8) { int w0 = 0, w1 = 0; w0 = __builtin_amdgcn_cvt_pk_fp8_f32(r[0], r[1], w0, false); w0 = __builtin_amdgcn_cvt_pk_fp8_f32(r[2], r[3], w0, true);
                        w1 = __builtin_amdgcn_cvt_pk_fp8_f32(r[4], r[5], w1, false); w1 = __builtin_amdgcn_cvt_pk_fp8_f32(r[6], r[7], w1, true); u32x2 w; w.x = (unsigned)w0; w.y = (unsigned)w1;
                        *(u32x2*)((unsigned char*)OG + tok * VW + col) = w; }
                    else { u32x4 w; w.x = cvt_pk_bf16(r[0], r[1]); w.y = cvt_pk_bf16(r[2], r[3]); w.z = cvt_pk_bf16(r[4], r[5]); w.w = cvt_pk_bf16(r[6], r[7]);
                        *(u32x4*)(OG + tok * VW + col) = w; } } }
            VM_WAIT(); RT_BAR;
        }
    }
#undef RT_STAGE
#undef RT_STAGE_STEP
#undef RT_BAR
}

__device__ __forceinline__ void mfma8(f32x4& c, const i32x8& a, const i32x8& b, int sc) { asm volatile("v_mfma_scale_f32_16x16x128_f8f6f4 %0, %1, %2, %0, %3, %3 op_sel_hi:[0,0,0]" : "+v"(c) : "v"(a), "v"(b), "v"(sc)); }
__device__ __forceinline__ void retention8_phase(Frame& F, const unsigned char* Q8, const unsigned char* K8, const unsigned char* VT8, const bf16_t* GB, const float* normg, bf16_t* OG, const int og8) {
    using namespace pg8;
    LAS unsigned char* lds = F.lds;
    int tid = mk_tid(F.wv); asm volatile("" : "+v"(tid));
    const int wid = __builtin_amdgcn_readfirstlane(tid >> 6), lane = tid & 63, wr = wid >> 2, wc = wid & 3;
    unsigned voffQ[2], voffV[2];
#pragma unroll
    for (int i = 0; i < 2; ++i) { int R, C; stage_rc(tid * 16 + i * 8192, R, C); const int Rb = (R & ~31) + perm32(R & 31);
        voffQ[i] = (unsigned)(R * QKW + C * 2); voffV[i] = (unsigned)(Rb * NT + C * 2); }
    const unsigned ldsw = (unsigned)wid * 1024u;
    const int aoff = lds_byte(wr * 64 + (lane & 15), (lane >> 4) * 8), boff = lds_byte(wc * 32 + (lane & 15), (lane >> 4) * 8);
    constexpr int PIMG = 6 * HTB;
    LAS float* red = (LAS float*)(lds + MISC_OFF + 256);
    int f8scale = 0x7f7f7f7f; asm volatile("" : "+v"(f8scale));
    const __amdgpu_buffer_rsrc_t rsQ = __builtin_amdgcn_make_buffer_rsrc((void*)Q8, 0, NT * QKW, 0x00020000);
    const __amdgpu_buffer_rsrc_t rsK = __builtin_amdgcn_make_buffer_rsrc((void*)K8, 0, NT * QKW, 0x00020000);
    const __amdgpu_buffer_rsrc_t rsV = __builtin_amdgcn_make_buffer_rsrc((void*)VT8, 0, VW * NT, 0x00020000);
#define RT_STAGE(bufoff, rsrc, soff, voff) do { _Pragma("unroll") for (int _i = 0; _i < 2; ++_i) \
        __builtin_amdgcn_raw_ptr_buffer_load_lds((rsrc), (LAS unsigned*)(lds + (bufoff) + ldsw + _i * 8192), 16, (voff)[_i], (soff), 0, 0); } while (0)
#define RT_BAR __builtin_amdgcn_s_barrier()
#define RT_LD16(off) (*(const LAS i32x4*)(lds + (off)))
    for (int it = F.bid; it < 256; it += F.G) {
        const int item = (it & 7) * 32 + (it >> 3);
        const int b = item >> 6, h = (item >> 3) & 7, x = item & 7;
        const float lg2 = ((const float*)(F.ws + WS_LG2))[h];
        const int koff = b * SEQ * QKW + h * DK, voff0 = h * DV * NT + b * SEQ;
        for (int qs = 0; qs < 2; ++qs) {
            const int qc = qs == 0 ? 15 - x : x, nkv = qc + 1, total = 4 * nkv;
            const int qoff = (b * SEQ + qc * 128) * QKW + h * DK;
            f32x4 O[4][4][2], P[4][2]; i32x8 Apf[4];
#pragma unroll
            for (int c = 0; c < 4; ++c)
#pragma unroll
                for (int m = 0; m < 4; ++m)
#pragma unroll
                    for (int n = 0; n < 2; ++n) O[c][m][n] = (f32x4){0.f, 0.f, 0.f, 0.f};
#define RT_STAGE_STEP(sv) do { const int _s = (sv); const int _kt = _s >> 2, _sub = _s & 3, _bo = (_s % 3) * 2 * HTB; \
                if (_sub < 2) { RT_STAGE(_bo, rsQ, qoff + _sub * 128, voffQ); RT_STAGE(_bo + HTB, rsK, koff + _kt * (128 * QKW) + _sub * 128, voffQ); } \
                else { const int _vo = voff0 + (_sub - 2) * (256 * NT) + _kt * 128; RT_STAGE(_bo, rsV, _vo, voffV); RT_STAGE(_bo + HTB, rsV, _vo + 128 * NT, voffV); } } while (0)
            RT_STAGE_STEP(0); RT_STAGE_STEP(1);
            asm volatile("s_waitcnt vmcnt(4)" ::: "memory"); RT_BAR;
            int s = 0;
            for (int kt = 0; kt < nkv; ++kt) {
                const float tscale = __builtin_amdgcn_exp2f((float)(128 * (qc - kt)) * lg2);
                const bool diag = (kt == qc);
#pragma unroll
                for (int sub = 0; sub < 4; ++sub, ++s) {
                    __builtin_amdgcn_sched_barrier(0);
                    if (s + 2 < total) RT_STAGE_STEP(s + 2);
                    const int bo = (s % 3) * 2 * HTB;
                    if (sub < 2) {
                        if (sub == 0) {
#pragma unroll
                            for (int m = 0; m < 4; ++m)
#pragma unroll
                                for (int n = 0; n < 2; ++n) P[m][n] = (f32x4){0.f, 0.f, 0.f, 0.f};
                        }
                        i32x8 Bt[2], At[4];
#pragma unroll
                        for (int n = 0; n < 2; ++n) { Bt[n].lo = RT_LD16(bo + HTB + boff + n * 2048); Bt[n].hi = RT_LD16(bo + HTB + boff + n * 2048 + 1024); }
#pragma unroll
                        for (int m = 0; m < 4; ++m) { At[m].lo = RT_LD16(bo + aoff + m * 2048); At[m].hi = RT_LD16(bo + aoff + m * 2048 + 1024); }
#pragma unroll
                        for (int m = 0; m < 4; ++m)
#pragma unroll
                            for (int n = 0; n < 2; ++n) mfma8(P[m][n], Bt[n], At[m], f8scale);
                        __builtin_amdgcn_sched_barrier(0);
                        if (sub == 1) {
                            asm volatile("s_nop 15\n\ts_nop 7" ::: "memory"); __builtin_amdgcn_sched_barrier(0);
                            int ln = lane; asm volatile("" : "+v"(ln)); const int fr = ln & 15, fq = ln >> 4;
#pragma unroll
                            for (int m = 0; m < 4; ++m) { const int i = wr * 64 + m * 16 + fr;
#pragma unroll
                                for (int n = 0; n < 2; ++n) { const int j0 = wc * 32 + n * 16 + fq * 4; f32x4 v = P[m][n] * tscale;
                                    if (diag) { int dd = i - j0; asm volatile("" : "+v"(dd));
#pragma unroll
                                        for (int e = 0; e < 4; ++e) v[e] = (e > dd) ? 0.f : v[e]; }
                                    int w = 0; w = __builtin_amdgcn_cvt_pk_fp8_f32(v[0], v[1], w, false); w = __builtin_amdgcn_cvt_pk_fp8_f32(v[2], v[3], w, true);
                                    *(LAS int*)(lds + PIMG + lds_byte(i, j0 >> 1)) = w; } }
                        }
                    } else {
                        if (sub == 2) {
#pragma unroll
                            for (int m = 0; m < 4; ++m) { Apf[m].lo = RT_LD16(PIMG + aoff + m * 2048); Apf[m].hi = RT_LD16(PIMG + aoff + m * 2048 + 1024); }
                        }
#pragma unroll
                        for (int ch = 0; ch < 2; ++ch) {
                            i32x8 Bv[2];
#pragma unroll
                            for (int n = 0; n < 2; ++n) { Bv[n].lo = RT_LD16(bo + ch * HTB + boff + n * 2048); Bv[n].hi = RT_LD16(bo + ch * HTB + boff + n * 2048 + 1024); }
#pragma unroll
                            for (int m = 0; m < 4; ++m)
#pragma unroll
                                for (int n = 0; n < 2; ++n) mfma8(O[(sub - 2) * 2 + ch][m][n], Bv[n], Apf[m], f8scale);
                            __builtin_amdgcn_sched_barrier(0);
                        }
                    }
                    if (s + 2 < total) asm volatile("s_waitcnt vmcnt(4) lgkmcnt(0)" ::: "memory"); else asm volatile("s_waitcnt vmcnt(0) lgkmcnt(0)" ::: "memory");
                    RT_BAR;
                }
            }
            asm volatile("s_nop 15\n\ts_nop 7" ::: "memory"); __builtin_amdgcn_sched_barrier(0);
            int ln = lane; asm volatile("" : "+v"(ln)); const int fr = ln & 15, fq = ln >> 4;
#pragma unroll
            for (int m = 0; m < 4; ++m) { float ss = 0.f;
#pragma unroll
                for (int c = 0; c < 4; ++c)
#pragma unroll
                    for (int n = 0; n < 2; ++n) { const f32x4 o = O[c][m][n]; ss += (o[0] * o[0] + o[1] * o[1]) + (o[2] * o[2] + o[3] * o[3]); }
                ss += __shfl_xor(ss, 16); ss += __shfl_xor(ss, 32);
                if (fq == 0) red[(wr * 64 + m * 16 + fr) * 4 + wc] = ss; }
            LDS_WAIT(); RT_BAR;
#pragma unroll
            for (int m = 0; m < 4; ++m) { const int i = wr * 64 + m * 16 + fr; const f32x4 pr = *(const LAS f32x4*)(red + i * 4);
                const float inv = __builtin_amdgcn_rsqf(((pr[0] + pr[1]) + (pr[2] + pr[3])) * (1.0f / DV) + EPS);
                const size_t tok = (size_t)b * SEQ + (size_t)qc * 128 + i;
#pragma unroll
                for (int c = 0; c < 4; ++c) { const int col = h * DV + c * 128 + wc * 32 + fq * 8;
                    const u32x4 gw = *(const u32x4*)(GB + tok * VW + col); const f32x4 n0 = *(const f32x4*)(normg + col), n1 = *(const f32x4*)(normg + col + 4);
                    const f32x4 o0 = O[c][m][0] * inv * n0, o1 = O[c][m][1] * inv * n1;
                    float gv[8] = {bf_lo(gw.x), bf_hi(gw.x), bf_lo(gw.y), bf_hi(gw.y), bf_lo(gw.z), bf_hi(gw.z), bf_lo(gw.w), bf_hi(gw.w)};
                    float r[8];
#pragma unroll
                    for (int e = 0; e < 4; ++e) { r[e] = o0[e] * gv[e] * fast_sigmoid(gv[e]); r[4 + e] = o1[e] * gv[4 + e] * fast_sigmoid(gv[4 + e]); }
                    if (og8) { int w0 = 0, w1 = 0; w0 = __builtin_amdgcn_cvt_pk_fp8_f32(r[0], r[1], w0, false); w0 = __builtin_amdgcn_cvt_pk_fp8_f32(r[2], r[3], w0, true);
                        w1 = __builtin_amdgcn_cvt_pk_fp8_f32(r[4], r[5], w1, false); w1 = __builtin_amdgcn_cvt_pk_fp8_f32(r[6], r[7], w1, true); u32x2 w; w.x = (unsigned)w0; w.y = (unsigned)w1;
                        *(u32x2*)((unsigned char*)OG + tok * VW + col) = w; }
                    else { u32x4 w; w.x = cvt_pk_bf16(r[0], r[1]); w.y = cvt_pk_bf16(r[2], r[3]); w.z = cvt_pk_bf16(r[4], r[5]); w.w = cvt_pk_bf16(r[6], r[7]);
                        *(u32x4*)(OG + tok * VW + col) = w; } } }
            VM_WAIT(); RT_BAR;
        }
    }
#undef RT_STAGE
#undef RT_STAGE_STEP
#undef RT_BAR
#undef RT_LD16
}

template <int W>
__device__ __forceinline__ void pool_rows(const bf16_t* X, const LAS float* rs, bf16_t* MIX, int r0, int s0, int q, int col) {
    f32x4 v[23];
#pragma unroll
    for (int t = 0; t < 23; ++t) { if (t >= 16 - W) { int row = r0 - 15 + 8 * q + t; row = row < 0 ? 0 : row; v[t] = bf4(*(const u32x2*)(X + (size_t)row * D + col)) * rs[8 * q + t]; } }
#pragma unroll
    for (int o = 0; o < 8; ++o) { const int t = 15 + o, s = s0 + 8 * q + o; f32x4 sum = v[t];
#pragma unroll
        for (int d = 1; d < W; ++d) sum = sum + v[t - d];
        const int cnt = (s + 1) < W ? (s + 1) : W; const float ic = 1.0f / (float)cnt;
        const f32x4 mx = sum * ic - v[t];
        u32x2 w; w.x = cvt_pk_bf16(mx[0], mx[1]); w.y = cvt_pk_bf16(mx[2], mx[3]);
        *(u32x2*)(MIX + (size_t)(r0 + 8 * q + o) * D + col) = w; }
}
__device__ __forceinline__ void pool_phase(Frame& F_, const bf16_t* X, const float* ROWSS, bf16_t* MIX) {
    Frame F = F_; { int t_ = mk_tid(F_.wv); asm volatile("" : "+v"(t_)); F.tid = t_; F.lane = t_ & 63; F.wave = __builtin_amdgcn_readfirstlane(t_ >> 6); }
    LAS float* rs = (LAS float*)(F.lds);
    for (int u = F.bid; u < 1024; u += F.G) {
        const int rt = u >> 2, g = u & 3, r0 = rt * 32, s0 = r0 & (SEQ - 1);
        for (int li = F.wave; li < 47; li += 8) { const int s = s0 - 15 + li; int row = r0 - 15 + li; row = row < 0 ? 0 : row;
            float p = (F.lane < 32) ? ROWSS[(size_t)row * 32 + F.lane] : 0.f; p = wave_sum(p);
            if (F.lane == 0) rs[li] = (s >= 0) ? (1.0f / sqrtf(p * (1.0f / D) + EPS)) : 0.f; }
        LDS_WAIT(); __syncthreads();
        const int q = F.tid >> 7, col = g * 512 + (F.tid & 127) * 4;
        if (g == 0) pool_rows<2>(X, rs, MIX, r0, s0, q, col); else if (g == 1) pool_rows<4>(X, rs, MIX, r0, s0, q, col); else if (g == 2) pool_rows<8>(X, rs, MIX, r0, s0, q, col); else pool_rows<16>(X, rs, MIX, r0, s0, q, col);
        __syncthreads();
    }
}

template <int W>
__device__ __forceinline__ void pool_pair(const bf16_t* Z, const LAS float* invt, int li0  , int ra, int sa, int col, f32x4& pa, f32x4& pb) {
    f32x4 S = (f32x4){0.f, 0.f, 0.f, 0.f}, first = S, za = S, zb = S;
#pragma unroll
    for (int k = 0; k <= W; ++k) { int row = ra - W + 1 + k; row = row < 0 ? 0 : row;
        const f32x4 z = bf4(*(const u32x2*)(Z + (size_t)row * D + col)) * invt[li0 - W + 1 + k];
        if (k == 0) first = z; if (k < W) S = S + z; if (k == W - 1) za = z; if (k == W) zb = z; }
    const int ca = (sa + 1) < W ? (sa + 1) : W, cb = (sa + 2) < W ? (sa + 2) : W;
    pa = S * (1.0f / (float)ca) - za; pb = (S - first + zb) * (1.0f / (float)cb) - zb;
}
template <int fp8>
__device__ __forceinline__ void router_phase(Frame& F_, bf16_t* X, const bf16_t* Z, const float* ROWSS, const float* pscale  , const float* router  , const float* gain  , unsigned* counts  , unsigned char* XG, int* TOK, float* GATE, unsigned char* ACTM8, float* SAM) {
    Frame F = F_; { int t_ = mk_tid(F_.wv); asm volatile("" : "+v"(t_)); F.tid = t_; F.lane = t_ & 63; F.wave = __builtin_amdgcn_readfirstlane(t_ >> 6); }
    LAS float* RTt = (LAS float*)(F.lds);
    LAS float* GN = (LAS float*)(F.lds + 65536);
    LAS float* PS = (LAS float*)(F.lds + 73728);
    LAS float* invt = (LAS float*)(F.lds + 81920);
    LAS int* lcnt = (LAS int*)(F.lds + MISC_OFF + 256);
    for (int i = F.tid; i < D * 8; i += 512) { const int c = i >> 3, e = i & 7; RTt[e * D + c] = router[i] * gain[c]; }
    for (int i = F.tid; i < D; i += 512) { GN[i] = gain[i]; PS[i] = pscale[i]; }
    if (fp8 != 0) { for (int i = F.bid * 512 + F.tid; i < NE * NT * 8; i += F.G * 512) *(u32x4*)(ACTM8 + (size_t)(i >> 3) * FE8 + FE + (i & 7) * 16) = (u32x4){0u, 0u, 0u, 0u}; }
    __syncthreads();
    for (int t = F.bid; t < 256; t += F.G) {
        const int r0 = t * 32, s0 = r0 & (SEQ - 1);
        if (F.tid < 16) lcnt[F.tid] = 0;
        for (int li = F.wave; li < 47; li += 8) { const int sp = s0 - 15 + li; int row = r0 - 15 + li; row = row < 0 ? 0 : row;
            float p = (F.lane < 32) ? ROWSS[(size_t)row * 32 + F.lane] : 0.f; p = wave_sum(p);
            if (F.lane == 0) invt[li] = (sp >= 0) ? (1.0f / sqrtf(p * (1.0f / D) + EPS)) : 0.f; }
        LDS_WAIT(); __syncthreads();
        const int rbase = r0 + F.wave * 4;
        int e0[4], e1[4], p0[4], p1[4]; float g0[4], inr[4], mq[4];
#pragma unroll
        for (int pr = 0; pr < 2; ++pr) {
            const int ra = rbase + 2 * pr, sa = ra & (SEQ - 1), li0 = ra - r0 + 15;
            f32x4 xa[8], xb[8];
#pragma unroll
            for (int j = 0; j < 8; ++j) { int ln = F.lane; asm volatile("" : "+v"(ln));
                const int col = 4 * ln + 256 * j; f32x4 pa, pb;
                if (j < 2) pool_pair<2>(Z, invt, li0, ra, sa, col, pa, pb); else if (j < 4) pool_pair<4>(Z, invt, li0, ra, sa, col, pa, pb); else if (j < 6) pool_pair<8>(Z, invt, li0, ra, sa, col, pa, pb); else pool_pair<16>(Z, invt, li0, ra, sa, col, pa, pb);
                const f32x4 ps = *(const LAS f32x4*)(PS + col);
                xa[j] = bf4(*(const u32x2*)(X + (size_t)ra * D + col)) + ps * pa; xb[j] = bf4(*(const u32x2*)(X + (size_t)(ra + 1) * D + col)) + ps * pb;
                u32x2 wa, wb; wa.x = cvt_pk_bf16(xa[j][0], xa[j][1]); wa.y = cvt_pk_bf16(xa[j][2], xa[j][3]); wb.x = cvt_pk_bf16(xb[j][0], xb[j][1]); wb.y = cvt_pk_bf16(xb[j][2], xb[j][3]);
                *(u32x2*)(X + (size_t)ra * D + col) = wa; *(u32x2*)(X + (size_t)(ra + 1) * D + col) = wb;
                if (j == 3 || j == 7) __builtin_amdgcn_sched_barrier(0); }
            float sqa = 0.f, sqb = 0.f;
            if constexpr (fp8 == 2) { float ma = 0.f, mb = 0.f;
#pragma unroll
                for (int j = 0; j < 8; ++j) { const f32x4 gn = *(const LAS f32x4*)(GN + 4 * F.lane + 256 * j); const f32x4 ta = xa[j] * gn, tb = xb[j] * gn;
                    ma = fmaxf(ma, fmaxf(fmaxf(fabsf(ta[0]), fabsf(ta[1])), fmaxf(fabsf(ta[2]), fabsf(ta[3])))); mb = fmaxf(mb, fmaxf(fmaxf(fabsf(tb[0]), fabsf(tb[1])), fmaxf(fabsf(tb[2]), fabsf(tb[3])))); }
                mq[2 * pr] = fmaxf(wave_max(ma), 1e-20f); mq[2 * pr + 1] = fmaxf(wave_max(mb), 1e-20f); }
#pragma unroll
            for (int j = 0; j < 8; ++j) { sqa += (xa[j][0] * xa[j][0] + xa[j][1] * xa[j][1]) + (xa[j][2] * xa[j][2] + xa[j][3] * xa[j][3]); sqb += (xb[j][0] * xb[j][0] + xb[j][1] * xb[j][1]) + (xb[j][2] * xb[j][2] + xb[j][3] * xb[j][3]); }
            const float inva = 1.0f / sqrtf(wave_sum(sqa) * (1.0f / D) + EPS), invb = 1.0f / sqrtf(wave_sum(sqb) * (1.0f / D) + EPS);
            inr[2 * pr] = inva; inr[2 * pr + 1] = invb;
            float lg[2][8];
#pragma unroll
            for (int e = 0; e < 8; ++e) { float a0 = 0.f, a1 = 0.f;
#pragma unroll
                for (int j = 0; j < 8; ++j) { const f32x4 w = *(const LAS f32x4*)(RTt + e * D + 4 * F.lane + 256 * j);
                    a0 += (xa[j][0] * w[0] + xa[j][1] * w[1]) + (xa[j][2] * w[2] + xa[j][3] * w[3]);
                    a1 += (xb[j][0] * w[0] + xb[j][1] * w[1]) + (xb[j][2] * w[2] + xb[j][3] * w[3]); }
                lg[0][e] = wave_sum(a0) * inva; lg[1][e] = wave_sum(a1) * invb; }
#pragma unroll
            for (int q = 0; q < 2; ++q) { const int rr = 2 * pr + q;
                float v0 = lg[q][0]; int i0 = 0;
#pragma unroll
                for (int e = 1; e < 8; ++e) if (lg[q][e] > v0) { v0 = lg[q][e]; i0 = e; }
                float v1 = -3.0e38f; int i1 = 0;
#pragma unroll
                for (int e = 0; e < 8; ++e) if (e != i0 && lg[q][e] > v1) { v1 = lg[q][e]; i1 = e; }
                e0[rr] = i0; e1[rr] = i1; g0[rr] = 1.0f / (1.0f + expf(v1 - v0));
                int a = 0, bq = 0;
                if (F.lane == 0) { a = atomicAdd((int*)(lcnt + i0), 1); bq = atomicAdd((int*)(lcnt + i1), 1); }
                p0[rr] = __builtin_amdgcn_readfirstlane(a); p1[rr] = __builtin_amdgcn_readfirstlane(bq); }
            __builtin_amdgcn_sched_barrier(0);
        }
        VM_WAIT();
        __syncthreads();
        if (F.tid < 8) lcnt[8 + F.tid] = (int)__hip_atomic_fetch_add(counts + 64 * F.tid, (unsigned)lcnt[F.tid], __ATOMIC_RELAXED, __HIP_MEMORY_SCOPE_AGENT);
        __syncthreads();
#pragma unroll
        for (int rr = 0; rr < 4; ++rr) { const int row = rbase + rr;
            const int q0 = lcnt[8 + e0[rr]] + p0[rr], q1 = lcnt[8 + e1[rr]] + p1[rr];
            const size_t pitch = fp8 ? D : 2 * D;
            float q8 = 0.f; if constexpr (fp8 == 2) q8 = 127.0f / mq[rr];
            unsigned char* d0 = XG + ((size_t)e0[rr] * NT + q0) * pitch; unsigned char* d1 = XG + ((size_t)e1[rr] * NT + q1) * pitch;
            int ln = F.lane; asm volatile("" : "+v"(ln));
#pragma unroll
            for (int j = 0; j < 8; ++j) { const f32x4 gn = *(const LAS f32x4*)(GN + 4 * ln + 256 * j);
                const unsigned long long xw = __hip_atomic_load((const unsigned long long*)(X + (size_t)row * D) + ln + 64 * j, __ATOMIC_RELAXED, __HIP_MEMORY_SCOPE_AGENT);
                u32x2 xx; xx.x = (unsigned)xw; xx.y = (unsigned)(xw >> 32); const f32x4 hv = bf4(xx) * inr[rr] * gn;
                if constexpr (fp8 == 2) { const int w = pack_i8x4(bf4(xx) * gn * q8); ((unsigned*)d0 + ln)[64 * j] = (unsigned)w; ((unsigned*)d1 + ln)[64 * j] = (unsigned)w; }
                else if constexpr (fp8 != 0) { int w = 0; w = __builtin_amdgcn_cvt_pk_fp8_f32(hv[0], hv[1], w, false); w = __builtin_amdgcn_cvt_pk_fp8_f32(hv[2], hv[3], w, true);
                    ((unsigned*)d0 + ln)[64 * j] = (unsigned)w; ((unsigned*)d1 + ln)[64 * j] = (unsigned)w; }
                else { u32x2 w; w.x = cvt_pk_bf16(hv[0], hv[1]); w.y = cvt_pk_bf16(hv[2], hv[3]); ((u32x2*)d0 + ln)[64 * j] = w; ((u32x2*)d1 + ln)[64 * j] = w; } }
            if constexpr (fp8 == 2) { if (F.lane == 0) { const float sc = mq[rr] * inr[rr] * (1.0f / 127.0f); SAM[e0[rr] * NT + q0] = sc; SAM[e1[rr] * NT + q1] = sc; } }
            if (F.lane == 0) { TOK[e0[rr] * NT + q0] = row * 2; GATE[e0[rr] * NT + q0] = g0[rr]; TOK[e1[rr] * NT + q1] = row * 2 + 1; GATE[e1[rr] * NT + q1] = 1.0f - g0[rr]; }
        }
        __syncthreads();
    }
}

__device__ __forceinline__ void cb_row(const int lane, const int row, const u32x2 (&rx)[8], const u32x2 (&ry0)[8], const u32x2 (&ry1)[8], bf16_t* X, bf16_t* XB, const float* gfinal, float* out, const bool last, const int xb8, const float ys, float* SA) {
    f32x4 v[8]; float s = 0.f;
#pragma unroll
    for (int j = 0; j < 8; ++j) { const u32x2 y0 = ry0[j], y1 = ry1[j];
        v[j] = bf4(rx[j]) + ((f32x4){bf_lo(y0.x), bf_hi(y0.x), bf_lo(y0.y), bf_hi(y0.y)} + (f32x4){bf_lo(y1.x), bf_hi(y1.x), bf_lo(y1.y), bf_hi(y1.y)}) * ys;
        s += (v[j][0] * v[j][0] + v[j][1] * v[j][1]) + (v[j][2] * v[j][2] + v[j][3] * v[j][3]); }
    const float inv = 1.0f / sqrtf(wave_sum(s) * (1.0f / D) + EPS);
    if (last) {
#pragma unroll
        for (int j = 0; j < 8; ++j) { const f32x4 g = ((const f32x4*)gfinal)[lane + 64 * j]; ((f32x4*)(out + (size_t)row * D))[lane + 64 * j] = v[j] * inv * g; }
    } else {
        float q8 = 0.f;
        if (xb8 == 2) { float mx = 0.f;
#pragma unroll
            for (int j = 0; j < 8; ++j) mx = fmaxf(mx, fmaxf(fmaxf(fabsf(v[j][0]), fabsf(v[j][1])), fmaxf(fabsf(v[j][2]), fabsf(v[j][3]))));
            mx = fmaxf(wave_max(mx) * inv, 1e-20f); q8 = inv * 127.0f / mx; if (lane == 0) SA[row] = mx * (1.0f / 127.0f); }
#pragma unroll
        for (int j = 0; j < 8; ++j) { { u32x2 w; w.x = cvt_pk_bf16(v[j][0], v[j][1]); w.y = cvt_pk_bf16(v[j][2], v[j][3]); ((u32x2*)(X + (size_t)row * D))[lane + 64 * j] = w; }
            if (xb8 == 2) ((int*)((unsigned char*)XB + (size_t)row * D) + lane)[64 * j] = pack_i8x4(v[j] * q8);
            else if (xb8) { int w = 0; w = __builtin_amdgcn_cvt_pk_fp8_f32(v[j][0] * inv, v[j][1] * inv, w, false); w = __builtin_amdgcn_cvt_pk_fp8_f32(v[j][2] * inv, v[j][3] * inv, w, true); ((unsigned*)((unsigned char*)XB + (size_t)row * D) + lane)[64 * j] = (unsigned)w; }
            else { u32x2 w; w.x = cvt_pk_bf16(v[j][0] * inv, v[j][1] * inv); w.y = cvt_pk_bf16(v[j][2] * inv, v[j][3] * inv); ((u32x2*)(XB + (size_t)row * D) + lane)[64 * j] = w; } }
    }
}
__device__ __forceinline__ void combine_phase(Frame& F_, bf16_t* X, const bf16_t* Y, bf16_t* XB, const float* gfinal, float* out, bool last, const int xb8  , const float ys, float* SA) {
    Frame F = F_; { int t_ = mk_tid(F_.wv); asm volatile("" : "+v"(t_)); F.tid = t_; F.lane = t_ & 63; F.wave = __builtin_amdgcn_readfirstlane(t_ >> 6); }
    const int gw = F.bid * 8 + F.wave, NGW = F.G * 8;
#define CB_LOAD(RX, RY0, RY1, row_) do { _Pragma("unroll") for (int j = 0; j < 8; ++j) { const size_t o = (size_t)(row_) * D / 4 + F.lane + 64 * j; \
        RX[j] = ((const u32x2*)X)[o]; RY0[j] = ((const u32x2*)Y)[o]; RY1[j] = ((const u32x2*)(Y + (size_t)NT * D))[o]; } } while (0)
    int row = gw; if (row >= NT) return;
    u32x2 ax[8], ay0[8], ay1[8], bx[8], by0[8], by1[8];
    CB_LOAD(ax, ay0, ay1, row);
    for (;;) {
        int nrow = row + NGW; bool has = nrow < NT;
        if (has) CB_LOAD(bx, by0, by1, nrow);
        cb_row(F.lane, row, ax, ay0, ay1, X, XB, gfinal, out, last, xb8, ys, SA);
        if (!has) break;
        row = nrow; nrow = row + NGW; has = nrow < NT;
        if (has) CB_LOAD(ax, ay0, ay1, nrow);
        cb_row(F.lane, row, bx, by0, by1, X, XB, gfinal, out, last, xb8, ys, SA);
        if (!has) break;
        row = nrow;
    }
#undef CB_LOAD
}

__device__ __forceinline__ int compute_cus(int T, int G) { if (T <= 0) return G; const int R = (T + G - 1) / G; int g = (T + R - 1) / R; g = (g + 7) & ~7; return g > G ? G : g; }
__device__ __forceinline__ void q4_row(const int lane, const int row, const float pss, const u32x2 (&rx)[8], unsigned char* XQ, float* SA) {
    const float p = wave_sum(pss); const float inv = 1.0f / sqrtf(p * (1.0f / D) + EPS);
    f32x4 v[8]; float mx = 0.f;
#pragma unroll
    for (int j = 0; j < 8; ++j) { v[j] = bf4(rx[j]) * inv; mx = fmaxf(mx, fmaxf(fmaxf(fabsf(v[j][0]), fabsf(v[j][1])), fmaxf(fabsf(v[j][2]), fabsf(v[j][3])))); }
    mx = fmaxf(wave_max(mx), 1e-20f); const float q = 127.0f / mx;
#pragma unroll
    for (int j = 0; j < 8; ++j) ((int*)(XQ + (size_t)row * D) + lane)[64 * j] = pack_i8x4(v[j] * q);
    if (lane == 0) SA[row] = mx * (1.0f / 127.0f);
}
__device__ __forceinline__ void quant_rows_phase(Frame& F_, const bf16_t* X, const float* ROWSS, unsigned char* XQ, float* SA) {
    Frame F = F_; { int t_ = mk_tid(F_.wv); asm volatile("" : "+v"(t_)); F.tid = t_; F.lane = t_ & 63; F.wave = __builtin_amdgcn_readfirstlane(t_ >> 6); }
    const int gw = F.bid * 8 + F.wave, NGW = F.G * 8;
#define Q4_LOAD(P, RX, row_) do { P = (F.lane < 32) ? ROWSS[(size_t)(row_) * 32 + F.lane] : 0.f; _Pragma("unroll") for (int j = 0; j < 8; ++j) RX[j] = ((const u32x2*)(X + (size_t)(row_) * D) + F.lane)[64 * j]; } while (0)
    int row = gw; if (row >= NT) return;
    u32x2 ax[8], bx[8]; float pa, pb = 0.f;
    Q4_LOAD(pa, ax, row);
    for (;;) {
        int nrow = row + NGW; bool has = nrow < NT;
        if (has) Q4_LOAD(pb, bx, nrow);
        q4_row(F.lane, row, pa, ax, XQ, SA);
        if (!has) break;
        row = nrow; nrow = row + NGW; has = nrow < NT;
        if (has) Q4_LOAD(pa, ax, nrow);
        q4_row(F.lane, row, pb, bx, XQ, SA);
        if (!has) break;
        row = nrow;
    }
#undef Q4_LOAD
}
__global__ void __launch_bounds__(512, 2) trunk_fwd(Params args) {
    extern __shared__ __attribute__((aligned(16))) unsigned char lds_raw[];
    Frame F;
    F.lds = (LAS unsigned char*)lds_raw;
    F.tid = 0; F.lane = 0; F.wave = 0; F.G = gridDim.x; F.bid = blockIdx.x; F.wv = __builtin_amdgcn_readfirstlane((int)(threadIdx.x >> 6));
    F.out = args.out; F.ws = args.ws;
    unsigned char* ws = args.ws;
    unsigned* ctl = (unsigned*)(ws + WS_CTL);
    volatile LAS unsigned* MISC = (volatile LAS unsigned*)(F.lds + MISC_OFF);
    if (threadIdx.x < 64) MISC[threadIdx.x] = 0u;
    __syncthreads();
    const int lo = args.ph_lo, hi = args.ph_hi;
    const bool use_bar = (hi - lo) > 1;
    XcdBarrier bar; bar.bar = ctl + CW_BAR; bar.x = 0; bar.st = MISC + 8;
    if (use_bar) bar = xcd_barrier_post(ctl + CW_BAR, MISC + 8);
    bar.wv = F.wv;
#ifndef PHMASK
#define PHMASK 0x1FFF
#endif
#ifndef REPSLOT
#define REPSLOT -1
#endif
#ifndef REPCNT
#define REPCNT 2
#endif
#define NREP(j) (((j) == (REPSLOT)) ? (REPCNT) : 1)
#define EN(j) (((PHMASK) >> (j)) & 1)
#define IN(k) (lo <= (k) && (k) < hi)
#define WS_FRESH do { } while (0)
#define SEAM(k) do { if (IN(k) && IN((k) + 1)) xcd_barrier(bar); } while (0)
    bf16_t* X = (bf16_t*)(ws + WS_X); bf16_t* XB = (bf16_t*)(ws + WS_XB); float* ROWSS = (float*)(ws + WS_ROWSS);
    LAS unsigned char* ring = F.lds;

    if (EN(0) && IN(0)) { _Pragma("unroll 1") for (int rep = 0; rep < NREP(0); ++rep) { p0_prologue(F, args); __syncthreads(); } }
    SEAM(0);

#pragma unroll 1
    for (int l = 0; l < 2; ++l) {
        const int pb = 1 + 11 * l;
        asm volatile("" : "+s"(ws));
        WS_FRESH;
        if (EN(1) && IN(pb + 0)) _Pragma("unroll 1") for (int rep = 0; rep < NREP(1); ++rep) {
            const bool p8 = (PROJ8 >> l) & 1; const int r8 = (RET8 >> l) & 1;
            A1Order S; S.XB = (unsigned)WS_XB; S.WQKG = (unsigned)(WS_WQKG + l * SZ_WQKG); S.WVT = (unsigned)(WS_WVT + l * SZ_WVT); S.G = F.G; S.c = F.bid; S.t = p8 ? 256u * D : 256u * D * 2;
            const bool i8 = (I8A1 >> l) & 1; if (i8) S.t = 256u * D;
            EpiA1 E{(bf16_t*)(ws + WS_QB), (bf16_t*)(ws + WS_KB), (bf16_t*)(ws + WS_GB), (bf16_t*)(ws + WS_VT), (const float*)(ws + WS_COS), (const float*)(ws + WS_SIN), (const float*)(ws + (r8 ? WS_DQ8 : WS_DQ)), (const float*)(ws + (r8 ? WS_DKS8 : WS_DKS)), (p8 && !i8) ? 1.0f / 32.0f : 1.0f, r8,
                    i8 ? (const float*)(ws + WS_SA) : nullptr, (const float*)(ws + WS_SWQ + l * SZ_SWL), (const float*)(ws + WS_SWV + l * SZ_SWL)};
            if (i8) pg8::gemm_phase<EpiA1, A1Order, 2>(ring, ws, D, D, D, S, E, F.wv);
            else if (!p8) pg8::gemm_phase<EpiA1, A1Order>(ring, ws, D, D, D, S, E, F.wv);
            else pg8::gemm_phase<EpiA1, A1Order, true>(ring, ws, D, D, D, S, E, F.wv);
        }
        SEAM(pb + 0);
        WS_FRESH;
        if (EN(2) && IN(pb + 1)) _Pragma("unroll 1") for (int rep = 0; rep < NREP(2); ++rep) { if (!((RET8 >> l) & 1)) retention_phase(F, (const bf16_t*)(ws + WS_QB), (const bf16_t*)(ws + WS_KB), (const bf16_t*)(ws + WS_VT), (const bf16_t*)(ws + WS_GB), args.in[2] + (size_t)l * VW, (bf16_t*)(ws + WS_OG), (PROJ8 >> l) & 1);
            else retention8_phase(F, ws + WS_QB, ws + WS_KB, ws + WS_VT, (const bf16_t*)(ws + WS_GB), args.in[2] + (size_t)l * VW, (bf16_t*)(ws + WS_OG), (PROJ8 >> l) & 1); }
        SEAM(pb + 1);
        WS_FRESH;
        if (EN(3) && IN(pb + 2)) _Pragma("unroll 1") for (int rep = 0; rep < NREP(3); ++rep) {
            const bool d8 = ((DENSE8 >> l) & 1) && !((I8A4 >> l) & 1);
            const bool p8 = (PROJ8 >> l) & 1;
            DenseOrder S; S.init(WS_OG, p8 ? VW / 2 : VW, WS_WOUT + l * SZ_WOUT, p8 ? VW / 2 : VW, NT, D, F.G, F.bid);
            EpiRes E{X, nullptr, ROWSS, nullptr, 0, rep ? 0.f : (p8 ? 1.0f / 32.0f : 1.0f), d8 ? (unsigned char*)XB : nullptr};
            if (!p8) pg8::gemm_phase<EpiRes, DenseOrder>(ring, ws, VW, VW, VW, S, E, F.wv);
            else pg8::gemm_phase<EpiRes, DenseOrder, true>(ring, ws, VW, VW, VW, S, E, F.wv);
        }
        SEAM(pb + 2);
        if ((I8A4 >> l) & 1) {
            WS_FRESH;
        if (EN(12) && IN(pb + 3)) _Pragma("unroll 1") for (int rep = 0; rep < NREP(12); ++rep) quant_rows_phase(F, X, ROWSS, ws + WS_XB, (float*)(ws + WS_SA));
            SEAM(pb + 3);
        }
        WS_FRESH;
        if (EN(4) && IN(pb + 4)) _Pragma("unroll 1") for (int rep = 0; rep < NREP(4); ++rep) {
            const int Gc = compute_cus(32 * 44, F.G);
            if (F.bid < Gc) {
                if ((I8A4 >> l) & 1) {
                    DenseOrder S; S.init(WS_XB, D / 2, WS_WGU + l * SZ_WGU, D / 2, NT, 2 * FF, Gc, F.bid);
                    EpiGUi8 E{(bf16_t*)(ws + WS_ACT), FF, (const float*)(ws + WS_SA), (const float*)(ws + WS_SWGU + l * SZ_SWL), (DENSE8 >> l) & 1, 0, 0, 0};
                    pg8::gemm_phase<EpiGUi8, DenseOrder, 2>(ring, ws, D, D, D, S, E, F.wv);
                } else if (!((DENSE8 >> l) & 1)) {
                    DenseOrder S; S.init(WS_X, D, WS_WGU + l * SZ_WGU, D, NT, 2 * FF, Gc, F.bid);
                    EpiGU E{(bf16_t*)(ws + WS_ACT), FF, ROWSS, 0};
                    pg8::gemm_phase<EpiGU, DenseOrder>(ring, ws, D, D, D, S, E, F.wv);
                } else {
                    DenseOrder S; S.init(WS_XB, D / 2, WS_WGU + l * SZ_WGU, D / 2, NT, 2 * FF, Gc, F.bid);
                    EpiGU8 E{ws + WS_ACT, FF, 0, 1.0f / 32.0f, ROWSS};
                    pg8::gemm_phase<EpiGU8, DenseOrder, true>(ring, ws, D, D, D, S, E, F.wv);
                }
            }
            if ((I8B4 >> l) & 1) strip_loop<true>(F, args, l, 0, 704, 0, 736, 1 + l);
            tile_loop<true>(F, args, l == 0 ? 1 : 4, 0, 0); __syncthreads();
        }
        SEAM(pb + 4);
        WS_FRESH;
        if (EN(5) && IN(pb + 5)) _Pragma("unroll 1") for (int rep = 0; rep < NREP(5); ++rep) {
            const bool d8 = (DENSE8 >> l) & 1;
            DenseOrder S; S.init(WS_ACT, d8 ? FF / 2 : FF, WS_WDN + l * SZ_WDN, d8 ? FF / 2 : FF, NT, D, F.G, F.bid);
            EpiRes E{X, nullptr, ROWSS, nullptr, 0, rep ? 0.f : (d8 ? 1.0f / 32.0f : 1.0f), nullptr};
            if (!d8) pg8::gemm_phase<EpiRes, DenseOrder>(ring, ws, FF, FF, FF, S, E, F.wv);
            else pg8::gemm_phase<EpiRes, DenseOrder, true>(ring, ws, FF, FF, FF, S, E, F.wv);
        }
        SEAM(pb + 5);
        WS_FRESH;
        if (EN(6) && IN(pb + 6)) _Pragma("unroll 1") for (int rep = 0; rep < NREP(6); ++rep) {
            PoolOrder S; S.MIX = (unsigned)WS_X; S.W = (unsigned)(WS_WPOOL + l * SZ_WPOOL); S.G = F.G; S.c = F.bid;
            EpiZ E{(bf16_t*)(ws + WS_MIX)};
            pg8::gemm_phase<EpiZ, PoolOrder>(ring, ws, 512, D, 512, S, E, F.wv);
        }
        SEAM(pb + 6);
        unsigned* counts = ctl + CW_CNT + l * 512;
        WS_FRESH;
        if (EN(8) && IN(pb + 7)) _Pragma("unroll 1") for (int rep = 0; rep < NREP(8); ++rep) {
            const float* a_ps = args.in[5] + (size_t)l * D; const float* a_rt = args.in[8] + (size_t)l * D * NE; const float* a_gn = args.in[12] + (size_t)(2 * l + 1) * D;
            constexpr bool all_i8 = (I8B4 & 3) == 3, all_f8 = (F8MASK & 3) == 3;
            if (all_i8 || ((I8B4 >> l) & 1)) router_phase<2>(F, X, (const bf16_t*)(ws + WS_MIX), ROWSS, a_ps, a_rt, a_gn, counts, ws + WS_XG, (int*)(ws + WS_TOK), (float*)(ws + WS_GATE), ws + WS_ACTM, (float*)(ws + WS_SAM));
            else if (all_f8 || ((F8MASK >> l) & 1)) router_phase<1>(F, X, (const bf16_t*)(ws + WS_MIX), ROWSS, a_ps, a_rt, a_gn, counts, ws + WS_XG, (int*)(ws + WS_TOK), (float*)(ws + WS_GATE), ws + WS_ACTM, nullptr);
            else router_phase<0>(F, X, (const bf16_t*)(ws + WS_MIX), ROWSS, a_ps, a_rt, a_gn, counts, ws + WS_XG, (int*)(ws + WS_TOK), (float*)(ws + WS_GATE), ws + WS_ACTM, nullptr);
        }
        SEAM(pb + 7);
        WS_FRESH;
        if (EN(9) && IN(pb + 8)) _Pragma("unroll 1") for (int rep = 0; rep < NREP(9); ++rep) {
            const bool f8 = (F8MASK >> l) & 1;
            MoeOrder S;
            if (!f8) S.init(WS_XG, (size_t)NT * D * 2, D, WS_WMGU + l * SZ_WMGU, (size_t)2 * FE * D * 2, D, 2 * FE / 256, counts, F.G, F.bid);
            else S.init(WS_XG, (size_t)NT * D, D, WS_WMGU + l * SZ_WMGU, (size_t)2 * FE * D, D, 2 * FE / 256, counts, F.G, F.bid, 1);
#ifndef B4GC
#define B4GC 0
#endif
            const int Gc = (l == 0) ? (B4GC ? B4GC : compute_cus(S.total, F.G)) : F.G; S.G = Gc;
            if (F.bid < Gc) {
                if (!f8) { EpiGU E{(bf16_t*)(ws + WS_ACTM), FE, nullptr, (size_t)NT * FE}; pg8::gemm_phase<EpiGU, MoeOrder>(ring, ws, D, D, D, S, E, F.wv); }
                else if ((I8B4 >> l) & 1) { EpiGUi8 E{(bf16_t*)(ws + WS_ACTM), FE8, (const float*)(ws + WS_SAM), (const float*)(ws + WS_SWM) + l * NE * 2 * FE, 1, (size_t)NT * FE8, NT, 2 * FE};
                    pg8::gemm_phase<EpiGUi8, MoeOrder, 2>(ring, ws, D, D, D, S, E, F.wv); }
                else { EpiGU8 E{ws + WS_ACTM, FE8, (size_t)NT * FE8, 1.0f / 32.0f, nullptr}; pg8::gemm_phase<EpiGU8, MoeOrder, true>(ring, ws, D, D, D, S, E, F.wv); }
            }
            if (l == 0) { if (I8A1 & 2) strip_loop<true>(F, args, 1, 0, 384, 0, 0, 0); tile_loop<true>(F, args, 2, 0, 0); }
            __syncthreads();
        }
        SEAM(pb + 8);
        WS_FRESH;
        if (EN(10) && IN(pb + 9)) _Pragma("unroll 1") for (int rep = 0; rep < NREP(10); ++rep) {
            const bool f8 = (F8MASK >> l) & 1;
            MoeOrder S;
            if (!f8) S.init(WS_ACTM, (size_t)NT * FE * 2, FE, WS_WMDN + l * SZ_WMDN, (size_t)D * FE * 2, FE, D / 256, counts, F.G, F.bid);
            else S.init(WS_ACTM, (size_t)NT * FE8, FE8, WS_WMDN + l * SZ_WMDN, (size_t)D * FE8, FE8, D / 256, counts, F.G, F.bid, 1);
            const int Gc = (l == 0) ? compute_cus(S.total, F.G) : F.G; S.G = Gc;
            if (F.bid < Gc) {
                EpiMoeDown E{(bf16_t*)(ws + WS_Y), (const int*)(ws + WS_TOK), (const float*)(ws + WS_GATE), f8 ? 1.0f / 32.0f : 1.0f};
                if (!f8) pg8::gemm_phase<EpiMoeDown, MoeOrder>(ring, ws, FE, FE, FE, S, E, F.wv);
                else pg8::gemm_phase<EpiMoeDown, MoeOrder, true>(ring, ws, FE8, FE8, FE8, S, E, F.wv);
            }
            if (l == 0) tile_loop<true>(F, args, 3, 0, 0);
            __syncthreads();
        }
        SEAM(pb + 9);
        WS_FRESH;
        if (EN(11) && IN(pb + 10)) _Pragma("unroll 1") for (int rep = 0; rep < NREP(11); ++rep) combine_phase(F, X, (const bf16_t*)(ws + WS_Y), XB, args.in[13], F.out, l == 1, ((I8A1 >> (l + 1)) & 1) ? 2 : ((PROJ8 >> (l + 1)) & 1), rep ? 0.f : 1.0f, (float*)(ws + WS_SA));
        if (l == 0) SEAM(pb + 10);
    }
#undef IN
#undef SEAM
}

extern "C" void kernel_launch(void* const* d_in, const int* in_sizes, int n_in, void* d_out, int out_size, void* d_ws, size_t ws_size, hipStream_t stream) {
    static int grid = 0;
    if (grid == 0) {
        if (n_in != 14 || in_sizes[0] != NT * D || out_size != NT * D || ws_size < WS_END) { fprintf(stderr, "kernel_launch: unexpected shapes (n_in %d, in0 %d, out %d, ws %zu < %zu)\n", n_in, n_in > 0 ? in_sizes[0] : -1, out_size, ws_size, (size_t)WS_END); grid = -1; return; }
        int dev = 0, cus = 0, per_cu = 0;
        if (hipGetDevice(&dev) != hipSuccess || hipDeviceGetAttribute(&cus, hipDeviceAttributeMultiprocessorCount, dev) != hipSuccess) { grid = -1; return; }
        if (hipFuncSetAttribute((const void*)trunk_fwd, hipFuncAttributeMaxDynamicSharedMemorySize, LDS_BYTES) != hipSuccess) { fprintf(stderr, "kernel_launch: hipFuncSetAttribute failed\n"); grid = -1; return; }
        if (hipOccupancyMaxActiveBlocksPerMultiprocessor(&per_cu, (const void*)trunk_fwd, 512, LDS_BYTES) != hipSuccess || per_cu < 1) fprintf(stderr, "kernel_launch: occupancy query reports %d\n", per_cu);
        (void)hipGetLastError();
        grid = cus;
    }
    if (grid < 0) return;
    if (hipMemsetAsync((char*)d_ws + WS_CTL, 0, CTL_BYTES, stream) != hipSuccess) return;
    Params p{};
    for (int i = 0; i < 14; ++i) p.in[i] = (const float*)d_in[i];
    p.out = (float*)d_out; p.ws = (unsigned char*)d_ws;
#if MK_N_LAUNCHES == 1
    p.ph_lo = 0; p.ph_hi = NPHASE;
    hipLaunchKernelGGL(trunk_fwd, dim3(grid), dim3(512), LDS_BYTES, stream, p);
#else
    for (int k = 0; k < NPHASE; ++k) { p.ph_lo = k; p.ph_hi = k + 1; hipLaunchKernelGGL(trunk_fwd, dim3(grid), dim3(512), LDS_BYTES, stream, p); }
#endif
}
```

```cpp
#include <hip/hip_runtime.h>
#include <cstdio>

#define LAS __attribute__((address_space(3)))
#define GAS __attribute__((address_space(1)))
typedef unsigned short bf16_t;
typedef short bf16x8 __attribute__((ext_vector_type(8)));
typedef float f32x4 __attribute__((ext_vector_type(4)));
typedef float f32x2 __attribute__((ext_vector_type(2)));
typedef unsigned u32x4 __attribute__((ext_vector_type(4)));
typedef unsigned u32x2 __attribute__((ext_vector_type(2)));
typedef int i32x4 __attribute__((ext_vector_type(4)));
typedef int i32x8 __attribute__((ext_vector_type(8)));

#ifndef MK_N_LAUNCHES
#define MK_N_LAUNCHES 1
#endif

constexpr int NT = 8192, SEQ = 2048, D = 2048, NH = 8, DK = 256, DV = 512, QKW = 2048, VW = 4096, FF = 5632, NE = 8, FE = 1408;
constexpr float EPS = 1e-6f;
constexpr int NPHASE = 23;
#ifndef DENSE8
#define DENSE8 3
#endif
#ifndef PROJ8
#define PROJ8 2
#endif
#ifndef I8A1
#define I8A1 3
#endif
#ifndef I8A4
#define I8A4 1
#endif
#ifndef I8B4
#define I8B4 0
#endif
#ifndef RET8
#define RET8 2
#endif
#ifndef F8MASK
#define F8MASK 3
#endif
constexpr int FE8 = 1536;

constexpr size_t MiB = 1u << 20;
constexpr size_t WS_CTL = 0, CTL_BYTES = 1 * MiB;
constexpr size_t WS_COS = 1 * MiB, WS_SIN = 2 * MiB, WS_DQ = 3 * MiB, WS_DKS = 3 * MiB + 4096, WS_LG2 = 3 * MiB + 8192, WS_DQ8 = 3 * MiB + 12288, WS_DKS8 = 3 * MiB + 16384;
constexpr size_t WS_ROWSS = 4 * MiB, WS_TOK = 5 * MiB, WS_GATE = 5 * MiB + 512 * 1024;
constexpr size_t WS_SA = 6 * MiB, WS_SWGU = 6 * MiB + 64 * 1024;
constexpr size_t WS_SWQ = WS_SA + 128 * 1024, WS_SWV = WS_SA + 160 * 1024, SZ_SWL = 256 * 1024;
constexpr size_t WS_SAM = WS_SA + 1024 * 1024, WS_SWM = WS_SA + 1536 * 1024;
constexpr size_t WS_WQKG = 8 * MiB, SZ_WQKG = 32 * MiB;
constexpr size_t WS_WVT = 72 * MiB, SZ_WVT = 16 * MiB;
constexpr size_t WS_WOUT = 104 * MiB, SZ_WOUT = 16 * MiB;
constexpr size_t WS_WGU = 136 * MiB, SZ_WGU = 44 * MiB;
constexpr size_t WS_WDN = 224 * MiB, SZ_WDN = 22 * MiB;
constexpr size_t WS_WPOOL = 268 * MiB, SZ_WPOOL = 2 * MiB;
constexpr size_t WS_WMGU = 272 * MiB, SZ_WMGU = 88 * MiB;
constexpr size_t WS_WMDN = 448 * MiB, SZ_WMDN = 44 * MiB;
constexpr size_t WS_X = 536 * MiB, WS_XB = 600 * MiB, WS_S = 632 * MiB;
constexpr size_t WS_QB = WS_S, WS_KB = WS_S + 32 * MiB, WS_VT = WS_S + 64 * MiB, WS_GB = WS_S + 128 * MiB, WS_OG = WS_S + 192 * MiB, WS_ACT = WS_S;
constexpr size_t WS_MIX = WS_S, WS_XG = WS_S + 32 * MiB, WS_ACTM = WS_S + 288 * MiB, WS_Y = WS_S + 464 * MiB;
constexpr size_t WS_END = WS_S + 592 * MiB;
constexpr unsigned WS_END_32 = (unsigned)WS_END;
constexpr int CW_BAR = 4096;
constexpr int CW_Q = 8192;
constexpr int CW_CNT = 1024;

constexpr int RING_BYTES = 131072, MISC_OFF = 139264, LDS_BYTES = 143360;

__device__ __forceinline__ unsigned cvt_pk_bf16(float lo, float hi) { unsigned r; asm volatile("v_cvt_pk_bf16_f32 %0, %1, %2" : "=v"(r) : "v"(lo), "v"(hi)); return r; }
__device__ __forceinline__ float bf_lo(unsigned w) { return __uint_as_float(w << 16); }
__device__ __forceinline__ float bf_hi(unsigned w) { return __uint_as_float(w & 0xffff0000u); }
__device__ __forceinline__ f32x4 bf4(u32x2 w) { return (f32x4){bf_lo(w.x), bf_hi(w.x), bf_lo(w.y), bf_hi(w.y)}; }
__device__ __forceinline__ float fast_sigmoid(float a) { return __builtin_amdgcn_rcpf(1.0f + __builtin_amdgcn_exp2f(-1.4426950408889634f * a)); }
__device__ __forceinline__ float wave_sum(float v) {
#pragma unroll
    for (int o = 1; o < 64; o <<= 1) v += __shfl_xor(v, o);
    return v;
}
#define LDS_WAIT() asm volatile("s_waitcnt lgkmcnt(0)" ::: "memory")
__device__ __forceinline__ int mk_tid(int wv) { unsigned z = 0u; asm volatile("" : "+s"(z)); return wv * 64 + (int)__builtin_amdgcn_mbcnt_hi(~0u, __builtin_amdgcn_mbcnt_lo(~0u, z)); }
#define VM_WAIT() asm volatile("s_waitcnt vmcnt(0)" ::: "memory")

namespace pg8 {
constexpr int BM = 256, BK = 64, HALF = 128, HTB = HALF * BK * 2, STAGE_BYTES = 8 * HTB;
__host__ __device__ __forceinline__ int lds_byte(int r, int c) { const int st = (r >> 4) * 2 + (c >> 5), rr = r & 15, cc = c & 31, ob = rr * 64 + cc * 2; return st * 1024 + (ob ^ (((ob >> 9) & 1) << 5)); }
__host__ __device__ __forceinline__ void stage_rc(int b, int& R, int& C) { const int st = b / 1024, sb = b % 1024, swz = sb ^ (((sb >> 9) & 1) << 5); R = (st >> 1) * 16 + swz / 64; C = (st & 1) * 32 + (swz % 64) / 2; }
__host__ __device__ __forceinline__ int perm32(int rho) { const int n = rho >> 4, i = rho & 15; return 8 * (i >> 2) + 4 * n + (i & 3); }

struct Unit { unsigned a, b; int pm, pn, grp, rows; };

__device__ __forceinline__ int xcd_remap(int L, int nwg) { const int q = nwg / 8, r = nwg % 8, xcd = L % 8, off = L / 8; return (xcd < r ? xcd * (q + 1) : r * (q + 1) + (xcd - r) * q) + off; }
__device__ __forceinline__ void walk2d(int w, int nM, int nN, int& pm, int& pn) { const int nig = 8 * nN, gid = w / nig, fm = gid * 8, gsz = (nM - fm) < 8 ? (nM - fm) : 8; pm = fm + ((w % nig) % gsz); pn = (w % nig) / gsz; }

template <class Epi, class Sched, int FP8 = 0>
__device__ __forceinline__ void gemm_phase(LAS unsigned char* lds, const unsigned char* wsbase, const int K, const int lda, const int ldb, const Sched& S, const Epi& E, const int wv) {
    int tid = mk_tid(wv); asm volatile("" : "+v"(tid));
    const int wid = __builtin_amdgcn_readfirstlane(tid >> 6), lane = tid & 63, wr = wid >> 2, wc = wid & 3, fr = lane & 15, fq = lane >> 4;
    constexpr int ES = FP8 ? 1 : 2;
    const int nt = K * ES / 128;
    unsigned voffA[2], voffB[2];
#pragma unroll
    for (int i = 0; i < 2; ++i) { int R, C; stage_rc(tid * 16 + i * 8192, R, C); const int Rb = (R & ~31) + perm32(R & 31);
        voffA[i] = (unsigned)(R * lda * ES + C * 2); voffB[i] = (unsigned)(Rb * ldb * ES + C * 2); }
    const unsigned kstep = (unsigned)(BK * 2);
    const unsigned hstepA = (unsigned)HALF * lda * ES, hstepB = (unsigned)HALF * ldb * ES;
    const unsigned ldsw = (unsigned)wid * 1024u;
    const __amdgpu_buffer_rsrc_t rsrc = __builtin_amdgcn_make_buffer_rsrc((void*)wsbase, 0, (int)WS_END_32, 0x00020000);
    const int aoff = lds_byte(wr * 64 + fr, fq * 8); int boff = lds_byte(wc * 32 + fr, fq * 8) + 4 * HTB;
    asm volatile("" : "+v"(boff));
#define PG8_SBR(b, h) (((b) * 2 + (h)) * HTB)
#define PG8_SA(b, h) (((b) * 2 + (h)) * HTB)
#define PG8_SB(b, h) ((4 + (b) * 2 + (h)) * HTB)
#define PG8_STAGE(bufoff, soff, voff) do { _Pragma("unroll") for (int _i = 0; _i < 2; ++_i) \
        __builtin_amdgcn_raw_ptr_buffer_load_lds(rsrc, (LAS unsigned*)(lds + (bufoff) + ldsw + _i * 8192), 16, (voff)[_i], (int)(soff), 0, 0); } while (0)
#define PG8_LD16(off) (*(const LAS i32x4*)(lds + (off)))
#define PG8_LDA(dst, b, h) do { _Pragma("unroll") for (int m = 0; m < 4; ++m) { \
        if constexpr (FP8 == 1) { dst##8[m].lo = PG8_LD16(PG8_SA(b, h) + aoff + m * 2048); dst##8[m].hi = PG8_LD16(PG8_SA(b, h) + aoff + m * 2048 + 1024); } \
        else { _Pragma("unroll") for (int k = 0; k < 2; ++k) dst[m][k] = *(const LAS bf16x8*)(lds + PG8_SA(b, h) + aoff + m * 2048 + k * 1024); } } } while (0)
#define PG8_LDB(dst, b, h) do { _Pragma("unroll") for (int n = 0; n < 2; ++n) { \
        if constexpr (FP8 == 1) { dst##8[n].lo = PG8_LD16(PG8_SBR(b, h) + boff + n * 2048); dst##8[n].hi = PG8_LD16(PG8_SBR(b, h) + boff + n * 2048 + 1024); } \
        else { _Pragma("unroll") for (int k = 0; k < 2; ++k) dst[n][k] = *(const LAS bf16x8*)(lds + PG8_SBR(b, h) + boff + n * 2048 + k * 1024); } } } while (0)
#define PG8_MMA(ai, bj, At, Bt) do { __builtin_amdgcn_s_setprio(1); _Pragma("unroll") for (int m = 0; m < 4; ++m) _Pragma("unroll") for (int n = 0; n < 2; ++n) { \
        if constexpr (FP8 == 1) asm volatile("v_mfma_f32_16x16x128_f8f6f4 %0, %1, %2, %0" : "+v"(acc[ai][bj][m][n]) : "v"(Bt##8[n]), "v"(At##8[m]));     \
        else if constexpr (FP8 == 2) { _Pragma("unroll") for (int k = 0; k < 2; ++k) acc[ai][bj][m][n] = __builtin_bit_cast(f32x4, __builtin_amdgcn_mfma_i32_16x16x64_i8(__builtin_bit_cast(i32x4, Bt[n][k]), __builtin_bit_cast(i32x4, At[m][k]), __builtin_bit_cast(i32x4, acc[ai][bj][m][n]), 0, 0, 0)); } \
        else { _Pragma("unroll") for (int k = 0; k < 2; ++k) acc[ai][bj][m][n] = __builtin_amdgcn_mfma_f32_16x16x32_bf16(Bt[n][k], At[m][k], acc[ai][bj][m][n], 0, 0, 0); } } \
        __builtin_amdgcn_s_setprio(0); } while (0)
#define PG8_WAIT_V(n) asm volatile("s_waitcnt vmcnt(" #n ")" ::: "memory")
#define PG8_WAIT_L(n) asm volatile("s_waitcnt lgkmcnt(" #n ")" ::: "memory")
#define PG8_BAR __builtin_amdgcn_s_barrier()
#define PG8_SCHED __builtin_amdgcn_sched_barrier(0)
    Unit cur, nxt; int ui = 0;
    if (!S.next(0, cur)) return;
    f32x4 acc[2][2][4][2];
#pragma unroll
    for (int a = 0; a < 2; ++a)
#pragma unroll
        for (int b = 0; b < 2; ++b)
#pragma unroll
            for (int m = 0; m < 4; ++m)
#pragma unroll
                for (int n = 0; n < 2; ++n) acc[a][b][m][n] = (f32x4){0.f, 0.f, 0.f, 0.f};
    bf16x8 At[4][2], B0[2][2], B1[2][2]; i32x8 At8[4], B08[2], B18[2];
    int f8scale = 0x7f7f7f7f; asm volatile("" : "+v"(f8scale));
    unsigned cA = cur.a, cB = cur.b;
    PG8_STAGE(PG8_SB(0, 0), cB, voffB); PG8_STAGE(PG8_SB(0, 1), cB + hstepB, voffB); PG8_STAGE(PG8_SA(0, 0), cA, voffA); PG8_STAGE(PG8_SA(0, 1), cA + hstepA, voffA);
    if (wr == 1) PG8_BAR;
    PG8_WAIT_V(2); PG8_BAR;
    PG8_STAGE(PG8_SB(1, 0), cB + kstep, voffB); PG8_STAGE(PG8_SA(1, 0), cA + kstep, voffA); PG8_STAGE(PG8_SB(1, 1), cB + hstepB + kstep, voffB);
    PG8_WAIT_V(6); PG8_BAR;
    for (;;) {
        const bool has_next = S.next(ui + 1, nxt);
        const unsigned nA = has_next ? nxt.a : cA, nB = has_next ? nxt.b : cB;
        for (int t = 0; t < nt; t += 2) {
            const bool last = (t == nt - 2);
            const unsigned a1 = cA + (unsigned)(t + 1) * kstep;
            const unsigned a2 = last ? nA : cA + (unsigned)(t + 2) * kstep, b2 = last ? nB : cB + (unsigned)(t + 2) * kstep;
            const unsigned a3 = a2 + kstep, b3 = b2 + kstep;
            PG8_LDB(B0, 0, 0); PG8_LDB(B1, 0, 1); PG8_SCHED; PG8_LDA(At, 0, 0); PG8_STAGE(PG8_SA(1, 1), a1 + hstepA, voffA);
            PG8_WAIT_V(8); PG8_WAIT_L(0); PG8_BAR; PG8_MMA(0, 0, At, B0); PG8_MMA(0, 1, At, B1); PG8_BAR; PG8_SCHED;
            PG8_LDA(At, 0, 1); PG8_STAGE(PG8_SB(0, 0), b2, voffB); PG8_STAGE(PG8_SB(0, 1), b2 + hstepB, voffB); PG8_STAGE(PG8_SA(0, 0), a2, voffA);
            PG8_WAIT_V(8); PG8_WAIT_L(0); PG8_BAR; PG8_MMA(1, 0, At, B0); PG8_MMA(1, 1, At, B1); PG8_BAR; PG8_SCHED;
            PG8_LDB(B0, 1, 0); PG8_LDB(B1, 1, 1); PG8_SCHED; PG8_LDA(At, 1, 0); PG8_STAGE(PG8_SA(0, 1), a2 + hstepA, voffA);
            PG8_WAIT_V(8); PG8_WAIT_L(0); PG8_BAR; PG8_MMA(0, 0, At, B0); PG8_MMA(0, 1, At, B1); PG8_BAR; PG8_SCHED;
            PG8_LDA(At, 1, 1); PG8_STAGE(PG8_SB(1, 0), b3, voffB); PG8_STAGE(PG8_SB(1, 1), b3 + hstepB, voffB); PG8_STAGE(PG8_SA(1, 0), a3, voffA);
            PG8_WAIT_V(8); PG8_WAIT_L(0); PG8_BAR; PG8_MMA(1, 0, At, B0); PG8_MMA(1, 1, At, B1); PG8_BAR; PG8_SCHED;
        }
        if (wr == 0) PG8_BAR;
        if constexpr (FP8 == 1) { asm volatile("s_nop 15\n\ts_nop 7" ::: "memory"); PG8_SCHED; }
        if constexpr (FP8 == 2) {
            _Pragma("unroll") for (int a = 0; a < 2; ++a) _Pragma("unroll") for (int b = 0; b < 2; ++b) _Pragma("unroll") for (int m = 0; m < 4; ++m) _Pragma("unroll") for (int n = 0; n < 2; ++n)
                acc[a][b][m][n] = __builtin_convertvector(__builtin_bit_cast(i32x4, acc[a][b][m][n]), f32x4); }
        E(acc, cur, wr, wc, fr, fq);
        if (!has_next) break;
#pragma unroll
        for (int a = 0; a < 2; ++a)
#pragma unroll
            for (int b = 0; b < 2; ++b)
#pragma unroll
                for (int m = 0; m < 4; ++m)
#pragma unroll
                    for (int n = 0; n < 2; ++n) acc[a][b][m][n] = (f32x4){0.f, 0.f, 0.f, 0.f};
        cur = nxt; cA = nA; cB = nB; ++ui;
        if (wr == 1) PG8_BAR;
    }
    PG8_WAIT_V(0);
    PG8_BAR;
#undef PG8_SA
#undef PG8_SB
#undef PG8_SBR
#undef PG8_STAGE
#undef PG8_LDA
#undef PG8_LD16
#undef PG8_LDB
#undef PG8_MMA
#undef PG8_WAIT_V
#undef PG8_WAIT_L
#undef PG8_BAR
#undef PG8_SCHED
}
}

#define XB_TMO      128
#define XB_XCNT(j)  (256  + 64 * (j))
#define XB_XSUB(j)  (1280 + 64 * (j))
#define XB_XGEN(j)  (2304 + 64 * (j))
#define XB_TOP      3328
#define XB_TOPGEN   3392
#define XCD_BAR_WORDS 3456
#define XB_SPIN_CAP (1u << 18)

__device__ __forceinline__ unsigned xb_ld(unsigned* p)              { return __hip_atomic_load(p, __ATOMIC_RELAXED, __HIP_MEMORY_SCOPE_AGENT); }
__device__ __forceinline__ unsigned xb_add(unsigned* p, unsigned v) { return __hip_atomic_fetch_add(p, v, __ATOMIC_RELAXED, __HIP_MEMORY_SCOPE_AGENT); }
__device__ __forceinline__ unsigned xb_xcc_id() { return (unsigned)__builtin_amdgcn_s_getreg((3 << 11) | 20) & 0xFu; }
#define XB_SPIN(cond, bar) do { unsigned _sp = 0; while (cond) { __builtin_amdgcn_s_sleep(1); \
    if ((++_sp & 255u) == 0u) { if (xb_ld(&(bar)[XB_TMO])) break; if (_sp > XB_SPIN_CAP) { atomicAdd(&(bar)[XB_TMO], 1u); break; } } } } while (0)

struct XcdBarrier { unsigned* bar; unsigned x; volatile LAS unsigned* st; int wv; };

__device__ __forceinline__ XcdBarrier xcd_barrier_post(unsigned* bar, volatile LAS unsigned* st) {
    XcdBarrier b; b.bar = bar; b.x = xb_xcc_id(); b.st = st;
    if (threadIdx.x == 0) (void)xb_add(&bar[XB_XCNT(b.x)], 1u);
    return b;
}
__device__ __forceinline__ void xcd_barrier_complete(unsigned* bar, unsigned x, unsigned& nloc, unsigned& nx) {
    const unsigned G = gridDim.x * gridDim.y * gridDim.z;
    unsigned sum, cnt, mine, sp = 0u;
    for (;;) {
        sum = 0u; cnt = 0u; mine = 0u;
#pragma unroll
        for (unsigned j = 0; j < 16; ++j) { const unsigned c = xb_ld(&bar[XB_XCNT(j)]); sum += c; cnt += (c > 0u) ? 1u : 0u; mine = (j == x) ? c : mine; }
        if (sum == G) break;
        __builtin_amdgcn_s_sleep(1);
        if ((++sp & 255u) == 0u) { if (xb_ld(&bar[XB_TMO])) break; if (sp > XB_SPIN_CAP) { atomicAdd(&bar[XB_TMO], 1u); break; } }
    }
    nloc = mine > 0u ? mine : 1u; nx = cnt > 0u ? cnt : 1u;
}
__device__ __forceinline__ void xcd_barrier(const XcdBarrier& b) {
    asm volatile("s_waitcnt vmcnt(0)" ::: "memory");
    __syncthreads();
    if (mk_tid(b.wv) == 0) {
        unsigned* bar = b.bar;
        __builtin_amdgcn_s_waitcnt(0);
        unsigned nloc = b.st[0], nx = b.st[1];
        if (nloc == 0u) { xcd_barrier_complete(bar, b.x, nloc, nx); b.st[0] = nloc; b.st[1] = nx; }
        const unsigned old = xb_add(&bar[XB_XSUB(b.x)], 1u);
        const unsigned gen = old / nloc;
        if (old + 1u == (gen + 1u) * nloc) {
            __builtin_amdgcn_fence(__ATOMIC_RELEASE, "agent");
            asm volatile("s_waitcnt vmcnt(0)" ::: "memory");
            const unsigned og = xb_add(&bar[XB_TOP], 1u);
            const unsigned tg = og / nx;
            if (og + 1u == (tg + 1u) * nx) xb_add(&bar[XB_TOPGEN], 1u);
            else XB_SPIN(xb_ld(&bar[XB_TOPGEN]) == tg, bar);
            __builtin_amdgcn_fence(__ATOMIC_ACQUIRE, "agent");
            xb_add(&bar[XB_XGEN(b.x)], 1u);
            asm volatile("s_waitcnt vmcnt(0)" ::: "memory");
        } else {
            XB_SPIN(xb_ld(&bar[XB_XGEN(b.x)]) == gen, bar);
            __builtin_amdgcn_fence(__ATOMIC_ACQUIRE, "agent");
            asm volatile("s_waitcnt vmcnt(0)" ::: "memory");
        }
    }
    __syncthreads();
}

using pg8::Unit;
struct DenseOrder {
    unsigned A, B; int nM, nN, nwg, G, c; unsigned tA, tB;
    __device__ __forceinline__ void init(size_t A_, int lda, size_t B_, int ldb, int M, int N, int G_, int c_) { A = (unsigned)A_; B = (unsigned)B_; nM = M / 256; nN = N / 256; nwg = nM * nN; G = G_; c = c_; tA = 256u * lda * 2; tB = 256u * ldb * 2; }
    __device__ __forceinline__ bool next(int i, Unit& u) const {
        const long L = (long)i * G + c; if (L >= nwg) return false;
        const int w = pg8::xcd_remap((int)L, nwg); pg8::walk2d(w, nM, nN, u.pm, u.pn);
        u.a = A + (unsigned)u.pm * tA; u.b = B + (unsigned)u.pn * tB; u.grp = 0; u.rows = 256; return true;
    }
};
struct A1Order {
    unsigned XB, WQKG, WVT, t; int G, c;
    __device__ __forceinline__ bool next(int i, Unit& u) const {
        const long L = (long)i * G + c; if (L >= 32 * 48) return false;
        const int w = pg8::xcd_remap((int)L, 32 * 48); pg8::walk2d(w, 32, 48, u.pm, u.pn);
        if (u.pn < 32) { u.a = XB + (unsigned)u.pm * t; u.b = WQKG + (unsigned)u.pn * t; } else { u.a = WVT + (unsigned)(u.pn - 32) * t; u.b = XB + (unsigned)u.pm * t; }
        u.grp = 0; u.rows = 256; return true;
    }
};
struct PoolOrder {
    unsigned MIX, W; int G, c;
    __device__ __forceinline__ bool next(int i, Unit& u) const {
        const long L = (long)i * G + c; if (L >= 256) return false;
        const int rem = (int)L & 7; u.pm = (int)L >> 3; u.grp = rem >> 1; u.pn = rem & 1;
        u.a = MIX + ((unsigned)u.pm * 256 * D + (unsigned)u.grp * 512) * 2; u.b = W + ((unsigned)u.grp * 512 * 512 + (unsigned)u.pn * 256 * 512) * 2; u.rows = 256; return true;
    }
};
struct MoeOrder {
    unsigned A, B; int G, c, nN, total; int cnt[8], pre[9]; unsigned eA, eB, tA, tB;
    __device__ __forceinline__ void init(size_t A_, size_t eA_, int lda, size_t B_, size_t eB_, int ldb, int nN_, const unsigned* counts, int G_, int c_, int es = 2) {
        A = (unsigned)A_; B = (unsigned)B_; eA = (unsigned)eA_; eB = (unsigned)eB_; tA = 256u * lda * es; tB = 256u * ldb * es; nN = nN_; G = G_; c = c_;
        int p = 0;
#pragma unroll
        for (int e = 0; e < 8; ++e) { int n = (int)__builtin_amdgcn_readfirstlane(__hip_atomic_load(counts + 64 * e, __ATOMIC_RELAXED, __HIP_MEMORY_SCOPE_AGENT)); n = n > NT ? NT : n; cnt[e] = n; pre[e] = p; p += (n + 255) >> 8; }
        pre[8] = p; total = p * nN;
    }
    __device__ __forceinline__ bool next(int i, Unit& u) const {
        const long L = (long)i * G + c; if (L >= total) return false;
        const int w = pg8::xcd_remap((int)L, total);
        int e = 0;
#pragma unroll
        for (int j = 1; j < 8; ++j) e += (w >= pre[j] * nN) ? 1 : 0;
        int pe = 0, ce = 0, te = 0;
#pragma unroll
        for (int j = 0; j < 8; ++j) { if (j == e) { pe = pre[j]; ce = cnt[j]; te = pre[j + 1] - pre[j]; } }
        pg8::walk2d(w - pe * nN, te, nN, u.pm, u.pn);
        u.grp = e; u.rows = ce - u.pm * 256;
        u.a = A + (unsigned)e * eA + (unsigned)u.pm * tA; u.b = B + (unsigned)e * eB + (unsigned)u.pn * tB; return true;
    }
};

struct EpiA1 {
    bf16_t* QB; bf16_t* KB; bf16_t* GB; bf16_t* VT; const float* DQ; const float* DKS; float ascale; int r8; const float* SA; const float* SWQ; const float* SWV;
    __device__ __forceinline__ void operator()(const f32x4 (&acc)[2][2][4][2], const Unit& u, int wr, int wc, int fr, int fq) const {
        if (u.pn < 32) {
            const int kind = u.pn < 8 ? 0 : (u.pn < 16 ? 1 : 2), h = u.pn & 7;
            f32x4 frv[2];
#pragma unroll
            for (int bj = 0; bj < 2; ++bj)
#pragma unroll
                for (int j = 0; j < 4; ++j) frv[bj][j] = exp2f(-(float)(bj * 64 + wc * 16 + fq * 4 + j) * (13.287712379549449f / 127.0f)) * 0.15915494309189535f;
            float rf8[2][4];
#pragma unroll
            for (int ai = 0; ai < 2; ++ai)
#pragma unroll
                for (int m = 0; m < 4; ++m) { const int row = u.pm * 256 + ai * 128 + wr * 64 + m * 16 + fr, pos = row & (SEQ - 1);
                    float rf = ascale; if (kind < 2) rf = ascale * (kind == 0 ? DQ : DKS)[h * 128 + (pos & 127)];
                    if (SA) rf *= SA[row];
                    rf8[ai][m] = rf; }
            asm volatile("" ::: "memory");
#pragma unroll
            for (int ai = 0; ai < 2; ++ai)
#pragma unroll
                for (int m = 0; m < 4; ++m) {
                    const int row = u.pm * 256 + ai * 128 + wr * 64 + m * 16 + fr, pos = row & (SEQ - 1);
                    const float rf = rf8[ai][m];
#pragma unroll
                    for (int bj = 0; bj < 2; ++bj) {
                        const int cc = bj * 128 + wc * 32 + fq * 8;
                        f32x4 v0 = acc[ai][bj][m][0], v1 = acc[ai][bj][m][1];
                        if (SA) { v0 = v0 * *(const f32x4*)(SWQ + u.pn * 256 + cc); v1 = v1 * *(const f32x4*)(SWQ + u.pn * 256 + cc + 4); }
                        bf16_t* dst;
                        if (kind < 2) {
                            f32x4 cs, sn;
#pragma unroll
                            for (int j = 0; j < 4; ++j) { const float rv = __builtin_amdgcn_fractf((float)pos * frv[bj][j]); sn[j] = __builtin_amdgcn_sinf(rv); cs[j] = __builtin_amdgcn_cosf(rv); }
                            f32x4 o0, o1;
                            o0[0] = v0[0] * cs[0] - v0[1] * sn[0]; o0[1] = v0[1] * cs[0] + v0[0] * sn[0];
                            o0[2] = v0[2] * cs[1] - v0[3] * sn[1]; o0[3] = v0[3] * cs[1] + v0[2] * sn[1];
                            o1[0] = v1[0] * cs[2] - v1[1] * sn[2]; o1[1] = v1[1] * cs[2] + v1[0] * sn[2];
                            o1[2] = v1[2] * cs[3] - v1[3] * sn[3]; o1[3] = v1[3] * cs[3] + v1[2] * sn[3];
                            v0 = o0 * rf; v1 = o1 * rf;
                            dst = (kind == 0 ? QB : KB) + (size_t)row * QKW + h * 256 + cc;
                        } else { v0 = v0 * rf; v1 = v1 * rf; dst = GB + (size_t)row * VW + (u.pn - 16) * 256 + cc; }
                        if (r8 && kind < 2) { int w0 = 0, w1 = 0; w0 = __builtin_amdgcn_cvt_pk_fp8_f32(v0[0], v0[1], w0, false); w0 = __builtin_amdgcn_cvt_pk_fp8_f32(v0[2], v0[3], w0, true);
                            w1 = __builtin_amdgcn_cvt_pk_fp8_f32(v1[0], v1[1], w1, false); w1 = __builtin_amdgcn_cvt_pk_fp8_f32(v1[2], v1[3], w1, true); u32x2 w; w.x = (unsigned)w0; w.y = (unsigned)w1;
                            *(u32x2*)((unsigned char*)(kind == 0 ? QB : KB) + (size_t)row * QKW + h * 256 + cc) = w; }
                        else { u32x4 w; w.x = cvt_pk_bf16(v0[0], v0[1]); w.y = cvt_pk_bf16(v0[2], v0[3]); w.z = cvt_pk_bf16(v1[0], v1[1]); w.w = cvt_pk_bf16(v1[2], v1[3]);
                            *(u32x4*)dst = w; }
                    }
                }
        } else {
            float rsv8[2][4];
#pragma unroll
            for (int ai = 0; ai < 2; ++ai)
#pragma unroll
                for (int m = 0; m < 4; ++m) { const int vrow = (u.pn - 32) * 256 + ai * 128 + wr * 64 + m * 16 + fr; rsv8[ai][m] = SA ? ascale * SWV[vrow] : ascale; }
            asm volatile("" ::: "memory");
#pragma unroll
            for (int ai = 0; ai < 2; ++ai)
#pragma unroll
                for (int m = 0; m < 4; ++m) {
                    const int vrow = (u.pn - 32) * 256 + ai * 128 + wr * 64 + m * 16 + fr; const float rsv = rsv8[ai][m];
#pragma unroll
                    for (int bj = 0; bj < 2; ++bj) {
                        const int tok = u.pm * 256 + bj * 128 + wc * 32 + fq * 8;
                        f32x4 v0 = acc[ai][bj][m][0] * rsv, v1 = acc[ai][bj][m][1] * rsv;
                        if (SA) { v0 = v0 * *(const f32x4*)(SA + tok); v1 = v1 * *(const f32x4*)(SA + tok + 4); }
                        if (r8) { int w0 = 0, w1 = 0; w0 = __builtin_amdgcn_cvt_pk_fp8_f32(v0[0], v0[1], w0, false); w0 = __builtin_amdgcn_cvt_pk_fp8_f32(v0[2], v0[3], w0, true);
                            w1 = __builtin_amdgcn_cvt_pk_fp8_f32(v1[0], v1[1], w1, false); w1 = __builtin_amdgcn_cvt_pk_fp8_f32(v1[2], v1[3], w1, true); u32x2 w; w.x = (unsigned)w0; w.y = (unsigned)w1;
                            *(u32x2*)((unsigned char*)VT + (size_t)vrow * NT + tok) = w; }
                        else { u32x4 w; w.x = cvt_pk_bf16(v0[0], v0[1]); w.y = cvt_pk_bf16(v0[2], v0[3]); w.z = cvt_pk_bf16(v1[0], v1[1]); w.w = cvt_pk_bf16(v1[2], v1[3]);
                            *(u32x4*)(VT + (size_t)vrow * NT + tok) = w; }
                    }
                }
        }
    }
};
struct EpiRes {
    bf16_t* X; bf16_t* XB; float* ROWSS; const float* colscale; int pool; float ascale; unsigned char* XB8;
    __device__ __forceinline__ void operator()(const f32x4 (&acc)[2][2][4][2], const Unit& u, int wr, int wc, int fr, int fq) const {
        const int colbase = pool ? (u.grp * 512 + u.pn * 256) : u.pn * 256;
        f32x4 cs[2][2];
#pragma unroll
        for (int bj = 0; bj < 2; ++bj)
#pragma unroll
            for (int n = 0; n < 2; ++n) cs[bj][n] = (colscale ? *(const f32x4*)(colscale + colbase + bj * 128 + wc * 32 + fq * 8 + n * 4) : (f32x4){1.f, 1.f, 1.f, 1.f}) * ascale;
#pragma unroll
        for (int ai = 0; ai < 2; ++ai)
#pragma unroll
            for (int m = 0; m < 4; ++m) {
                const int row = u.pm * 256 + ai * 128 + wr * 64 + m * 16 + fr;
                float ss = 0.f;
#pragma unroll
                for (int bj = 0; bj < 2; ++bj) {
                    const size_t off = (size_t)row * D + colbase + bj * 128 + wc * 32 + fq * 8;
                    const u32x4 xw = *(const u32x4*)(X + off); const f32x4 x0 = bf4((u32x2){xw.x, xw.y}), x1 = bf4((u32x2){xw.z, xw.w});
                    const f32x4 v0 = x0 + acc[ai][bj][m][0] * cs[bj][0], v1 = x1 + acc[ai][bj][m][1] * cs[bj][1];
                    { u32x4 w; w.x = cvt_pk_bf16(v0[0], v0[1]); w.y = cvt_pk_bf16(v0[2], v0[3]); w.z = cvt_pk_bf16(v1[0], v1[1]); w.w = cvt_pk_bf16(v1[2], v1[3]); *(u32x4*)(X + off) = w; }
                    if (XB) { u32x4 w; w.x = cvt_pk_bf16(v0[0], v0[1]); w.y = cvt_pk_bf16(v0[2], v0[3]); w.z = cvt_pk_bf16(v1[0], v1[1]); w.w = cvt_pk_bf16(v1[2], v1[3]); *(u32x4*)(XB + off) = w; }
                    if (XB8) { int w0 = 0, w1 = 0; w0 = __builtin_amdgcn_cvt_pk_fp8_f32(v0[0], v0[1], w0, false); w0 = __builtin_amdgcn_cvt_pk_fp8_f32(v0[2], v0[3], w0, true);
                        w1 = __builtin_amdgcn_cvt_pk_fp8_f32(v1[0], v1[1], w1, false); w1 = __builtin_amdgcn_cvt_pk_fp8_f32(v1[2], v1[3], w1, true); u32x2 w; w.x = (unsigned)w0; w.y = (unsigned)w1; *(u32x2*)(XB8 + off) = w; }
                    ss += (v0[0] * v0[0] + v0[1] * v0[1]) + (v0[2] * v0[2] + v0[3] * v0[3]) + (v1[0] * v1[0] + v1[1] * v1[1]) + (v1[2] * v1[2] + v1[3] * v1[3]);
                }
                ss += __shfl_xor(ss, 16); ss += __shfl_xor(ss, 32);
                if (fq == 0) ROWSS[(size_t)row * 32 + (colbase >> 8) * 4 + wc] = ss;
                if (m & 1) asm volatile("" ::: "memory");
            }
    }
};
struct EpiZ {
    bf16_t* Z;
    __device__ __forceinline__ void operator()(const f32x4 (&acc)[2][2][4][2], const Unit& u, int wr, int wc, int fr, int fq) const {
#pragma unroll
        for (int ai = 0; ai < 2; ++ai)
#pragma unroll
            for (int m = 0; m < 4; ++m) { const int row = u.pm * 256 + ai * 128 + wr * 64 + m * 16 + fr;
#pragma unroll
                for (int bj = 0; bj < 2; ++bj) { const f32x4 v0 = acc[ai][bj][m][0], v1 = acc[ai][bj][m][1];
                    u32x4 w; w.x = cvt_pk_bf16(v0[0], v0[1]); w.y = cvt_pk_bf16(v0[2], v0[3]); w.z = cvt_pk_bf16(v1[0], v1[1]); w.w = cvt_pk_bf16(v1[2], v1[3]);
                    *(u32x4*)(Z + (size_t)row * D + u.grp * 512 + u.pn * 256 + bj * 128 + wc * 32 + fq * 8) = w; } }
    }
};
struct EpiGU {
    bf16_t* ACT; int ldact; const float* ROWSS; size_t estride;
    __device__ __forceinline__ void operator()(const f32x4 (&acc)[2][2][4][2], const Unit& u, int wr, int wc, int fr, int fq) const {
        bf16_t* base = ACT + (size_t)u.grp * estride;
#pragma unroll
        for (int ai = 0; ai < 2; ++ai)
#pragma unroll
            for (int m = 0; m < 4; ++m) {
                const int row = u.pm * 256 + ai * 128 + wr * 64 + m * 16 + fr;
                float rs = 1.f;
                if (ROWSS) { const f32x4 p0 = *(const f32x4*)(ROWSS + (size_t)row * 32 + fq * 8), p1 = *(const f32x4*)(ROWSS + (size_t)row * 32 + fq * 8 + 4);
                    float s = (p0[0] + p0[1]) + (p0[2] + p0[3]) + (p1[0] + p1[1]) + (p1[2] + p1[3]); s += __shfl_xor(s, 16); s += __shfl_xor(s, 32); rs = __builtin_amdgcn_rsqf(s * (1.0f / D) + EPS); }
                float o[8];
#pragma unroll
                for (int n = 0; n < 2; ++n)
#pragma unroll
                    for (int j = 0; j < 4; ++j) { const float a = acc[ai][0][m][n][j] * rs, g = acc[ai][1][m][n][j] * rs; o[n * 4 + j] = a * fast_sigmoid(a) * g; }
                u32x4 w; w.x = cvt_pk_bf16(o[0], o[1]); w.y = cvt_pk_bf16(o[2], o[3]); w.z = cvt_pk_bf16(o[4], o[5]); w.w = cvt_pk_bf16(o[6], o[7]);
                *(u32x4*)(base + (size_t)row * ldact + u.pn * 128 + wc * 32 + fq * 8) = w;
            }
    }
};
struct EpiGUi8 {
    bf16_t* ACT; int ldact; const float* SA; const float* SW; int out8; size_t estride; int sastride, swstride;
    __device__ __forceinline__ void operator()(const f32x4 (&acc)[2][2][4][2], const Unit& u, int wr, int wc, int fr, int fq) const {
        f32x4 wa[2], wu[2];
#pragma unroll
        for (int n = 0; n < 2; ++n) { wa[n] = *(const f32x4*)(SW + u.grp * swstride + u.pn * 256 + wc * 32 + fq * 8 + n * 4); wu[n] = *(const f32x4*)(SW + u.grp * swstride + u.pn * 256 + 128 + wc * 32 + fq * 8 + n * 4); }
        float sa8[2][4];
#pragma unroll
        for (int ai = 0; ai < 2; ++ai)
#pragma unroll
            for (int m = 0; m < 4; ++m) sa8[ai][m] = SA[u.grp * sastride + u.pm * 256 + ai * 128 + wr * 64 + m * 16 + fr];
        asm volatile("" ::: "memory");
#pragma unroll
        for (int ai = 0; ai < 2; ++ai)
#pragma unroll
            for (int m = 0; m < 4; ++m) {
                const int row = u.pm * 256 + ai * 128 + wr * 64 + m * 16 + fr; const float sa = sa8[ai][m];
                float o[8];
#pragma unroll
                for (int n = 0; n < 2; ++n)
#pragma unroll
                    for (int j = 0; j < 4; ++j) { const float a = acc[ai][0][m][n][j] * sa * wa[n][j], g = acc[ai][1][m][n][j] * sa * wu[n][j]; o[n * 4 + j] = a * fast_sigmoid(a) * g; }
                if (out8) { u32x2 w; w.x = 0u; w.y = 0u;
                    w.x = (unsigned)__builtin_amdgcn_cvt_pk_fp8_f32(o[0], o[1], (int)w.x, false); w.x = (unsigned)__builtin_amdgcn_cvt_pk_fp8_f32(o[2], o[3], (int)w.x, true);
                    w.y = (unsigned)__builtin_amdgcn_cvt_pk_fp8_f32(o[4], o[5], (int)w.y, false); w.y = (unsigned)__builtin_amdgcn_cvt_pk_fp8_f32(o[6], o[7], (int)w.y, true);
                    *(u32x2*)((unsigned char*)ACT + (size_t)u.grp * estride + (size_t)row * ldact + u.pn * 128 + wc * 32 + fq * 8) = w; }
                else { u32x4 w; w.x = cvt_pk_bf16(o[0], o[1]); w.y = cvt_pk_bf16(o[2], o[3]); w.z = cvt_pk_bf16(o[4], o[5]); w.w = cvt_pk_bf16(o[6], o[7]);
                    *(u32x4*)(ACT + (size_t)row * ldact + u.pn * 128 + wc * 32 + fq * 8) = w; }
            }
    }
};
struct EpiGU8 {
    unsigned char* ACT; int ldact; size_t estride; float s; const float* ROWSS;
    __device__ __forceinline__ void operator()(const f32x4 (&acc)[2][2][4][2], const Unit& u, int wr, int wc, int fr, int fq) const {
        unsigned char* base = ACT + (size_t)u.grp * estride;
        float rs8[2][4];
        if (ROWSS) {
#pragma unroll
            for (int ai = 0; ai < 2; ++ai) {
                f32x4 p0[4], p1[4];
#pragma unroll
                for (int m = 0; m < 4; ++m) { const float* pr = ROWSS + (size_t)(u.pm * 256 + ai * 128 + wr * 64 + m * 16 + fr) * 32 + fq * 8; p0[m] = *(const f32x4*)pr; p1[m] = *(const f32x4*)(pr + 4); }
#pragma unroll
                for (int m = 0; m < 4; ++m) { const f32x4 a = p0[m], b = p1[m];
                    float q = (a[0] + a[1]) + (a[2] + a[3]) + (b[0] + b[1]) + (b[2] + b[3]); q += __shfl_xor(q, 16); q += __shfl_xor(q, 32); rs8[ai][m] = s * __builtin_amdgcn_rsqf(q * (1.0f / D) + EPS); }
            }
        } else {
#pragma unroll
            for (int ai = 0; ai < 2; ++ai)
#pragma unroll
                for (int m = 0; m < 4; ++m) rs8[ai][m] = s;
        }
        asm volatile("" ::: "memory");
#pragma unroll
        for (int ai = 0; ai < 2; ++ai)
#pragma unroll
            for (int m = 0; m < 4; ++m) {
                const int row = u.pm * 256 + ai * 128 + wr * 64 + m * 16 + fr;
                const float rs = rs8[ai][m];
                float o[8];
#pragma unroll
                for (int n = 0; n < 2; ++n)
#pragma unroll
                    for (int j = 0; j < 4; ++j) { const float a = acc[ai][0][m][n][j] * rs, g = acc[ai][1][m][n][j] * rs; o[n * 4 + j] = a * fast_sigmoid(a) * g; }
                u32x2 w; w.x = 0u; w.y = 0u;
                w.x = (unsigned)__builtin_amdgcn_cvt_pk_fp8_f32(o[0], o[1], (int)w.x, false); w.x = (unsigned)__builtin_amdgcn_cvt_pk_fp8_f32(o[2], o[3], (int)w.x, true);
                w.y = (unsigned)__builtin_amdgcn_cvt_pk_fp8_f32(o[4], o[5], (int)w.y, false); w.y = (unsigned)__builtin_amdgcn_cvt_pk_fp8_f32(o[6], o[7], (int)w.y, true);
                *(u32x2*)(base + (size_t)row * ldact + u.pn * 128 + wc * 32 + fq * 8) = w;
            }
    }
};
struct EpiMoeDown {
    bf16_t* Y; const int* TOK; const float* GATE; float wscale;
    __device__ __forceinline__ void operator()(const f32x4 (&acc)[2][2][4][2], const Unit& u, int wr, int wc, int fr, int fq) const {
#pragma unroll
        for (int ai = 0; ai < 2; ++ai)
#pragma unroll
            for (int m = 0; m < 4; ++m) {
                const int rloc = ai * 128 + wr * 64 + m * 16 + fr;
                if (rloc < u.rows) {
                    const int gi = u.grp * NT + u.pm * 256 + rloc; const int t2 = TOK[gi]; const float gt = GATE[gi] * wscale;
                    bf16_t* dst = Y + ((size_t)(t2 & 1) * NT + (size_t)(t2 >> 1)) * D + u.pn * 256 + wc * 32 + fq * 8;
#pragma unroll
                    for (int bj = 0; bj < 2; ++bj) { const f32x4 v0 = acc[ai][bj][m][0] * gt, v1 = acc[ai][bj][m][1] * gt;
                        u32x4 w; w.x = cvt_pk_bf16(v0[0], v0[1]); w.y = cvt_pk_bf16(v0[2], v0[3]); w.z = cvt_pk_bf16(v1[0], v1[1]); w.w = cvt_pk_bf16(v1[2], v1[3]);
                        *(u32x4*)(dst + bj * 128) = w; }
                }
            }
    }
};

struct Frame {
    LAS unsigned char* lds; int tid, lane, wave, G, bid, wv;
    float* out; unsigned char* ws;
};
struct Params { const float* in[14]; float* out; unsigned char* ws; int ph_lo, ph_hi; };

struct RJob { const float* src; unsigned char* dst; const float* ks; int srcld, pitch, fmt, F, n0, kbyte; };
__device__ __forceinline__ RJob rj_make(int r, const float* src, int srcld, int K, int col_begin, int ncols, void* dst, int F, const float* kscale, int f8 = 0, int pitch8 = 0) {
    const int nn = ncols / 256, kb = r / nn, nb = r - kb * nn, k0 = kb * 128;
    RJob t; t.src = src + (size_t)k0 * srcld + col_begin + nb * 256; t.ks = kscale ? kscale + k0 : nullptr; t.srcld = srcld; t.dst = (unsigned char*)dst; t.F = F; t.n0 = nb * 256;
    if (f8) { t.pitch = pitch8; t.fmt = (f8 == 2 && kb == K / 128 - 1) ? 2 : 1; t.kbyte = k0; } else { t.pitch = K * 2; t.fmt = 0; t.kbyte = k0 * 2; }
    return t;
}
constexpr int IT_A = 256 * 4 + 704 + 352, IT_B = 32 + 1408 + 704;
__device__ __forceinline__ RJob conv_item_A(const Params& PA, unsigned char* ws, int l, int r) {
    const float* w_in = PA.in[1] + (size_t)l * D * 12288; const float* gm = PA.in[11] + (size_t)(2 * l) * D; const float* gf = PA.in[12] + (size_t)(2 * l) * D;
    bf16_t* WQKG = (bf16_t*)(ws + WS_WQKG + l * SZ_WQKG); bf16_t* WVT = (bf16_t*)(ws + WS_WVT + l * SZ_WVT);
    const int p8 = (PROJ8 >> l) & 1;
    if (r < 256) return rj_make(r, w_in, 12288, D, 0, 4096, WQKG, 0, gm, p8, D); r -= 256;
    if (r < 256) return rj_make(r, w_in, 12288, D, 8192, 4096, (unsigned char*)WQKG + (size_t)4096 * D * (p8 ? 1 : 2), 0, gm, p8, D); r -= 256;
    if (r < 256) return rj_make(r, w_in, 12288, D, 4096, 4096, WVT, 0, gm, p8, D); r -= 256;
    if (r < 256) return rj_make(r, PA.in[3] + (size_t)l * VW * D, D, VW, 0, D, (bf16_t*)(ws + WS_WOUT + l * SZ_WOUT), 0, nullptr, p8, VW); r -= 256;
    const float* gu = PA.in[6] + (size_t)l * D * 2 * FF; bf16_t* WGU = (bf16_t*)(ws + WS_WGU + l * SZ_WGU); const int d8 = (DENSE8 >> l) & 1;
    if (r < 704) return rj_make(r, gu, 2 * FF, D, 0, 2 * FF, WGU, FF, gf, d8, D); r -= 704;
    return rj_make(r, PA.in[7] + (size_t)l * FF * D, D, FF, 0, D, (bf16_t*)(ws + WS_WDN + l * SZ_WDN), 0, nullptr, d8, FF);
}
__device__ __forceinline__ RJob conv_item_B(const Params& PA, unsigned char* ws, int l, int r) {
    if (r < 32) { const int g = r >> 3; return rj_make(r & 7, PA.in[4] + ((size_t)l * 4 + g) * 512 * 512, 512, 512, 0, 512, (bf16_t*)(ws + WS_WPOOL + l * SZ_WPOOL) + (size_t)g * 512 * 512, 0, PA.in[11] + (size_t)(2 * l + 1) * D + g * 512); } r -= 32;
    const int f8 = (F8MASK >> l) & 1;
    if (r < 1408) { const int e = r / 176; unsigned char* d = ws + WS_WMGU + l * SZ_WMGU + (size_t)e * 2 * FE * D * (f8 ? 1 : 2); return rj_make(r % 176, PA.in[9] + ((size_t)l * NE + e) * D * 2 * FE, 2 * FE, D, 0, 2 * FE, d, FE, nullptr, f8, D); } r -= 1408;
    { const int e = r / 88; unsigned char* d = ws + WS_WMDN + l * SZ_WMDN + (size_t)e * D * (f8 ? FE8 : FE * 2); return rj_make(r % 88, PA.in[10] + ((size_t)l * NE + e) * FE * D, D, FE, 0, D, d, 0, nullptr, f8 ? 2 : 0, FE8); }
}
__device__ __forceinline__ int conv_batch_size(int b) { return b == 0 ? (IT_A - ((I8A1 & 1) ? 768 : 0) - ((I8A4 & 1) ? 704 : 0)) : b == 1 ? ((I8B4 & 1) ? 32 : 1440) : b == 2 ? (704 + 1024 - ((I8A1 & 2) ? 768 : 0)) : b == 3 ? (1056 + 32 + 704) : ((I8B4 & 2) ? 0 : 1408); }
__device__ __forceinline__ RJob conv_batch_item(const Params& PA, unsigned char* ws, int b, int r) {
    if (b == 0) { if (I8A1 & 1) r += 768; if ((I8A4 & 1) && r >= 1024) r += 704; return conv_item_A(PA, ws, 0, r); }
    if (b == 1) return conv_item_B(PA, ws, 0, r);
    if (b == 2) { if (r < 704) return conv_item_B(PA, ws, 0, 1440 + r); return conv_item_A(PA, ws, 1, r - 704 + ((I8A1 & 2) ? 768 : 0)); }
    if (b == 3) { if (r < 1056) return conv_item_A(PA, ws, 1, 1024 + r); if (r < 1056 + 32) return conv_item_B(PA, ws, 1, r - 1056); return conv_item_B(PA, ws, 1, 1440 + (r - 1056 - 32)); }
    return conv_item_B(PA, ws, 1, 32 + r);
}
template <bool DYN>
__device__ __forceinline__ void tile_loop(Frame& F_, const Params& PA, int b, int first, int step) {
    Frame F = F_; { int t_ = mk_tid(F_.wv); asm volatile("" : "+v"(t_)); F.tid = t_; F.lane = t_ & 63; F.wave = __builtin_amdgcn_readfirstlane(t_ >> 6); }
    LAS unsigned char* IMG = F.lds;
    volatile LAS unsigned* slot = (volatile LAS unsigned*)(F.lds + MISC_OFF + 512);
    unsigned* q = (unsigned*)(F.ws + WS_CTL) + CW_Q + 512 * b;
    const int n = conv_batch_size(b), lane = F.lane, w = F.wave;
    int jb = first;
    if (DYN) { if (F.tid == 0) slot[0] = __hip_atomic_fetch_add(q, 1u, __ATOMIC_RELAXED, __HIP_MEMORY_SCOPE_AGENT);
        __syncthreads(); jb = (int)slot[0]; __syncthreads(); }
    if (jb >= n) return;
    RJob J = conv_batch_item(PA, F.ws, b, jb);
    u32x4 v[16];
#define TJ_ISSUE(JJ, LIVE) do { const __amdgpu_buffer_rsrc_t rs_ = __builtin_amdgcn_make_buffer_rsrc((void*)(JJ).src, 0, (LIVE) ? (127 * (JJ).srcld + 256) * 4 : 0, 0x00020000);     \
        _Pragma("unroll") for (int it = 0; it < 16; ++it) v[it] = __builtin_amdgcn_raw_buffer_load_b128(rs_, lane * 16, (16 * w + it) * (JJ).srcld * 4, 0); } while (0)
    TJ_ISSUE(J, true);
    for (;;) {
        const int es = J.fmt ? 1 : 2, PITCH = 128 * es + 16;
        {
            float g[16];
#pragma unroll
            for (int it = 0; it < 16; ++it) g[it] = (J.fmt ? 32.0f : 1.0f) * (J.ks ? J.ks[16 * w + it] : 1.0f);
#pragma unroll
            for (int c = 0; c < 4; ++c) { LAS unsigned char* p = IMG + (64 * c + lane) * PITCH + 16 * w * es;
                if (J.fmt == 0) { u32x4 o0, o1;
#define TJ_F(i) (__builtin_bit_cast(f32x4, v[i])[c] * g[i])
                    o0.x = cvt_pk_bf16(TJ_F(0), TJ_F(1)); o0.y = cvt_pk_bf16(TJ_F(2), TJ_F(3)); o0.z = cvt_pk_bf16(TJ_F(4), TJ_F(5)); o0.w = cvt_pk_bf16(TJ_F(6), TJ_F(7));
                    o1.x = cvt_pk_bf16(TJ_F(8), TJ_F(9)); o1.y = cvt_pk_bf16(TJ_F(10), TJ_F(11)); o1.z = cvt_pk_bf16(TJ_F(12), TJ_F(13)); o1.w = cvt_pk_bf16(TJ_F(14), TJ_F(15));
                    *(LAS u32x4*)p = o0; *(LAS u32x4*)(p + 16) = o1;
                } else { int x[4];
#pragma unroll
                    for (int qd = 0; qd < 4; ++qd) { int y = 0; y = __builtin_amdgcn_cvt_pk_fp8_f32(TJ_F(4 * qd), TJ_F(4 * qd + 1), y, false); y = __builtin_amdgcn_cvt_pk_fp8_f32(TJ_F(4 * qd + 2), TJ_F(4 * qd + 3), y, true); x[qd] = y; }
                    *(LAS u32x4*)p = (u32x4){(unsigned)x[0], (unsigned)x[1], (unsigned)x[2], (unsigned)x[3]}; }
#undef TJ_F
            }
        }
        if (DYN) { if (F.tid == 0) slot[0] = __hip_atomic_fetch_add(q, 1u, __ATOMIC_RELAXED, __HIP_MEMORY_SCOPE_AGENT); }
        LDS_WAIT(); __syncthreads();
        const int nx = DYN ? (int)slot[0] : jb + step;
        const bool has = nx < n;
        const RJob Jn = conv_batch_item(PA, F.ws, b, has ? nx : jb);
        TJ_ISSUE(Jn, has);
        {
            const int lpr = 8 * es, rpi = 64 / lpr, pc = lane & (lpr - 1), rr = lane / lpr;
            for (int i = 0; i < 32 / rpi; ++i) { const int sl = w * 32 + i * rpi + rr, nn = J.n0 + (sl & 63) * 4 + (sl >> 6);
                int row = nn; if (J.F) { const int part = nn >= J.F ? 1 : 0, j = nn - part * J.F; row = 256 * (j >> 7) + (j & 127) + 128 * part; }
                const u32x4 d = *(const LAS u32x4*)(IMG + sl * PITCH + 16 * pc);
                unsigned char* o = J.dst + (size_t)row * J.pitch + J.kbyte + 16 * pc;
                *(u32x4*)o = d; if (J.fmt == 2) *(u32x4*)(o + 128) = (u32x4){0u, 0u, 0u, 0u}; }
        }
        LDS_WAIT(); __syncthreads();
        if (!has) break;
        J = Jn; jb = nx;
    }
#undef TJ_ISSUE
}
__device__ __forceinline__ int pack_i8x4(f32x4 v) {
    const int a = (int)rintf(v[0]), b = (int)rintf(v[1]), c = (int)rintf(v[2]), d = (int)rintf(v[3]);
    return (a & 0xff) | ((b & 0xff) << 8) | ((c & 0xff) << 16) | (d << 24);
}
__device__ __forceinline__ float wave_max(float v) {
#pragma unroll
    for (int o = 1; o < 64; o <<= 1) v = fmaxf(v, __shfl_xor(v, o));
    return v;
}
struct StripJob { const float* src; const float* ks; unsigned char* dst; float* sw; int srcld; };
__device__ __forceinline__ StripJob strip_make(const Params& PA, unsigned char* ws, int l, int st) {
    StripJob J;
    if (st < 384) { const int c0 = st * 32; J.srcld = 12288; J.src = PA.in[1] + (size_t)l * D * 12288 + c0; J.ks = PA.in[11] + (size_t)(2 * l) * D;
        J.dst = c0 < 4096 ? ws + WS_WQKG + l * SZ_WQKG + (size_t)c0 * D : (c0 < 8192 ? ws + WS_WVT + l * SZ_WVT + (size_t)(c0 - 4096) * D : ws + WS_WQKG + l * SZ_WQKG + (size_t)(c0 - 4096) * D);
        J.sw = c0 < 4096 ? (float*)(ws + WS_SWQ + l * SZ_SWL) + c0 : (c0 < 8192 ? (float*)(ws + WS_SWV + l * SZ_SWL) + (c0 - 4096) : (float*)(ws + WS_SWQ + l * SZ_SWL) + (c0 - 4096));
    } else if (st < 736) { const int s4 = st - 384, part = s4 / 176, j0 = (s4 % 176) * 32, drow = 256 * (j0 >> 7) + (j0 & 127) + 128 * part; J.srcld = 2 * FF;
        J.src = PA.in[6] + (size_t)l * D * 2 * FF + part * FF + j0; J.ks = PA.in[12] + (size_t)(2 * l) * D; J.dst = ws + WS_WGU + l * SZ_WGU + (size_t)drow * D; J.sw = (float*)(ws + WS_SWGU + l * SZ_SWL) + drow;
    } else { const int sm = st - 736, e = sm / 88, s4 = sm % 88, part = s4 / 44, j0 = (s4 % 44) * 32, drow = 256 * (j0 >> 7) + (j0 & 127) + 128 * part; J.srcld = 2 * FE;
        J.src = PA.in[9] + ((size_t)l * NE + e) * D * 2 * FE + part * FE + j0; J.ks = nullptr; J.dst = ws + WS_WMGU + l * SZ_WMGU + (size_t)e * 2 * FE * D + (size_t)drow * D; J.sw = (float*)(ws + WS_SWM) + (l * NE + e) * 2 * FE + drow; }
    return J;
}
template <bool DYN>
__device__ __forceinline__ void strip_loop(Frame& F_, const Params& PA, int l, int first, int end, int step, int base, int qi) {
    Frame F = F_; { int t_ = mk_tid(F_.wv); asm volatile("" : "+v"(t_)); F.tid = t_; F.lane = t_ & 63; F.wave = __builtin_amdgcn_readfirstlane(t_ >> 6); }
    constexpr int PITCH = 4104;
    LAS unsigned char* T = F.lds;
    LAS float* smax = (LAS float*)(F.lds + MISC_OFF + 1024);
    LAS float* cfin = smax + 256;
    volatile LAS unsigned* slot = (volatile LAS unsigned*)(F.lds + MISC_OFF + 512);
    unsigned* q = (unsigned*)(F.ws + WS_CTL) + CW_Q + 512 * 5 + 64 * qi;
    const int lane = F.lane, cq = lane & 7, r8 = lane >> 3;
    int st = first;
    if (DYN) { if (F.tid == 0) slot[0] = __hip_atomic_fetch_add(q, 1u, __ATOMIC_RELAXED, __HIP_MEMORY_SCOPE_AGENT);
        __syncthreads(); st = (int)slot[0]; __syncthreads(); }
    if (st >= end) return;
    StripJob J = strip_make(PA, F.ws, l, base + st);
    u32x4 va[16], vb[16]; float gq[4];
#define W8_ISSUE(JJ, LIVE) do { const __amdgpu_buffer_rsrc_t rs_ = __builtin_amdgcn_make_buffer_rsrc((void*)(JJ).src, 0, (LIVE) ? (D - 1) * (JJ).srcld * 4 + 128 : 0, 0x00020000);     \
        const int voff_ = (r8 * (JJ).srcld + 4 * cq) * 4, sbase_ = F.wave * 256 * (JJ).srcld * 4, sstep_ = 8 * (JJ).srcld * 4; \
        { const float* ksp_ = (JJ).ks ? (JJ).ks : PA.in[11]; const float one_ = (JJ).ks ? 0.0f : 1.0f, keep_ = (JJ).ks ? 1.0f : 0.0f;     \
          _Pragma("unroll") for (int t = 0; t < 4; ++t) gq[t] = ksp_[F.wave * 256 + t * 64 + lane] * keep_ + one_; } \
        _Pragma("unroll") for (int it = 0; it < 16; ++it) va[it] = __builtin_amdgcn_raw_buffer_load_b128(rs_, voff_, sbase_ + it * sstep_, 0); \
        _Pragma("unroll") for (int it = 0; it < 16; ++it) vb[it] = __builtin_amdgcn_raw_buffer_load_b128(rs_, voff_, sbase_ + (16 + it) * sstep_, 0); } while (0)
    W8_ISSUE(J, true);
    for (;;) {
        f32x4 cm = (f32x4){0.f, 0.f, 0.f, 0.f};
#pragma unroll
        for (int ch = 0; ch < 2; ++ch)
#pragma unroll
            for (int it = 0; it < 16; ++it) { const int j = ch * 16 + it, kk = F.wave * 256 + j * 8 + r8;
                const float g = __shfl(gq[j >> 3], (j & 7) * 8 + r8);
                const f32x4 w = __builtin_bit_cast(f32x4, ch ? vb[it] : va[it]) * g;
                cm[0] = fmaxf(cm[0], fabsf(w[0])); cm[1] = fmaxf(cm[1], fabsf(w[1])); cm[2] = fmaxf(cm[2], fabsf(w[2])); cm[3] = fmaxf(cm[3], fabsf(w[3]));
                const unsigned p01 = cvt_pk_bf16(w[0], w[1]), p23 = cvt_pk_bf16(w[2], w[3]);
                LAS unsigned short* p = (LAS unsigned short*)(T + (4 * cq) * PITCH + kk * 2);
                p[0] = (unsigned short)p01; p[PITCH / 2] = (unsigned short)(p01 >> 16); p[PITCH] = (unsigned short)p23; p[3 * PITCH / 2] = (unsigned short)(p23 >> 16); }
        if (DYN) { if (F.tid == 0) slot[0] = __hip_atomic_fetch_add(q, 1u, __ATOMIC_RELAXED, __HIP_MEMORY_SCOPE_AGENT); }
#pragma unroll
        for (int j = 0; j < 4; ++j) { cm[j] = fmaxf(cm[j], __shfl_xor(cm[j], 8)); cm[j] = fmaxf(cm[j], __shfl_xor(cm[j], 16)); cm[j] = fmaxf(cm[j], __shfl_xor(cm[j], 32)); }
        if (lane < 8) { LAS float* p = smax + F.wave * 32 + lane * 4; p[0] = cm[0]; p[1] = cm[1]; p[2] = cm[2]; p[3] = cm[3]; }
        LDS_WAIT(); __syncthreads();
        const int nx = DYN ? (int)slot[0] : st + step;
        const bool has = nx < end;
        const StripJob Jn = strip_make(PA, F.ws, l, base + (has ? nx : st));
        W8_ISSUE(Jn, has);
        if (F.tid < 32) { float m = 1e-30f;
#pragma unroll
            for (int w = 0; w < 8; ++w) m = fmaxf(m, smax[w * 32 + F.tid]);
            cfin[F.tid] = m; J.sw[F.tid] = m * (1.0f / 127.0f); }
        LDS_WAIT(); __syncthreads();
#pragma unroll
        for (int rr = 0; rr < 4; ++rr) { const int c = F.wave * 4 + rr; const float qs = 127.0f / cfin[c];
#pragma unroll
            for (int i = 0; i < 4; ++i) { const int k0 = (i * 64 + lane) * 8;
                const u32x2 a = *(const LAS u32x2*)(T + c * PITCH + k0 * 2), b = *(const LAS u32x2*)(T + c * PITCH + k0 * 2 + 8);
                u32x2 o; o.x = (unsigned)pack_i8x4(bf4(a) * qs); o.y = (unsigned)pack_i8x4(bf4(b) * qs);
                *(u32x2*)(J.dst + (size_t)c * D + k0) = o; } }
        LDS_WAIT(); __syncthreads();
        if (!has) break;
        J = Jn; st = nx;
    }
#undef W8_ISSUE
}
__device__ __forceinline__ void p0_row(const int lane, const int row, const f32x4 (&v)[8], bf16_t* X, bf16_t* XB, float* SA) {
    float s = 0.f;
#pragma unroll
    for (int j = 0; j < 8; ++j) s += (v[j][0] * v[j][0] + v[j][1] * v[j][1]) + (v[j][2] * v[j][2] + v[j][3] * v[j][3]);
    const float inv = 1.0f / sqrtf(wave_sum(s) * (1.0f / D) + EPS);
    if (I8A1 & 1) {
        float mx = 0.f;
#pragma unroll
        for (int j = 0; j < 8; ++j) mx = fmaxf(mx, fmaxf(fmaxf(fabsf(v[j][0]), fabsf(v[j][1])), fmaxf(fabsf(v[j][2]), fabsf(v[j][3]))));
        mx = fmaxf(wave_max(mx) * inv, 1e-20f); const float q = inv * 127.0f / mx;
#pragma unroll
        for (int j = 0; j < 8; ++j) { { u32x2 w; w.x = cvt_pk_bf16(v[j][0], v[j][1]); w.y = cvt_pk_bf16(v[j][2], v[j][3]); ((u32x2*)(X + (size_t)row * D) + lane)[64 * j] = w; }
            ((int*)((unsigned char*)XB + (size_t)row * D) + lane)[64 * j] = pack_i8x4(v[j] * q); }
        if (lane == 0) SA[row] = mx * (1.0f / 127.0f);
    } else {
#pragma unroll
        for (int j = 0; j < 8; ++j) { { u32x2 w; w.x = cvt_pk_bf16(v[j][0], v[j][1]); w.y = cvt_pk_bf16(v[j][2], v[j][3]); ((u32x2*)(X + (size_t)row * D) + lane)[64 * j] = w; }
            u32x2 w; w.x = cvt_pk_bf16(v[j][0] * inv, v[j][1] * inv); w.y = cvt_pk_bf16(v[j][2] * inv, v[j][3] * inv); ((u32x2*)(XB + (size_t)row * D) + lane)[64 * j] = w; }
    }
}
__device__ __forceinline__ void p0_prologue(Frame& F_, const Params& PA) {
    Frame F = F_; { int t_ = mk_tid(F_.wv); asm volatile("" : "+v"(t_)); F.tid = t_; F.lane = t_ & 63; F.wave = __builtin_amdgcn_readfirstlane(t_ >> 6); }
    unsigned char* ws = F.ws;
    const int gw = F.bid * 8 + F.wave, NGW = F.G * 8;
    {
        const int n1 = (I8A1 & 1) ? 384 : 0, n4 = (I8A4 & 1) ? 352 : 0;
        if (n1 + n4 > 0) strip_loop<false>(F_, PA, 0, F.bid, n1 + n4, F.G, (I8A1 & 1) ? 0 : 384, 0);
    }
    tile_loop<true>(F_, PA, 0, 0, 0);
    bf16_t* X = (bf16_t*)(ws + WS_X); bf16_t* XB = (bf16_t*)(ws + WS_XB);
#define P0_LOAD(V, row_) do { const f32x4* xr_ = (const f32x4*)(PA.in[0] + (size_t)(row_) * D) + F.lane; _Pragma("unroll") for (int j = 0; j < 8; ++j) V[j] = xr_[64 * j]; } while (0)
    {
        int row = gw; f32x4 va[8], vb[8];
        if (row < NT) { P0_LOAD(va, row);
            for (;;) {
                int nrow = row + NGW; bool has = nrow < NT;
                if (has) P0_LOAD(vb, nrow);
                p0_row(F.lane, row, va, X, XB, (float*)(ws + WS_SA));
                if (!has) break;
                row = nrow; nrow = row + NGW; has = nrow < NT;
                if (has) P0_LOAD(va, nrow);
                p0_row(F.lane, row, vb, X, XB, (float*)(ws + WS_SA));
                if (!has) break;
                row = nrow;
            } }
    }
#undef P0_LOAD
    if (F.bid == 0) { float* DQ = (float*)(ws + WS_DQ); float* DKS = (float*)(ws + WS_DKS);
        for (int i = F.tid; i < NH * 128; i += 512) { const int h = i >> 7, j = i & 127; const double lg = log1p(-exp2(-5.0 - (double)h)); const float lgf = (float)lg;
            DQ[i] = expf((float)j * lgf); DKS[i] = expf(-(float)j * lgf) * 0.0625f;
            ((float*)(ws + WS_DQ8))[i] = expf((float)(j - 64) * lgf); ((float*)(ws + WS_DKS8))[i] = expf((float)(64 - j) * lgf) * 0.0625f; if (j == 0) ((float*)(ws + WS_LG2))[h] = (float)(lg * 1.4426950408889634); } }
}

__device__ __forceinline__ void retention_phase(Frame& F, const bf16_t* QB, const bf16_t* KB, const bf16_t* VT, const bf16_t* GB, const float* normg, bf16_t* OG, const int og8) {
    using namespace pg8;
    LAS unsigned char* lds = F.lds;
    int tid = mk_tid(F.wv); asm volatile("" : "+v"(tid));
    const int wid = __builtin_amdgcn_readfirstlane(tid >> 6), lane = tid & 63, wr = wid >> 2, wc = wid & 3;
    unsigned voffQ[2], voffV[2];
#pragma unroll
    for (int i = 0; i < 2; ++i) { int R, C; stage_rc(tid * 16 + i * 8192, R, C); const int Rb = (R & ~31) + perm32(R & 31);
        voffQ[i] = (unsigned)(R * QKW + C) * 2u; voffV[i] = (unsigned)(Rb * NT + C) * 2u; }
    const unsigned ldsw = (unsigned)wid * 1024u;
    const int aoff = lds_byte(wr * 64 + (lane & 15), (lane >> 4) * 8), boff = lds_byte(wc * 32 + (lane & 15), (lane >> 4) * 8);
    constexpr int PIMG = 6 * HTB;
    LAS float* red = (LAS float*)(lds + MISC_OFF + 256);
    const __amdgpu_buffer_rsrc_t rsQ = __builtin_amdgcn_make_buffer_rsrc((void*)QB, 0, NT * QKW * 2, 0x00020000);
    const __amdgpu_buffer_rsrc_t rsK = __builtin_amdgcn_make_buffer_rsrc((void*)KB, 0, NT * QKW * 2, 0x00020000);
    const __amdgpu_buffer_rsrc_t rsV = __builtin_amdgcn_make_buffer_rsrc((void*)VT, 0, VW * NT * 2, 0x00020000);
#define RT_STAGE(bufoff, rsrc, soff, voff) do { _Pragma("unroll") for (int _i = 0; _i < 2; ++_i) \
        __builtin_amdgcn_raw_ptr_buffer_load_lds((rsrc), (LAS unsigned*)(lds + (bufoff) + ldsw + _i * 8192), 16, (voff)[_i], (soff), 0, 0); } while (0)
#define RT_BAR __builtin_amdgcn_s_barrier()
    for (int it = F.bid; it < 256; it += F.G) {
        const int item = (it & 7) * 32 + (it >> 3);
        const int b = item >> 6, h = (item >> 3) & 7, x = item & 7;
        const float lg2 = ((const float*)(F.ws + WS_LG2))[h];
        const int koff = (b * SEQ * QKW + h * DK) * 2, voff0 = (h * DV * NT + b * SEQ) * 2;
        for (int qs = 0; qs < 2; ++qs) {
            const int qc = qs == 0 ? 15 - x : x, nkv = qc + 1, total = 8 * nkv;
            const int qoff = ((b * SEQ + qc * 128) * QKW + h * DK) * 2;
            f32x4 O[4][4][2], P[4][2];
#pragma unroll
            for (int c = 0; c < 4; ++c)
#pragma unroll
                for (int m = 0; m < 4; ++m)
#pragma unroll
                    for (int n = 0; n < 2; ++n) O[c][m][n] = (f32x4){0.f, 0.f, 0.f, 0.f};
#define RT_STAGE_STEP(sv) do { const int _s = (sv); const int _kt = _s >> 3, _sub = _s & 7, _bo = (_s % 3) * 2 * HTB; \
                if (_sub < 4) { RT_STAGE(_bo, rsQ, qoff + _sub * 128, voffQ); RT_STAGE(_bo + HTB, rsK, koff + _kt * (128 * QKW * 2) + _sub * 128, voffQ); } \
                else { const int _vo = voff0 + (_sub - 4) * (128 * NT * 2) + _kt * 256; RT_STAGE(_bo, rsV, _vo, voffV); RT_STAGE(_bo + HTB, rsV, _vo + 128, voffV); } } while (0)
            RT_STAGE_STEP(0); RT_STAGE_STEP(1);
            asm volatile("s_waitcnt vmcnt(4)" ::: "memory"); RT_BAR;
            int s = 0;
            for (int kt = 0; kt < nkv; ++kt) {
                const float tscale = __builtin_amdgcn_exp2f((float)(128 * (qc - kt)) * lg2);
                const bool diag = (kt == qc);
#pragma unroll
                for (int sub = 0; sub < 8; ++sub, ++s) {
                    __builtin_amdgcn_sched_barrier(0);
                    if (s + 2 < total) RT_STAGE_STEP(s + 2);
                    const int bo = (s % 3) * 2 * HTB;
                    if (sub < 4) {
                        if (sub == 0) {
#pragma unroll
                            for (int m = 0; m < 4; ++m)
#pragma unroll
                                for (int n = 0; n < 2; ++n) P[m][n] = (f32x4){0.f, 0.f, 0.f, 0.f};
                        }
                        bf16x8 Bt[2][2];
#pragma unroll
                        for (int n = 0; n < 2; ++n)
#pragma unroll
                            for (int k = 0; k < 2; ++k) Bt[n][k] = *(const LAS bf16x8*)(lds + bo + HTB + boff + n * 2048 + k * 1024);
#pragma unroll
                        for (int mh = 0; mh < 2; ++mh) {
                            bf16x8 At[2][2];
#pragma unroll
                            for (int m = 0; m < 2; ++m)
#pragma unroll
                                for (int k = 0; k < 2; ++k) At[m][k] = *(const LAS bf16x8*)(lds + bo + aoff + (mh * 2 + m) * 2048 + k * 1024);
#pragma unroll
                            for (int m = 0; m < 2; ++m)
#pragma unroll
                                for (int n = 0; n < 2; ++n)
#pragma unroll
                                    for (int k = 0; k < 2; ++k) P[mh * 2 + m][n] = __builtin_amdgcn_mfma_f32_16x16x32_bf16(Bt[n][k], At[m][k], P[mh * 2 + m][n], 0, 0, 0);
                            __builtin_amdgcn_sched_barrier(0);
                        }
                        if (sub == 3) {
                            int ln = lane; asm volatile("" : "+v"(ln)); const int fr = ln & 15, fq = ln >> 4;
#pragma unroll
                            for (int m = 0; m < 4; ++m) { const int i = wr * 64 + m * 16 + fr;
#pragma unroll
                                for (int n = 0; n < 2; ++n) { const int j0 = wc * 32 + n * 16 + fq * 4; f32x4 v = P[m][n] * tscale;
                                    if (diag) { int dd = i - j0; asm volatile("" : "+v"(dd));
#pragma unroll
                                        for (int e = 0; e < 4; ++e) v[e] = (e > dd) ? 0.f : v[e]; }
                                    u32x2 w; w.x = cvt_pk_bf16(v[0], v[1]); w.y = cvt_pk_bf16(v[2], v[3]);
                                    *(LAS u32x2*)(lds + PIMG + (wc >> 1) * HTB + lds_byte(i, (wc & 1) * 32 + n * 16 + fq * 4)) = w; } }
                        }
                    } else {
#pragma unroll
                        for (int k2 = 0; k2 < 2; ++k2) {
                            bf16x8 Bt[2][2];
#pragma unroll
                            for (int n = 0; n < 2; ++n)
#pragma unroll
                                for (int k = 0; k < 2; ++k) Bt[n][k] = *(const LAS bf16x8*)(lds + bo + k2 * HTB + boff + n * 2048 + k * 1024);
#pragma unroll
                            for (int mh = 0; mh < 2; ++mh) {
                                bf16x8 At[2][2];
#pragma unroll
                                for (int m = 0; m < 2; ++m)
#pragma unroll
                                    for (int k = 0; k < 2; ++k) At[m][k] = *(const LAS bf16x8*)(lds + PIMG + k2 * HTB + aoff + (mh * 2 + m) * 2048 + k * 1024);
#pragma unroll
                                for (int m = 0; m < 2; ++m)
#pragma unroll
                                    for (int n = 0; n < 2; ++n)
#pragma unroll
                                        for (int k = 0; k < 2; ++k) O[sub - 4][mh * 2 + m][n] = __builtin_amdgcn_mfma_f32_16x16x32_bf16(Bt[n][k], At[m][k], O[sub - 4][mh * 2 + m][n], 0, 0, 0);
                                __builtin_amdgcn_sched_barrier(0);
                            }
                        }
                    }
                    if (s + 2 < total) asm volatile("s_waitcnt vmcnt(4) lgkmcnt(0)" ::: "memory"); else asm volatile("s_waitcnt vmcnt(0) lgkmcnt(0)" ::: "memory");
                    RT_BAR;
                }
            }
            int ln = lane; asm volatile("" : "+v"(ln)); const int fr = ln & 15, fq = ln >> 4;
#pragma unroll
            for (int m = 0; m < 4; ++m) { float ss = 0.f;
#pragma unroll
                for (int c = 0; c < 4; ++c)
#pragma unroll
                    for (int n = 0; n < 2; ++n) { const f32x4 o = O[c][m][n]; ss += (o[0] * o[0] + o[1] * o[1]) + (o[2] * o[2] + o[3] * o[3]); }
                ss += __shfl_xor(ss, 16); ss += __shfl_xor(ss, 32);
                if (fq == 0) red[(wr * 64 + m * 16 + fr) * 4 + wc] = ss; }
            LDS_WAIT(); RT_BAR;
#pragma unroll
            for (int m = 0; m < 4; ++m) { const int i = wr * 64 + m * 16 + fr; const f32x4 pr = *(const LAS f32x4*)(red + i * 4);
                const float inv = __builtin_amdgcn_rsqf(((pr[0] + pr[1]) + (pr[2] + pr[3])) * (1.0f / DV) + EPS);
                const size_t tok = (size_t)b * SEQ + (size_t)qc * 128 + i;
#pragma unroll
                for (int c = 0; c < 4; ++c) { const int col = h * DV + c * 128 + wc * 32 + fq * 8;
                    const u32x4 gw = *(const u32x4*)(GB + tok * VW + col); const f32x4 n0 = *(const f32x4*)(normg + col), n1 = *(const f32x4*)(normg + col + 4);
                    const f32x4 o0 = O[c][m][0] * inv * n0, o1 = O[c][m][1] * inv * n1;
                    float gv[8] = {bf_lo(gw.x), bf_hi(gw.x), bf_lo(gw.y), bf_hi(gw.y), bf_lo(gw.z), bf_hi(gw.z), bf_lo(gw.w), bf_hi(gw.w)};
                    float r[8];
#pragma unroll
                    for (int e = 0; e < 4; ++e) { r[e] = o0[e] * gv[e] * fast_sigmoid(gv[e]); r[4 + e] = o1[e] * gv[4 + e] * fast_sigmoid(gv[4 + e]); }
                    if (og8) { int w0 = 0, w1 = 0; w0 = __builtin_amdgcn_cvt_pk_fp8_f32(r[0], r[1], w0, false); w0 = __builtin_amdgcn_cvt_pk_fp8_f32(r[2], r[3], w0, true);
                        w1 = __builtin_amdgcn_cvt_pk_fp8_f32(r[4], r[5], w1, false); w1 = __builtin_amdgcn_cvt_pk_fp8_f32(r[6], r[7], w1, true); u32x2 w; w.x = (unsigned)w0; w.y = (unsigned)w1;
                        *(u32x2*)((unsigned char*)OG + tok * VW + col) = w; }
                    else { u32x4 w; w.x = cvt_pk_bf16(r[0], r[1]); w.y = cvt_pk_bf16(r[2], r[3]); w.z = cvt_pk_bf16(r[4], r[5]); w.w = cvt_pk_bf16(r[6], r[7]);
                        *(u32x4*)(OG + tok * VW + col) = w; } } }
            VM_WAIT(); RT_BAR;
        }
    }
#undef RT_STAGE
#undef RT_STAGE_STEP
#undef RT_BAR
}

__device__ __forceinline__ void mfma8(f32x4& c, const i32x8& a, const i32x8& b, int sc) { asm volatile("v_mfma_f32_16x16x128_f8f6f4 %0, %1, %2, %0" : "+v"(c) : "v"(a), "v"(b)); (void)sc; }
__device__ __forceinline__ void retention8_phase(Frame& F, const unsigned char* Q8, const unsigned char* K8, const unsigned char* VT8, const bf16_t* GB, const float* normg, bf16_t* OG, const int og8) {
    using namespace pg8;
    LAS unsigned char* lds = F.lds;
    int tid = mk_tid(F.wv); asm volatile("" : "+v"(tid));
    const int wid = __builtin_amdgcn_readfirstlane(tid >> 6), lane = tid & 63, wr = wid >> 2, wc = wid & 3;
    unsigned voffQ[2], voffV[2];
#pragma unroll
    for (int i = 0; i < 2; ++i) { int R, C; stage_rc(tid * 16 + i * 8192, R, C); const int Rb = (R & ~31) + perm32(R & 31);
        voffQ[i] = (unsigned)(R * QKW + C * 2); voffV[i] = (unsigned)(Rb * NT + C * 2); }
    const unsigned ldsw = (unsigned)wid * 1024u;
    const int aoff = lds_byte(wr * 64 + (lane & 15), (lane >> 4) * 8), boff = lds_byte(wc * 32 + (lane & 15), (lane >> 4) * 8);
    constexpr int PIMG = 6 * HTB;
    LAS float* red = (LAS float*)(lds + MISC_OFF + 256);
    int f8scale = 0x7f7f7f7f; asm volatile("" : "+v"(f8scale));
    const __amdgpu_buffer_rsrc_t rsQ = __builtin_amdgcn_make_buffer_rsrc((void*)Q8, 0, NT * QKW, 0x00020000);
    const __amdgpu_buffer_rsrc_t rsK = __builtin_amdgcn_make_buffer_rsrc((void*)K8, 0, NT * QKW, 0x00020000);
    const __amdgpu_buffer_rsrc_t rsV = __builtin_amdgcn_make_buffer_rsrc((void*)VT8, 0, VW * NT, 0x00020000);
#define RT_STAGE(bufoff, rsrc, soff, voff) do { _Pragma("unroll") for (int _i = 0; _i < 2; ++_i) \
        __builtin_amdgcn_raw_ptr_buffer_load_lds((rsrc), (LAS unsigned*)(lds + (bufoff) + ldsw + _i * 8192), 16, (voff)[_i], (soff), 0, 0); } while (0)
#define RT_BAR __builtin_amdgcn_s_barrier()
#define RT_LD16(off) (*(const LAS i32x4*)(lds + (off)))
    for (int it = F.bid; it < 256; it += F.G) {
        const int item = (it & 7) * 32 + (it >> 3);
        const int b = item >> 6, h = (item >> 3) & 7, x = item & 7;
        const float lg2 = ((const float*)(F.ws + WS_LG2))[h];
        const int koff = b * SEQ * QKW + h * DK, voff0 = h * DV * NT + b * SEQ;
        for (int qs = 0; qs < 2; ++qs) {
            const int qc = qs == 0 ? 15 - x : x, nkv = qc + 1, total = 4 * nkv;
            const int qoff = (b * SEQ + qc * 128) * QKW + h * DK;
            f32x4 O[4][4][2], P[4][2]; i32x8 Apf[4];
#pragma unroll
            for (int c = 0; c < 4; ++c)
#pragma unroll
                for (int m = 0; m < 4; ++m)
#pragma unroll
                    for (int n = 0; n < 2; ++n) O[c][m][n] = (f32x4){0.f, 0.f, 0.f, 0.f};
#define RT_STAGE_STEP(sv) do { const int _s = (sv); const int _kt = _s >> 2, _sub = _s & 3, _bo = (_s % 3) * 2 * HTB; \
                if (_sub < 2) { RT_STAGE(_bo, rsQ, qoff + _sub * 128, voffQ); RT_STAGE(_bo + HTB, rsK, koff + _kt * (128 * QKW) + _sub * 128, voffQ); } \
                else { const int _vo = voff0 + (_sub - 2) * (256 * NT) + _kt * 128; RT_STAGE(_bo, rsV, _vo, voffV); RT_STAGE(_bo + HTB, rsV, _vo + 128 * NT, voffV); } } while (0)
            RT_STAGE_STEP(0); RT_STAGE_STEP(1);
            asm volatile("s_waitcnt vmcnt(4)" ::: "memory"); RT_BAR;
            int s = 0;
            for (int kt = 0; kt < nkv; ++kt) {
                const float tscale = __builtin_amdgcn_exp2f((float)(128 * (qc - kt)) * lg2);
                const bool diag = (kt == qc);
#pragma unroll
                for (int sub = 0; sub < 4; ++sub, ++s) {
                    __builtin_amdgcn_sched_barrier(0);
                    if (s + 2 < total) RT_STAGE_STEP(s + 2);
                    const int bo = (s % 3) * 2 * HTB;
                    if (sub < 2) {
                        if (sub == 0) {
#pragma unroll
                            for (int m = 0; m < 4; ++m)
#pragma unroll
                                for (int n = 0; n < 2; ++n) P[m][n] = (f32x4){0.f, 0.f, 0.f, 0.f};
                        }
                        i32x8 Bt[2], At[4];
#pragma unroll
                        for (int n = 0; n < 2; ++n) { Bt[n].lo = RT_LD16(bo + HTB + boff + n * 2048); Bt[n].hi = RT_LD16(bo + HTB + boff + n * 2048 + 1024); }
#pragma unroll
                        for (int m = 0; m < 4; ++m) { At[m].lo = RT_LD16(bo + aoff + m * 2048); At[m].hi = RT_LD16(bo + aoff + m * 2048 + 1024); }
#pragma unroll
                        for (int m = 0; m < 4; ++m)
#pragma unroll
                            for (int n = 0; n < 2; ++n) mfma8(P[m][n], Bt[n], At[m], f8scale);
                        __builtin_amdgcn_sched_barrier(0);
                        if (sub == 1) {
                            asm volatile("s_nop 15\n\ts_nop 7" ::: "memory"); __builtin_amdgcn_sched_barrier(0);
                            int ln = lane; asm volatile("" : "+v"(ln)); const int fr = ln & 15, fq = ln >> 4;
#pragma unroll
                            for (int m = 0; m < 4; ++m) { const int i = wr * 64 + m * 16 + fr;
#pragma unroll
                                for (int n = 0; n < 2; ++n) { const int j0 = wc * 32 + n * 16 + fq * 4; f32x4 v = P[m][n] * tscale;
                                    if (diag) { int dd = i - j0; asm volatile("" : "+v"(dd));
#pragma unroll
                                        for (int e = 0; e < 4; ++e) v[e] = (e > dd) ? 0.f : v[e]; }
                                    int w = 0; w = __builtin_amdgcn_cvt_pk_fp8_f32(v[0], v[1], w, false); w = __builtin_amdgcn_cvt_pk_fp8_f32(v[2], v[3], w, true);
                                    *(LAS int*)(lds + PIMG + lds_byte(i, j0 >> 1)) = w; } }
                        }
                    } else {
                        if (sub == 2) {
#pragma unroll
                            for (int m = 0; m < 4; ++m) { Apf[m].lo = RT_LD16(PIMG + aoff + m * 2048); Apf[m].hi = RT_LD16(PIMG + aoff + m * 2048 + 1024); }
                        }
#pragma unroll
                        for (int ch = 0; ch < 2; ++ch) {
                            i32x8 Bv[2];
#pragma unroll
                            for (int n = 0; n < 2; ++n) { Bv[n].lo = RT_LD16(bo + ch * HTB + boff + n * 2048); Bv[n].hi = RT_LD16(bo + ch * HTB + boff + n * 2048 + 1024); }
#pragma unroll
                            for (int m = 0; m < 4; ++m)
#pragma unroll
                                for (int n = 0; n < 2; ++n) mfma8(O[(sub - 2) * 2 + ch][m][n], Bv[n], Apf[m], f8scale);
                            __builtin_amdgcn_sched_barrier(0);
                        }
                    }
                    if (s + 2 < total) asm volatile("s_waitcnt vmcnt(4) lgkmcnt(0)" ::: "memory"); else asm volatile("s_waitcnt vmcnt(0) lgkmcnt(0)" ::: "memory");
                    RT_BAR;
                }
            }
            asm volatile("s_nop 15\n\ts_nop 7" ::: "memory"); __builtin_amdgcn_sched_barrier(0);
            int ln = lane; asm volatile("" : "+v"(ln)); const int fr = ln & 15, fq = ln >> 4;
#pragma unroll
            for (int m = 0; m < 4; ++m) { float ss = 0.f;
#pragma unroll
                for (int c = 0; c < 4; ++c)
#pragma unroll
                    for (int n = 0; n < 2; ++n) { const f32x4 o = O[c][m][n]; ss += (o[0] * o[0] + o[1] * o[1]) + (o[2] * o[2] + o[3] * o[3]); }
                ss += __shfl_xor(ss, 16); ss += __shfl_xor(ss, 32);
                if (fq == 0) red[(wr * 64 + m * 16 + fr) * 4 + wc] = ss; }
            LDS_WAIT(); RT_BAR;
#pragma unroll
            for (int m = 0; m < 4; ++m) { const int i = wr * 64 + m * 16 + fr; const f32x4 pr = *(const LAS f32x4*)(red + i * 4);
                const float inv = __builtin_amdgcn_rsqf(((pr[0] + pr[1]) + (pr[2] + pr[3])) * (1.0f / DV) + EPS);
                const size_t tok = (size_t)b * SEQ + (size_t)qc * 128 + i;
#pragma unroll
                for (int c = 0; c < 4; ++c) { const int col = h * DV + c * 128 + wc * 32 + fq * 8;
                    const u32x4 gw = *(const u32x4*)(GB + tok * VW + col); const f32x4 n0 = *(const f32x4*)(normg + col), n1 = *(const f32x4*)(normg + col + 4);
                    const f32x4 o0 = O[c][m][0] * inv * n0, o1 = O[c][m][1] * inv * n1;
                    float gv[8] = {bf_lo(gw.x), bf_hi(gw.x), bf_lo(gw.y), bf_hi(gw.y), bf_lo(gw.z), bf_hi(gw.z), bf_lo(gw.w), bf_hi(gw.w)};
                    float r[8];
#pragma unroll
                    for (int e = 0; e < 4; ++e) { r[e] = o0[e] * gv[e] * fast_sigmoid(gv[e]); r[4 + e] = o1[e] * gv[4 + e] * fast_sigmoid(gv[4 + e]); }
                    if (og8) { int w0 = 0, w1 = 0; w0 = __builtin_amdgcn_cvt_pk_fp8_f32(r[0], r[1], w0, false); w0 = __builtin_amdgcn_cvt_pk_fp8_f32(r[2], r[3], w0, true);
                        w1 = __builtin_amdgcn_cvt_pk_fp8_f32(r[4], r[5], w1, false); w1 = __builtin_amdgcn_cvt_pk_fp8_f32(r[6], r[7], w1, true); u32x2 w; w.x = (unsigned)w0; w.y = (unsigned)w1;
                        *(u32x2*)((unsigned char*)OG + tok * VW + col) = w; }
                    else { u32x4 w; w.x = cvt_pk_bf16(r[0], r[1]); w.y = cvt_pk_bf16(r[2], r[3]); w.z = cvt_pk_bf16(r[4], r[5]); w.w = cvt_pk_bf16(r[6], r[7]);
                        *(u32x4*)(OG + tok * VW + col) = w; } } }
            VM_WAIT(); RT_BAR;
        }
    }
#undef RT_STAGE
#undef RT_STAGE_STEP
#undef RT_BAR
#undef RT_LD16
}

template <int W>
__device__ __forceinline__ void pool_rows(const bf16_t* X, const LAS float* rs, bf16_t* MIX, int r0, int s0, int q, int col) {
    f32x4 v[23];
#pragma unroll
    for (int t = 0; t < 23; ++t) { if (t >= 16 - W) { int row = r0 - 15 + 8 * q + t; row = row < 0 ? 0 : row; v[t] = bf4(*(const u32x2*)(X + (size_t)row * D + col)) * rs[8 * q + t]; } }
#pragma unroll
    for (int o = 0; o < 8; ++o) { const int t = 15 + o, s = s0 + 8 * q + o; f32x4 sum = v[t];
#pragma unroll
        for (int d = 1; d < W; ++d) sum = sum + v[t - d];
        const int cnt = (s + 1) < W ? (s + 1) : W; const float ic = 1.0f / (float)cnt;
        const f32x4 mx = sum * ic - v[t];
        u32x2 w; w.x = cvt_pk_bf16(mx[0], mx[1]); w.y = cvt_pk_bf16(mx[2], mx[3]);
        *(u32x2*)(MIX + (size_t)(r0 + 8 * q + o) * D + col) = w; }
}
__device__ __forceinline__ void pool_phase(Frame& F_, const bf16_t* X, const float* ROWSS, bf16_t* MIX) {
    Frame F = F_; { int t_ = mk_tid(F_.wv); asm volatile("" : "+v"(t_)); F.tid = t_; F.lane = t_ & 63; F.wave = __builtin_amdgcn_readfirstlane(t_ >> 6); }
    LAS float* rs = (LAS float*)(F.lds);
    for (int u = F.bid; u < 1024; u += F.G) {
        const int rt = u >> 2, g = u & 3, r0 = rt * 32, s0 = r0 & (SEQ - 1);
        for (int li = F.wave; li < 47; li += 8) { const int s = s0 - 15 + li; int row = r0 - 15 + li; row = row < 0 ? 0 : row;
            float p = (F.lane < 32) ? ROWSS[(size_t)row * 32 + F.lane] : 0.f; p = wave_sum(p);
            if (F.lane == 0) rs[li] = (s >= 0) ? (1.0f / sqrtf(p * (1.0f / D) + EPS)) : 0.f; }
        LDS_WAIT(); __syncthreads();
        const int q = F.tid >> 7, col = g * 512 + (F.tid & 127) * 4;
        if (g == 0) pool_rows<2>(X, rs, MIX, r0, s0, q, col); else if (g == 1) pool_rows<4>(X, rs, MIX, r0, s0, q, col); else if (g == 2) pool_rows<8>(X, rs, MIX, r0, s0, q, col); else pool_rows<16>(X, rs, MIX, r0, s0, q, col);
        __syncthreads();
    }
}

template <int W>
__device__ __forceinline__ void pool_pair(const bf16_t* Z, const LAS float* invt, int li0  , int ra, int sa, int col, f32x4& pa, f32x4& pb) {
    f32x4 S = (f32x4){0.f, 0.f, 0.f, 0.f}, first = S, za = S, zb = S;
#pragma unroll
    for (int k = 0; k <= W; ++k) { int row = ra - W + 1 + k; row = row < 0 ? 0 : row;
        const f32x4 z = bf4(*(const u32x2*)(Z + (size_t)row * D + col)) * invt[li0 - W + 1 + k];
        if (k == 0) first = z; if (k < W) S = S + z; if (k == W - 1) za = z; if (k == W) zb = z; }
    const int ca = (sa + 1) < W ? (sa + 1) : W, cb = (sa + 2) < W ? (sa + 2) : W;
    pa = S * (1.0f / (float)ca) - za; pb = (S - first + zb) * (1.0f / (float)cb) - zb;
}
template <int fp8>
__device__ __forceinline__ void router_phase(Frame& F_, bf16_t* X, const bf16_t* Z, const float* ROWSS, const float* pscale  , const float* router  , const float* gain  , unsigned* counts  , unsigned char* XG, int* TOK, float* GATE, unsigned char* ACTM8, float* SAM) {
    Frame F = F_; { int t_ = mk_tid(F_.wv); asm volatile("" : "+v"(t_)); F.tid = t_; F.lane = t_ & 63; F.wave = __builtin_amdgcn_readfirstlane(t_ >> 6); }
    LAS float* RTt = (LAS float*)(F.lds);
    LAS float* GN = (LAS float*)(F.lds + 65536);
    LAS float* PS = (LAS float*)(F.lds + 73728);
    LAS float* invt = (LAS float*)(F.lds + 81920);
    LAS int* lcnt = (LAS int*)(F.lds + MISC_OFF + 256);
    for (int i = F.tid; i < D * 8; i += 512) { const int c = i >> 3, e = i & 7; RTt[e * D + c] = router[i] * gain[c]; }
    for (int i = F.tid; i < D; i += 512) { GN[i] = gain[i]; PS[i] = pscale[i]; }
    if (fp8 != 0) { for (int i = F.bid * 512 + F.tid; i < NE * NT * 8; i += F.G * 512) *(u32x4*)(ACTM8 + (size_t)(i >> 3) * FE8 + FE + (i & 7) * 16) = (u32x4){0u, 0u, 0u, 0u}; }
    __syncthreads();
    for (int t = F.bid; t < 256; t += F.G) {
        const int r0 = t * 32, s0 = r0 & (SEQ - 1);
        if (F.tid < 16) lcnt[F.tid] = 0;
        for (int li = F.wave; li < 47; li += 8) { const int sp = s0 - 15 + li; int row = r0 - 15 + li; row = row < 0 ? 0 : row;
            float p = (F.lane < 32) ? ROWSS[(size_t)row * 32 + F.lane] : 0.f; p = wave_sum(p);
            if (F.lane == 0) invt[li] = (sp >= 0) ? (1.0f / sqrtf(p * (1.0f / D) + EPS)) : 0.f; }
        LDS_WAIT(); __syncthreads();
        const int rbase = r0 + F.wave * 4;
        int e0[4], e1[4], p0[4], p1[4]; float g0[4], inr[4], mq[4];
#pragma unroll
        for (int pr = 0; pr < 2; ++pr) {
            const int ra = rbase + 2 * pr, sa = ra & (SEQ - 1), li0 = ra - r0 + 15;
            f32x4 xa[8], xb[8];
#pragma unroll
            for (int j = 0; j < 8; ++j) { int ln = F.lane; asm volatile("" : "+v"(ln));
                const int col = 4 * ln + 256 * j; f32x4 pa, pb;
                if (j < 2) pool_pair<2>(Z, invt, li0, ra, sa, col, pa, pb); else if (j < 4) pool_pair<4>(Z, invt, li0, ra, sa, col, pa, pb); else if (j < 6) pool_pair<8>(Z, invt, li0, ra, sa, col, pa, pb); else pool_pair<16>(Z, invt, li0, ra, sa, col, pa, pb);
                const f32x4 ps = *(const LAS f32x4*)(PS + col);
                xa[j] = bf4(*(const u32x2*)(X + (size_t)ra * D + col)) + ps * pa; xb[j] = bf4(*(const u32x2*)(X + (size_t)(ra + 1) * D + col)) + ps * pb;
                u32x2 wa, wb; wa.x = cvt_pk_bf16(xa[j][0], xa[j][1]); wa.y = cvt_pk_bf16(xa[j][2], xa[j][3]); wb.x = cvt_pk_bf16(xb[j][0], xb[j][1]); wb.y = cvt_pk_bf16(xb[j][2], xb[j][3]);
                *(u32x2*)(X + (size_t)ra * D + col) = wa; *(u32x2*)(X + (size_t)(ra + 1) * D + col) = wb;
                if (j == 3 || j == 7) __builtin_amdgcn_sched_barrier(0); }
            float sqa = 0.f, sqb = 0.f;
            if constexpr (fp8 == 2) { float ma = 0.f, mb = 0.f;
#pragma unroll
                for (int j = 0; j < 8; ++j) { const f32x4 gn = *(const LAS f32x4*)(GN + 4 * F.lane + 256 * j); const f32x4 ta = xa[j] * gn, tb = xb[j] * gn;
                    ma = fmaxf(ma, fmaxf(fmaxf(fabsf(ta[0]), fabsf(ta[1])), fmaxf(fabsf(ta[2]), fabsf(ta[3])))); mb = fmaxf(mb, fmaxf(fmaxf(fabsf(tb[0]), fabsf(tb[1])), fmaxf(fabsf(tb[2]), fabsf(tb[3])))); }
                mq[2 * pr] = fmaxf(wave_max(ma), 1e-20f); mq[2 * pr + 1] = fmaxf(wave_max(mb), 1e-20f); }
#pragma unroll
            for (int j = 0; j < 8; ++j) { sqa += (xa[j][0] * xa[j][0] + xa[j][1] * xa[j][1]) + (xa[j][2] * xa[j][2] + xa[j][3] * xa[j][3]); sqb += (xb[j][0] * xb[j][0] + xb[j][1] * xb[j][1]) + (xb[j][2] * xb[j][2] + xb[j][3] * xb[j][3]); }
            const float inva = 1.0f / sqrtf(wave_sum(sqa) * (1.0f / D) + EPS), invb = 1.0f / sqrtf(wave_sum(sqb) * (1.0f / D) + EPS);
            inr[2 * pr] = inva; inr[2 * pr + 1] = invb;
            float lg[2][8];
            {
                float rv[16];
#pragma unroll
                for (int e = 0; e < 8; ++e) { float a0 = 0.f, a1 = 0.f;
#pragma unroll
                    for (int j = 0; j < 8; ++j) { const f32x4 w = *(const LAS f32x4*)(RTt + e * D + 4 * F.lane + 256 * j);
                        a0 += (xa[j][0] * w[0] + xa[j][1] * w[1]) + (xa[j][2] * w[2] + xa[j][3] * w[3]);
                        a1 += (xb[j][0] * w[0] + xb[j][1] * w[1]) + (xb[j][2] * w[2] + xb[j][3] * w[3]); }
                    rv[e] = a0; rv[8 + e] = a1; }
#pragma unroll
                for (int st = 0; st < 4; ++st) { const int n2 = 8 >> st, msk = 32 >> st; const bool up = (F.lane & msk) != 0;
#pragma unroll
                    for (int j = 0; j < n2; ++j) { const float snd = up ? rv[j] : rv[j + n2], kp = up ? rv[j + n2] : rv[j]; rv[j] = kp + __shfl_xor(snd, msk); } }
                rv[0] += __shfl_xor(rv[0], 2); rv[0] += __shfl_xor(rv[0], 1);
#pragma unroll
                for (int i = 0; i < 16; ++i) { const int src = ((i >> 3) & 1) << 5 | ((i >> 2) & 1) << 4 | ((i >> 1) & 1) << 3 | (i & 1) << 2;
                    const float tot = __builtin_bit_cast(float, __builtin_amdgcn_readlane(__builtin_bit_cast(int, rv[0]), src));
                    if (i < 8) lg[0][i] = tot * inva; else lg[1][i - 8] = tot * invb; }
            }
#pragma unroll
            for (int q = 0; q < 2; ++q) { const int rr = 2 * pr + q;
                float v0 = lg[q][0]; int i0 = 0;
#pragma unroll
                for (int e = 1; e < 8; ++e) if (lg[q][e] > v0) { v0 = lg[q][e]; i0 = e; }
                float v1 = -3.0e38f; int i1 = 0;
#pragma unroll
                for (int e = 0; e < 8; ++e) if (e != i0 && lg[q][e] > v1) { v1 = lg[q][e]; i1 = e; }
                e0[rr] = i0; e1[rr] = i1; g0[rr] = 1.0f / (1.0f + expf(v1 - v0));
                int a = 0, bq = 0;
                if (F.lane == 0) { a = atomicAdd((int*)(lcnt + i0), 1); bq = atomicAdd((int*)(lcnt + i1), 1); }
                p0[rr] = __builtin_amdgcn_readfirstlane(a); p1[rr] = __builtin_amdgcn_readfirstlane(bq); }
            __builtin_amdgcn_sched_barrier(0);
        }
        VM_WAIT();
        __syncthreads();
        if (F.tid < 8) lcnt[8 + F.tid] = (int)__hip_atomic_fetch_add(counts + 64 * F.tid, (unsigned)lcnt[F.tid], __ATOMIC_RELAXED, __HIP_MEMORY_SCOPE_AGENT);
        __syncthreads();
#pragma unroll
        for (int rr = 0; rr < 4; ++rr) { const int row = rbase + rr;
            const int q0 = lcnt[8 + e0[rr]] + p0[rr], q1 = lcnt[8 + e1[rr]] + p1[rr];
            const size_t pitch = fp8 ? D : 2 * D;
            float q8 = 0.f; if constexpr (fp8 == 2) q8 = 127.0f / mq[rr];
            unsigned char* d0 = XG + ((size_t)e0[rr] * NT + q0) * pitch; unsigned char* d1 = XG + ((size_t)e1[rr] * NT + q1) * pitch;
            int ln = F.lane; asm volatile("" : "+v"(ln));
            unsigned long long xr[8];
#pragma unroll
            for (int j = 0; j < 8; ++j) xr[j] = *((const unsigned long long*)(X + (size_t)row * D) + ln + 64 * j);
#pragma unroll
            for (int j = 0; j < 8; ++j) { const f32x4 gn = *(const LAS f32x4*)(GN + 4 * ln + 256 * j);
                const unsigned long long xw = xr[j];
                u32x2 xx; xx.x = (unsigned)xw; xx.y = (unsigned)(xw >> 32); const f32x4 hv = bf4(xx) * inr[rr] * gn;
                if constexpr (fp8 == 2) { const int w = pack_i8x4(bf4(xx) * gn * q8); ((unsigned*)d0 + ln)[64 * j] = (unsigned)w; ((unsigned*)d1 + ln)[64 * j] = (unsigned)w; }
                else if constexpr (fp8 != 0) { int w = 0; w = __builtin_amdgcn_cvt_pk_fp8_f32(hv[0], hv[1], w, false); w = __builtin_amdgcn_cvt_pk_fp8_f32(hv[2], hv[3], w, true);
                    ((unsigned*)d0 + ln)[64 * j] = (unsigned)w; ((unsigned*)d1 + ln)[64 * j] = (unsigned)w; }
                else { u32x2 w; w.x = cvt_pk_bf16(hv[0], hv[1]); w.y = cvt_pk_bf16(hv[2], hv[3]); ((u32x2*)d0 + ln)[64 * j] = w; ((u32x2*)d1 + ln)[64 * j] = w; } }
            if constexpr (fp8 == 2) { if (F.lane == 0) { const float sc = mq[rr] * inr[rr] * (1.0f / 127.0f); SAM[e0[rr] * NT + q0] = sc; SAM[e1[rr] * NT + q1] = sc; } }
            if (F.lane == 0) { TOK[e0[rr] * NT + q0] = row * 2; GATE[e0[rr] * NT + q0] = g0[rr]; TOK[e1[rr] * NT + q1] = row * 2 + 1; GATE[e1[rr] * NT + q1] = 1.0f - g0[rr]; }
        }
        __syncthreads();
    }
}

__device__ __forceinline__ void cb_row(const int lane, const int row, const u32x2 (&rx)[8], const u32x2 (&ry0)[8], const u32x2 (&ry1)[8], bf16_t* X, bf16_t* XB, const float* gfinal, float* out, const bool last, const int xb8, const float ys, float* SA) {
    f32x4 v[8]; float s = 0.f;
#pragma unroll
    for (int j = 0; j < 8; ++j) { const u32x2 y0 = ry0[j], y1 = ry1[j];
        v[j] = bf4(rx[j]) + ((f32x4){bf_lo(y0.x), bf_hi(y0.x), bf_lo(y0.y), bf_hi(y0.y)} + (f32x4){bf_lo(y1.x), bf_hi(y1.x), bf_lo(y1.y), bf_hi(y1.y)}) * ys;
        s += (v[j][0] * v[j][0] + v[j][1] * v[j][1]) + (v[j][2] * v[j][2] + v[j][3] * v[j][3]); }
    const float inv = 1.0f / sqrtf(wave_sum(s) * (1.0f / D) + EPS);
    if (last) {
#pragma unroll
        for (int j = 0; j < 8; ++j) { const f32x4 g = ((const f32x4*)gfinal)[lane + 64 * j]; ((f32x4*)(out + (size_t)row * D))[lane + 64 * j] = v[j] * inv * g; }
    } else {
        float q8 = 0.f;
        if (xb8 == 2) { float mx = 0.f;
#pragma unroll
            for (int j = 0; j < 8; ++j) mx = fmaxf(mx, fmaxf(fmaxf(fabsf(v[j][0]), fabsf(v[j][1])), fmaxf(fabsf(v[j][2]), fabsf(v[j][3]))));
            mx = fmaxf(wave_max(mx) * inv, 1e-20f); q8 = inv * 127.0f / mx; if (lane == 0) SA[row] = mx * (1.0f / 127.0f); }
#pragma unroll
        for (int j = 0; j < 8; ++j) { { u32x2 w; w.x = cvt_pk_bf16(v[j][0], v[j][1]); w.y = cvt_pk_bf16(v[j][2], v[j][3]); ((u32x2*)(X + (size_t)row * D))[lane + 64 * j] = w; }
            if (xb8 == 2) ((int*)((unsigned char*)XB + (size_t)row * D) + lane)[64 * j] = pack_i8x4(v[j] * q8);
            else if (xb8) { int w = 0; w = __builtin_amdgcn_cvt_pk_fp8_f32(v[j][0] * inv, v[j][1] * inv, w, false); w = __builtin_amdgcn_cvt_pk_fp8_f32(v[j][2] * inv, v[j][3] * inv, w, true); ((unsigned*)((unsigned char*)XB + (size_t)row * D) + lane)[64 * j] = (unsigned)w; }
            else { u32x2 w; w.x = cvt_pk_bf16(v[j][0] * inv, v[j][1] * inv); w.y = cvt_pk_bf16(v[j][2] * inv, v[j][3] * inv); ((u32x2*)(XB + (size_t)row * D) + lane)[64 * j] = w; } }
    }
}
__device__ __forceinline__ void combine_phase(Frame& F_, bf16_t* X, const bf16_t* Y, bf16_t* XB, const float* gfinal, float* out, bool last, const int xb8  , const float ys, float* SA) {
    Frame F = F_; { int t_ = mk_tid(F_.wv); asm volatile("" : "+v"(t_)); F.tid = t_; F.lane = t_ & 63; F.wave = __builtin_amdgcn_readfirstlane(t_ >> 6); }
    const int gw = F.bid * 8 + F.wave, NGW = F.G * 8;
#define CB_LOAD(RX, RY0, RY1, row_) do { _Pragma("unroll") for (int j = 0; j < 8; ++j) { const size_t o = (size_t)(row_) * D / 4 + F.lane + 64 * j; \
        RX[j] = ((const u32x2*)X)[o]; RY0[j] = ((const u32x2*)Y)[o]; RY1[j] = ((const u32x2*)(Y + (size_t)NT * D))[o]; } } while (0)
    int row = gw; if (row >= NT) return;
    u32x2 ax[8], ay0[8], ay1[8], bx[8], by0[8], by1[8];
    CB_LOAD(ax, ay0, ay1, row);
    for (;;) {
        int nrow = row + NGW; bool has = nrow < NT;
        if (has) CB_LOAD(bx, by0, by1, nrow);
        cb_row(F.lane, row, ax, ay0, ay1, X, XB, gfinal, out, last, xb8, ys, SA);
        if (!has) break;
        row = nrow; nrow = row + NGW; has = nrow < NT;
        if (has) CB_LOAD(ax, ay0, ay1, nrow);
        cb_row(F.lane, row, bx, by0, by1, X, XB, gfinal, out, last, xb8, ys, SA);
        if (!has) break;
        row = nrow;
    }
#undef CB_LOAD
}

__device__ __forceinline__ int compute_cus(int T, int G) { if (T <= 0) return G; const int R = (T + G - 1) / G; int g = (T + R - 1) / R; g = (g + 7) & ~7; return g > G ? G : g; }
__device__ __forceinline__ void q4_row(const int lane, const int row, const float pss, const u32x2 (&rx)[8], unsigned char* XQ, float* SA) {
    const float p = wave_sum(pss); const float inv = 1.0f / sqrtf(p * (1.0f / D) + EPS);
    f32x4 v[8]; float mx = 0.f;
#pragma unroll
    for (int j = 0; j < 8; ++j) { v[j] = bf4(rx[j]) * inv; mx = fmaxf(mx, fmaxf(fmaxf(fabsf(v[j][0]), fabsf(v[j][1])), fmaxf(fabsf(v[j][2]), fabsf(v[j][3])))); }
    mx = fmaxf(wave_max(mx), 1e-20f); const float q = 127.0f / mx;
#pragma unroll
    for (int j = 0; j < 8; ++j) ((int*)(XQ + (size_t)row * D) + lane)[64 * j] = pack_i8x4(v[j] * q);
    if (lane == 0) SA[row] = mx * (1.0f / 127.0f);
}
__device__ __forceinline__ void quant_rows_phase(Frame& F_, const bf16_t* X, const float* ROWSS, unsigned char* XQ, float* SA) {
    Frame F = F_; { int t_ = mk_tid(F_.wv); asm volatile("" : "+v"(t_)); F.tid = t_; F.lane = t_ & 63; F.wave = __builtin_amdgcn_readfirstlane(t_ >> 6); }
    const int gw = F.bid * 8 + F.wave, NGW = F.G * 8;
#define Q4_LOAD(P, RX, row_) do { P = (F.lane < 32) ? ROWSS[(size_t)(row_) * 32 + F.lane] : 0.f; _Pragma("unroll") for (int j = 0; j < 8; ++j) RX[j] = ((const u32x2*)(X + (size_t)(row_) * D) + F.lane)[64 * j]; } while (0)
    int row = gw; if (row >= NT) return;
    u32x2 ax[8], bx[8]; float pa, pb = 0.f;
    Q4_LOAD(pa, ax, row);
    for (;;) {
        int nrow = row + NGW; bool has = nrow < NT;
        if (has) Q4_LOAD(pb, bx, nrow);
        q4_row(F.lane, row, pa, ax, XQ, SA);
        if (!has) break;
        row = nrow; nrow = row + NGW; has = nrow < NT;
        if (has) Q4_LOAD(pa, ax, nrow);
        q4_row(F.lane, row, pb, bx, XQ, SA);
        if (!has) break;
        row = nrow;
    }
#undef Q4_LOAD
}
__global__ void __launch_bounds__(512, 2) trunk_fwd(Params args) {
    extern __shared__ __attribute__((aligned(16))) unsigned char lds_raw[];
    Frame F;
    F.lds = (LAS unsigned char*)lds_raw;
    F.tid = 0; F.lane = 0; F.wave = 0; F.G = gridDim.x; F.bid = blockIdx.x; F.wv = __builtin_amdgcn_readfirstlane((int)(threadIdx.x >> 6));
    F.out = args.out; F.ws = args.ws;
    unsigned char* ws = args.ws;
    unsigned* ctl = (unsigned*)(ws + WS_CTL);
    volatile LAS unsigned* MISC = (volatile LAS unsigned*)(F.lds + MISC_OFF);
    if (threadIdx.x < 64) MISC[threadIdx.x] = 0u;
    __syncthreads();
#if MK_N_LAUNCHES == 1
    constexpr int lo = 0, hi = NPHASE;
#else
    const int lo = args.ph_lo, hi = args.ph_hi;
#endif
    const bool use_bar = (hi - lo) > 1;
    XcdBarrier bar; bar.bar = ctl + CW_BAR; bar.x = 0; bar.st = MISC + 8;
    if (use_bar) bar = xcd_barrier_post(ctl + CW_BAR, MISC + 8);
    bar.wv = F.wv;
#ifndef PHMASK
#define PHMASK 0x1FFF
#endif
#ifndef REPSLOT
#define REPSLOT -1
#endif
#ifndef REPCNT
#define REPCNT 2
#endif
#define NREP(j) (((j) == (REPSLOT)) ? (REPCNT) : 1)
#define EN(j) (((PHMASK) >> (j)) & 1)
#define IN(k) (lo <= (k) && (k) < hi)
#define WS_FRESH do { } while (0)
#define SEAM(k) do { if (IN(k) && IN((k) + 1)) xcd_barrier(bar); } while (0)
    bf16_t* X = (bf16_t*)(ws + WS_X); bf16_t* XB = (bf16_t*)(ws + WS_XB); float* ROWSS = (float*)(ws + WS_ROWSS);
    LAS unsigned char* ring = F.lds;

    if (EN(0) && IN(0)) { _Pragma("unroll 1") for (int rep = 0; rep < NREP(0); ++rep) { p0_prologue(F, args); __syncthreads(); } }
    SEAM(0);

#pragma unroll 1
    for (int l = 0; l < 2; ++l) {
        const int pb = 1 + 11 * l;
        { GAS unsigned char* wg_ = (GAS unsigned char*)ws; asm volatile("" : "+s"(wg_)); ws = (unsigned char*)wg_; }
        ctl = (unsigned*)(ws + WS_CTL); X = (bf16_t*)(ws + WS_X); XB = (bf16_t*)(ws + WS_XB); ROWSS = (float*)(ws + WS_ROWSS); F.ws = ws;
        { int b_ = F.bid, g_ = F.G; asm volatile("" : "+s"(b_), "+s"(g_)); F.bid = b_; F.G = g_; }
        WS_FRESH;
        if (EN(1) && IN(pb + 0)) _Pragma("unroll 1") for (int rep = 0; rep < NREP(1); ++rep) {
            const bool p8 = (PROJ8 >> l) & 1; const int r8 = (RET8 >> l) & 1;
            A1Order S; S.XB = (unsigned)WS_XB; S.WQKG = (unsigned)(WS_WQKG + l * SZ_WQKG); S.WVT = (unsigned)(WS_WVT + l * SZ_WVT); S.G = F.G; S.c = F.bid; S.t = p8 ? 256u * D : 256u * D * 2;
            const bool i8 = (I8A1 >> l) & 1; if (i8) S.t = 256u * D;
            EpiA1 E{(bf16_t*)(ws + WS_QB), (bf16_t*)(ws + WS_KB), (bf16_t*)(ws + WS_GB), (bf16_t*)(ws + WS_VT), (const float*)(ws + (r8 ? WS_DQ8 : WS_DQ)), (const float*)(ws + (r8 ? WS_DKS8 : WS_DKS)), (p8 && !i8) ? 1.0f / 32.0f : 1.0f, r8,
                    i8 ? (const float*)(ws + WS_SA) : nullptr, (const float*)(ws + WS_SWQ + l * SZ_SWL), (const float*)(ws + WS_SWV + l * SZ_SWL)};
            if (i8) pg8::gemm_phase<EpiA1, A1Order, 2>(ring, ws, D, D, D, S, E, F.wv);
            else if (!p8) pg8::gemm_phase<EpiA1, A1Order>(ring, ws, D, D, D, S, E, F.wv);
            else pg8::gemm_phase<EpiA1, A1Order, true>(ring, ws, D, D, D, S, E, F.wv);
        }
        SEAM(pb + 0);
        WS_FRESH;
        if (EN(2) && IN(pb + 1)) _Pragma("unroll 1") for (int rep = 0; rep < NREP(2); ++rep) { if (!((RET8 >> l) & 1)) retention_phase(F, (const bf16_t*)(ws + WS_QB), (const bf16_t*)(ws + WS_KB), (const bf16_t*)(ws + WS_VT), (const bf16_t*)(ws + WS_GB), args.in[2] + (size_t)l * VW, (bf16_t*)(ws + WS_OG), (PROJ8 >> l) & 1);
            else retention8_phase(F, ws + WS_QB, ws + WS_KB, ws + WS_VT, (const bf16_t*)(ws + WS_GB), args.in[2] + (size_t)l * VW, (bf16_t*)(ws + WS_OG), (PROJ8 >> l) & 1); }
        SEAM(pb + 1);
        WS_FRESH;
        if (EN(3) && IN(pb + 2)) _Pragma("unroll 1") for (int rep = 0; rep < NREP(3); ++rep) {
            const bool d8 = ((DENSE8 >> l) & 1) && !((I8A4 >> l) & 1);
            const bool p8 = (PROJ8 >> l) & 1;
            DenseOrder S; S.init(WS_OG, p8 ? VW / 2 : VW, WS_WOUT + l * SZ_WOUT, p8 ? VW / 2 : VW, NT, D, F.G, F.bid);
            EpiRes E{X, nullptr, ROWSS, nullptr, 0, rep ? 0.f : (p8 ? 1.0f / 32.0f : 1.0f), d8 ? (unsigned char*)XB : nullptr};
            if (!p8) pg8::gemm_phase<EpiRes, DenseOrder>(ring, ws, VW, VW, VW, S, E, F.wv);
            else pg8::gemm_phase<EpiRes, DenseOrder, true>(ring, ws, VW, VW, VW, S, E, F.wv);
        }
        SEAM(pb + 2);
        if ((I8A4 >> l) & 1) {
            WS_FRESH;
        if (EN(12) && IN(pb + 3)) _Pragma("unroll 1") for (int rep = 0; rep < NREP(12); ++rep) quant_rows_phase(F, X, ROWSS, ws + WS_XB, (float*)(ws + WS_SA));
            SEAM(pb + 3);
        }
        WS_FRESH;
        if (EN(4) && IN(pb + 4)) _Pragma("unroll 1") for (int rep = 0; rep < NREP(4); ++rep) {
            const int Gc = compute_cus(32 * 44, F.G);
            if (F.bid < Gc) {
                if ((I8A4 >> l) & 1) {
                    DenseOrder S; S.init(WS_XB, D / 2, WS_WGU + l * SZ_WGU, D / 2, NT, 2 * FF, Gc, F.bid);
                    EpiGUi8 E{(bf16_t*)(ws + WS_ACT), FF, (const float*)(ws + WS_SA), (const float*)(ws + WS_SWGU + l * SZ_SWL), (DENSE8 >> l) & 1, 0, 0, 0};
                    pg8::gemm_phase<EpiGUi8, DenseOrder, 2>(ring, ws, D, D, D, S, E, F.wv);
                } else if (!((DENSE8 >> l) & 1)) {
                    DenseOrder S; S.init(WS_X, D, WS_WGU + l * SZ_WGU, D, NT, 2 * FF, Gc, F.bid);
                    EpiGU E{(bf16_t*)(ws + WS_ACT), FF, ROWSS, 0};
                    pg8::gemm_phase<EpiGU, DenseOrder>(ring, ws, D, D, D, S, E, F.wv);
                } else {
                    DenseOrder S; S.init(WS_XB, D / 2, WS_WGU + l * SZ_WGU, D / 2, NT, 2 * FF, Gc, F.bid);
                    EpiGU8 E{ws + WS_ACT, FF, 0, 1.0f / 32.0f, ROWSS};
                    pg8::gemm_phase<EpiGU8, DenseOrder, true>(ring, ws, D, D, D, S, E, F.wv);
                }
            }
            if ((I8B4 >> l) & 1) strip_loop<true>(F, args, l, 0, 704, 0, 736, 1 + l);
            tile_loop<true>(F, args, l == 0 ? 1 : 4, 0, 0); __syncthreads();
        }
        SEAM(pb + 4);
        WS_FRESH;
        if (EN(5) && IN(pb + 5)) _Pragma("unroll 1") for (int rep = 0; rep < NREP(5); ++rep) {
            const bool d8 = (DENSE8 >> l) & 1;
            DenseOrder S; S.init(WS_ACT, d8 ? FF / 2 : FF, WS_WDN + l * SZ_WDN, d8 ? FF / 2 : FF, NT, D, F.G, F.bid);
            EpiRes E{X, nullptr, ROWSS, nullptr, 0, rep ? 0.f : (d8 ? 1.0f / 32.0f : 1.0f), nullptr};
            if (!d8) pg8::gemm_phase<EpiRes, DenseOrder>(ring, ws, FF, FF, FF, S, E, F.wv);
            else pg8::gemm_phase<EpiRes, DenseOrder, true>(ring, ws, FF, FF, FF, S, E, F.wv);
        }
        SEAM(pb + 5);
        WS_FRESH;
        if (EN(6) && IN(pb + 6)) _Pragma("unroll 1") for (int rep = 0; rep < NREP(6); ++rep) {
            PoolOrder S; S.MIX = (unsigned)WS_X; S.W = (unsigned)(WS_WPOOL + l * SZ_WPOOL); S.G = F.G; S.c = F.bid;
            EpiZ E{(bf16_t*)(ws + WS_MIX)};
            pg8::gemm_phase<EpiZ, PoolOrder>(ring, ws, 512, D, 512, S, E, F.wv);
        }
        SEAM(pb + 6);
        unsigned* counts = ctl + CW_CNT + l * 512;
        WS_FRESH;
        if (EN(8) && IN(pb + 7)) _Pragma("unroll 1") for (int rep = 0; rep < NREP(8); ++rep) {
            const float* a_ps = args.in[5] + (size_t)l * D; const float* a_rt = args.in[8] + (size_t)l * D * NE; const float* a_gn = args.in[12] + (size_t)(2 * l + 1) * D;
            constexpr bool all_i8 = (I8B4 & 3) == 3, all_f8 = (F8MASK & 3) == 3;
            if (all_i8 || ((I8B4 >> l) & 1)) router_phase<2>(F, X, (const bf16_t*)(ws + WS_MIX), ROWSS, a_ps, a_rt, a_gn, counts, ws + WS_XG, (int*)(ws + WS_TOK), (float*)(ws + WS_GATE), ws + WS_ACTM, (float*)(ws + WS_SAM));
            else if (all_f8 || ((F8MASK >> l) & 1)) router_phase<1>(F, X, (const bf16_t*)(ws + WS_MIX), ROWSS, a_ps, a_rt, a_gn, counts, ws + WS_XG, (int*)(ws + WS_TOK), (float*)(ws + WS_GATE), ws + WS_ACTM, nullptr);
            else router_phase<0>(F, X, (const bf16_t*)(ws + WS_MIX), ROWSS, a_ps, a_rt, a_gn, counts, ws + WS_XG, (int*)(ws + WS_TOK), (float*)(ws + WS_GATE), ws + WS_ACTM, nullptr);
        }
        SEAM(pb + 7);
        WS_FRESH;
        if (EN(9) && IN(pb + 8)) _Pragma("unroll 1") for (int rep = 0; rep < NREP(9); ++rep) {
            const bool f8 = (F8MASK >> l) & 1;
            MoeOrder S;
            if (!f8) S.init(WS_XG, (size_t)NT * D * 2, D, WS_WMGU + l * SZ_WMGU, (size_t)2 * FE * D * 2, D, 2 * FE / 256, counts, F.G, F.bid);
            else S.init(WS_XG, (size_t)NT * D, D, WS_WMGU + l * SZ_WMGU, (size_t)2 * FE * D, D, 2 * FE / 256, counts, F.G, F.bid, 1);
#ifndef B4GC
#define B4GC 0
#endif
            const int Gc = (l == 0) ? (B4GC ? B4GC : compute_cus(S.total, F.G)) : F.G; S.G = Gc;
            if (F.bid < Gc) {
                if (!f8) { EpiGU E{(bf16_t*)(ws + WS_ACTM), FE, nullptr, (size_t)NT * FE}; pg8::gemm_phase<EpiGU, MoeOrder>(ring, ws, D, D, D, S, E, F.wv); }
                else if ((I8B4 >> l) & 1) { EpiGUi8 E{(bf16_t*)(ws + WS_ACTM), FE8, (const float*)(ws + WS_SAM), (const float*)(ws + WS_SWM) + l * NE * 2 * FE, 1, (size_t)NT * FE8, NT, 2 * FE};
                    pg8::gemm_phase<EpiGUi8, MoeOrder, 2>(ring, ws, D, D, D, S, E, F.wv); }
                else { EpiGU8 E{ws + WS_ACTM, FE8, (size_t)NT * FE8, 1.0f / 32.0f, nullptr}; pg8::gemm_phase<EpiGU8, MoeOrder, true>(ring, ws, D, D, D, S, E, F.wv); }
            }
            if (l == 0) { if (I8A1 & 2) strip_loop<true>(F, args, 1, 0, 384, 0, 0, 0); tile_loop<true>(F, args, 2, 0, 0); }
            __syncthreads();
        }
        SEAM(pb + 8);
        WS_FRESH;
        if (EN(10) && IN(pb + 9)) _Pragma("unroll 1") for (int rep = 0; rep < NREP(10); ++rep) {
            const bool f8 = (F8MASK >> l) & 1;
            MoeOrder S;
            if (!f8) S.init(WS_ACTM, (size_t)NT * FE * 2, FE, WS_WMDN + l * SZ_WMDN, (size_t)D * FE * 2, FE, D / 256, counts, F.G, F.bid);
            else S.init(WS_ACTM, (size_t)NT * FE8, FE8, WS_WMDN + l * SZ_WMDN, (size_t)D * FE8, FE8, D / 256, counts, F.G, F.bid, 1);
            const int Gc = (l == 0) ? compute_cus(S.total, F.G) : F.G; S.G = Gc;
            if (F.bid < Gc) {
                EpiMoeDown E{(bf16_t*)(ws + WS_Y), (const int*)(ws + WS_TOK), (const float*)(ws + WS_GATE), f8 ? 1.0f / 32.0f : 1.0f};
                if (!f8) pg8::gemm_phase<EpiMoeDown, MoeOrder>(ring, ws, FE, FE, FE, S, E, F.wv);
                else pg8::gemm_phase<EpiMoeDown, MoeOrder, true>(ring, ws, FE8, FE8, FE8, S, E, F.wv);
            }
            if (l == 0) tile_loop<true>(F, args, 3, 0, 0);
            __syncthreads();
        }
        SEAM(pb + 9);
        WS_FRESH;
        if (EN(11) && IN(pb + 10)) _Pragma("unroll 1") for (int rep = 0; rep < NREP(11); ++rep) combine_phase(F, X, (const bf16_t*)(ws + WS_Y), XB, args.in[13], F.out, l == 1, ((I8A1 >> (l + 1)) & 1) ? 2 : ((PROJ8 >> (l + 1)) & 1), rep ? 0.f : 1.0f, (float*)(ws + WS_SA));
        if (l == 0) SEAM(pb + 10);
    }
#undef IN
#undef SEAM
}

extern "C" void kernel_launch(void* const* d_in, const int* in_sizes, int n_in, void* d_out, int out_size, void* d_ws, size_t ws_size, hipStream_t stream) {
    static int grid = 0;
    if (grid == 0) {
        if (n_in != 14 || in_sizes[0] != NT * D || out_size != NT * D || ws_size < WS_END) { fprintf(stderr, "kernel_launch: unexpected shapes (n_in %d, in0 %d, out %d, ws %zu < %zu)\n", n_in, n_in > 0 ? in_sizes[0] : -1, out_size, ws_size, (size_t)WS_END); grid = -1; return; }
        int dev = 0, cus = 0, per_cu = 0;
        if (hipGetDevice(&dev) != hipSuccess || hipDeviceGetAttribute(&cus, hipDeviceAttributeMultiprocessorCount, dev) != hipSuccess) { grid = -1; return; }
        if (hipFuncSetAttribute((const void*)trunk_fwd, hipFuncAttributeMaxDynamicSharedMemorySize, LDS_BYTES) != hipSuccess) { fprintf(stderr, "kernel_launch: hipFuncSetAttribute failed\n"); grid = -1; return; }
        if (hipOccupancyMaxActiveBlocksPerMultiprocessor(&per_cu, (const void*)trunk_fwd, 512, LDS_BYTES) != hipSuccess || per_cu < 1) fprintf(stderr, "kernel_launch: occupancy query reports %d\n", per_cu);
        (void)hipGetLastError();
        grid = cus;
    }
    if (grid < 0) return;
    if (hipMemsetAsync((char*)d_ws + WS_CTL, 0, CTL_BYTES, stream) != hipSuccess) return;
    Params p{};
    for (int i = 0; i < 14; ++i) p.in[i] = (const float*)d_in[i];
    p.out = (float*)d_out; p.ws = (unsigned char*)d_ws;
#if MK_N_LAUNCHES == 1
    p.ph_lo = 0; p.ph_hi = NPHASE;
    hipLaunchKernelGGL(trunk_fwd, dim3(grid), dim3(512), LDS_BYTES, stream, p);
#else
    for (int k = 0; k < NPHASE; ++k) { p.ph_lo = k; p.ph_hi = k + 1; hipLaunchKernelGGL(trunk_fwd, dim3(grid), dim3(512), LDS_BYTES, stream, p); }
#endif
}
```
